# Optimizing an MI355X kernel written in HIP

```python
import jax, jax.numpy as jnp
from jax import lax
import numpy as np

D_MODEL = 1024
BATCH = 8
SEQ = 4096
DEPTH = 1
DEC_BATCH = 32
DEC_SEQ = 8
PAST_LEN = 16384
PAGE_SIZE = 128

ATT_WIDTH = D_MODEL // 2
CONV_CH = D_MODEL - ATT_WIDTH
HEAD_DIM = 64
N_ATT_HEADS = ATT_WIDTH // HEAD_DIM
DILATED_BRANCHES = ((128, 1), (512, 4), (2048, 16))
W_MAX = 2048
Q_BLOCK = 128
CONV_K = 31
IN_COLS = 3 * ATT_WIDTH + 2 * CONV_CH
N_KEYS = 128
N_EXPERTS = N_KEYS * N_KEYS
PEER_HEADS = 8
PEER_KEY_DIM = 256
PEER_TOPK = 16
PEER_BLOCK = 256
ALPHA = (2.0 * DEPTH) ** 0.25
BETA = (8.0 * DEPTH) ** -0.25
LN_EPS = 1e-5

kernel_name = "hymba_conformer_dilated_peer_step"


def _layer_norm(x, g, b):
    xf = x.astype(jnp.float32)
    mu = jnp.mean(xf, -1, keepdims=True)
    var = jnp.mean(jnp.square(xf - mu), -1, keepdims=True)
    return ((xf - mu) * lax.rsqrt(var + LN_EPS) * g.astype(jnp.float32) + b.astype(jnp.float32)).astype(x.dtype)


def _masked_softmax_stats(s, mask):
    s = jnp.where(mask, s, -jnp.inf)
    m = jnp.max(s, -1, keepdims=True)
    p = jnp.exp(s - m)
    den = jnp.sum(p, -1, keepdims=True)
    return p / den, m[..., 0] + jnp.log(den[..., 0])


def _combine_branches(outs, lses, dtype):
    wts = jax.nn.softmax(jnp.stack(lses, 0), axis=0)
    o = outs[0] * wts[0][..., None]
    for i in range(1, len(outs)):
        o = o + outs[i] * wts[i][..., None]
    return o.astype(dtype)


def _in_proj(x, w_in):
    B, T, _ = x.shape
    z = jnp.einsum('btd,df->btf', x, w_in)
    q = z[..., 0:ATT_WIDTH].reshape(B, T, N_ATT_HEADS, HEAD_DIM)
    k = z[..., ATT_WIDTH:2 * ATT_WIDTH].reshape(B, T, N_ATT_HEADS, HEAD_DIM)
    v = z[..., 2 * ATT_WIDTH:3 * ATT_WIDTH].reshape(B, T, N_ATT_HEADS, HEAD_DIM)
    a = z[..., 3 * ATT_WIDTH:3 * ATT_WIDTH + CONV_CH]
    g = z[..., 3 * ATT_WIDTH + CONV_CH:]
    glu = a * jax.nn.sigmoid(g)
    return q, k, v, glu


def _dilated_attn_prompt(q, k, v):
    B, S, H, E = q.shape
    scale = HEAD_DIM ** -0.5
    pad = ((0, 0), (W_MAX, 0), (0, 0), (0, 0))
    kp = jnp.pad(k, pad)
    vp = jnp.pad(v, pad)

    def block(t0):
        qb = lax.dynamic_slice_in_dim(q, t0, Q_BLOCK, axis=1)
        outs, lses = [], []
        for w, d in DILATED_BRANCHES:
            L = w + Q_BLOCK
            kb = lax.dynamic_slice_in_dim(kp, t0 + W_MAX - w, L, axis=1)
            vb = lax.dynamic_slice_in_dim(vp, t0 + W_MAX - w, L, axis=1)
            qr = qb.reshape(B, Q_BLOCK // d, d, H, E)
            kr = kb.reshape(B, L // d, d, H, E)
            vr = vb.reshape(B, L // d, d, H, E).astype(jnp.float32)
            s = jnp.einsum('birhe,bjrhe->brhij', qr, kr,
                           preferred_element_type=jnp.float32) * scale
            i = jnp.arange(Q_BLOCK // d)[:, None]
            j = jnp.arange(L // d)[None, :]
            r = jnp.arange(d)[:, None, None]
            rel = j - i
            key_pos = t0 - w + j * d + r
            mask = (rel >= 0) & (rel <= w // d) & (key_pos >= 0)
            p, lse = _masked_softmax_stats(s, mask[:, None])
            o = jnp.einsum('brhij,bjrhe->birhe', p, vr)
            outs.append(o.reshape(B, Q_BLOCK, H, E))
            lses.append(lse.transpose(0, 3, 1, 2).reshape(B, Q_BLOCK, H))
        return _combine_branches(outs, lses, q.dtype)

    ob = lax.map(block, jnp.arange(S // Q_BLOCK) * Q_BLOCK)
    return ob.transpose(1, 0, 2, 3, 4).reshape(B, S, H, E)


def _dilated_attn_sample(q, k_all, v_all):
    B, T, H, E = q.shape
    Lb = k_all.shape[1] - T
    scale = HEAD_DIM ** -0.5
    outs, lses = [], []
    for w, d in DILATED_BRANCHES:
        n = w // d + 1
        idx = Lb + jnp.arange(T)[:, None] - d * jnp.arange(n)[None, :]
        valid = idx >= 0
        idxc = jnp.maximum(idx, 0)
        kg = jnp.take(k_all, idxc, axis=1)
        vg = jnp.take(v_all, idxc, axis=1).astype(jnp.float32)
        s = jnp.einsum('bthe,btnhe->bhtn', q, kg,
                       preferred_element_type=jnp.float32) * scale
        p, lse = _masked_softmax_stats(s, valid)
        outs.append(jnp.einsum('bhtn,btnhe->bthe', p, vg))
        lses.append(lse.transpose(0, 2, 1))
    return _combine_branches(outs, lses, q.dtype)


def _conv_module(glu, conv_past, conv_w, conv_b, ln_g, ln_b):
    xpad = jnp.concatenate([conv_past, glu], axis=1)
    y = lax.conv_general_dilated(xpad, conv_w[:, None, :].astype(xpad.dtype), window_strides=(1,),
                                 padding='VALID', dimension_numbers=('NWC', 'WIO', 'NWC'),
                                 feature_group_count=CONV_CH)
    y = _layer_norm(y + conv_b, ln_g, ln_b)
    return jax.nn.silu(y)


def _peer(x, w_query, sub_keys, expert_u, expert_v):
    B, T, D = x.shape
    xt = x.reshape(B * T, D)
    n = xt.shape[0]
    n_pad = (-n) % PEER_BLOCK
    blocks = jnp.pad(xt, ((0, n_pad), (0, 0))).reshape(-1, PEER_BLOCK, D)
    half = PEER_KEY_DIM // 2

    def block(xb):
        q = (xb @ w_query).reshape(PEER_BLOCK, PEER_HEADS, 2, half)
        s = jnp.einsum('thpc,hpkc->thpk', q, sub_keys, preferred_element_type=jnp.float32)
        top_s, top_i = lax.top_k(s, PEER_TOPK)
        cand_s = (top_s[:, :, 0, :, None] + top_s[:, :, 1, None, :]).reshape(PEER_BLOCK, PEER_HEADS, -1)
        cand_e = (top_i[:, :, 0, :, None] * N_KEYS + top_i[:, :, 1, None, :]).reshape(PEER_BLOCK, PEER_HEADS, -1)
        best_s, best_j = lax.top_k(cand_s, PEER_TOPK)
        experts = jnp.take_along_axis(cand_e, best_j, axis=-1)
        gate = jax.nn.softmax(best_s, axis=-1).reshape(PEER_BLOCK, -1)
        e_flat = experts.reshape(PEER_BLOCK, -1)
        u = jnp.take(expert_u, e_flat, axis=0)
        vv = jnp.take(expert_v, e_flat, axis=0)
        act = jax.nn.gelu(jnp.einsum('td,tkd->tk', xb, u, preferred_element_type=jnp.float32),
                          approximate=False)
        coef = (gate * act).astype(vv.dtype)
        return jnp.einsum('tk,tkd->td', coef, vv)

    out = lax.map(block, blocks).reshape(-1, D)[:n]
    return out.reshape(B, T, D).astype(x.dtype)


def _finish(x, att, conv, w_out, ln1_g, ln1_b, w_query, sub_keys, expert_u, expert_v, ln2_g, ln2_b):
    B, T, _ = x.shape
    mixed = jnp.concatenate([att.reshape(B, T, ATT_WIDTH), conv], axis=-1)
    mix = jnp.einsum('btf,fd->btd', mixed, w_out)
    x1 = _layer_norm(ALPHA * x + mix, ln1_g, ln1_b)
    return _layer_norm(ALPHA * x1 + _peer(x1, w_query, sub_keys, expert_u, expert_v), ln2_g, ln2_b)


def setup_inputs(seed: int = 0) -> dict:
    key = jax.random.key(seed)
    ks = jax.random.split(key, 20)
    f32 = jnp.float32
    wb = min(W_MAX, PAST_LEN)
    col_scale = jnp.concatenate([jnp.ones((2 * ATT_WIDTH,), f32),
                                 jnp.full((ATT_WIDTH + 2 * CONV_CH,), BETA, f32)])
    return {
        "x_prompt": jax.random.normal(ks[0], (BATCH, SEQ, D_MODEL), f32),
        "x_sample": jax.random.normal(ks[1], (DEC_BATCH, DEC_SEQ, D_MODEL), f32),
        "cache_k_win": jax.random.normal(ks[2], (DEPTH, DEC_BATCH, wb, N_ATT_HEADS, HEAD_DIM), f32),
        "cache_v_win": BETA * jax.random.normal(ks[3], (DEPTH, DEC_BATCH, wb, N_ATT_HEADS, HEAD_DIM), f32),
        "state_conv": 0.5 * jax.random.normal(ks[4], (DEPTH, DEC_BATCH, CONV_K - 1, CONV_CH), f32),
        "w_in": jax.random.normal(ks[5], (DEPTH, D_MODEL, IN_COLS), f32) * D_MODEL ** -0.5 * col_scale,
        "w_out": jax.random.normal(ks[6], (DEPTH, D_MODEL, D_MODEL), f32) * D_MODEL ** -0.5 * BETA,
        "conv_w": jax.random.normal(ks[7], (DEPTH, CONV_K, CONV_CH), f32) * CONV_K ** -0.5,
        "conv_b": 0.02 * jax.random.normal(ks[8], (DEPTH, CONV_CH), f32),
        "conv_ln_g": 1.0 + 0.02 * jax.random.normal(ks[9], (DEPTH, CONV_CH), f32),
        "conv_ln_b": 0.02 * jax.random.normal(ks[10], (DEPTH, CONV_CH), f32),
        "ln1_g": 1.0 + 0.02 * jax.random.normal(ks[11], (DEPTH, D_MODEL), f32),
        "ln1_b": 0.02 * jax.random.normal(ks[12], (DEPTH, D_MODEL), f32),
        "w_query": jax.random.normal(ks[13], (DEPTH, D_MODEL, PEER_HEADS * PEER_KEY_DIM), f32) * D_MODEL ** -0.5,
        "sub_keys": jax.random.normal(ks[14], (DEPTH, PEER_HEADS, 2, N_KEYS, PEER_KEY_DIM // 2), f32) * (PEER_KEY_DIM // 2) ** -0.5,
        "expert_u": jax.random.normal(ks[15], (DEPTH, N_EXPERTS, D_MODEL), f32) * D_MODEL ** -0.5 * BETA,
        "expert_v": jax.random.normal(ks[16], (DEPTH, N_EXPERTS, D_MODEL), f32) * 0.5 * BETA,
        "ln2_g": 1.0 + 0.02 * jax.random.normal(ks[17], (DEPTH, D_MODEL), f32),
        "ln2_b": 0.02 * jax.random.normal(ks[18], (DEPTH, D_MODEL), f32),
    }


def reference(x_prompt, x_sample, cache_k_win, cache_v_win, state_conv,
              w_in, w_out, conv_w, conv_b, conv_ln_g, conv_ln_b,
              ln1_g, ln1_b, w_query, sub_keys, expert_u, expert_v, ln2_g, ln2_b):
    hp, hs = x_prompt, x_sample
    kp_rows, vp_rows, cp_rows, ks_rows, vs_rows, cs_rows = [], [], [], [], [], []
    for l in range(DEPTH):
        S = hp.shape[1]
        q, k, v, glu = _in_proj(hp, w_in[l])
        att = _dilated_attn_prompt(q, k, v)
        conv = _conv_module(glu, jnp.zeros((hp.shape[0], CONV_K - 1, CONV_CH), glu.dtype),
                            conv_w[l], conv_b[l], conv_ln_g[l], conv_ln_b[l])
        keep_p = min(W_MAX, S)
        kp_rows.append(k[:, S - keep_p:])
        vp_rows.append(v[:, S - keep_p:])
        cp_rows.append(glu[:, S - (CONV_K - 1):])
        hp = _finish(hp, att, conv, w_out[l], ln1_g[l], ln1_b[l], w_query[l], sub_keys[l],
                     expert_u[l], expert_v[l], ln2_g[l], ln2_b[l])

        T = hs.shape[1]
        q2, k2, v2, glu2 = _in_proj(hs, w_in[l])
        k_all = jnp.concatenate([cache_k_win[l].astype(k2.dtype), k2], axis=1)
        v_all = jnp.concatenate([cache_v_win[l].astype(v2.dtype), v2], axis=1)
        att2 = _dilated_attn_sample(q2, k_all, v_all)
        conv_in = jnp.concatenate([state_conv[l].astype(glu2.dtype), glu2], axis=1)
        conv2 = _conv_module(glu2, state_conv[l].astype(glu2.dtype),
                             conv_w[l], conv_b[l], conv_ln_g[l], conv_ln_b[l])
        L_all = k_all.shape[1]
        keep_s = min(W_MAX, L_all)
        ks_rows.append(k_all[:, L_all - keep_s:])
        vs_rows.append(v_all[:, L_all - keep_s:])
        cs_rows.append(conv_in[:, conv_in.shape[1] - (CONV_K - 1):])
        hs = _finish(hs, att2, conv2, w_out[l], ln1_g[l], ln1_b[l], w_query[l], sub_keys[l],
                     expert_u[l], expert_v[l], ln2_g[l], ln2_b[l])

    new_k_prompt = jnp.stack(kp_rows, 0)
    new_v_prompt = jnp.stack(vp_rows, 0)
    new_conv_prompt = jnp.stack(cp_rows, 0)
    new_k_sample = jnp.stack(ks_rows, 0)
    new_v_sample = jnp.stack(vs_rows, 0)
    new_conv_sample = jnp.stack(cs_rows, 0)
    return (hp, hs, new_k_prompt, new_v_prompt, new_conv_prompt, new_k_sample, new_v_sample, new_conv_sample)
```

```cpp
#include <hip/hip_runtime.h>
#include <hip/hip_cooperative_groups.h>
#include <cstdio>
#include <cstdint>
namespace cg = cooperative_groups;

namespace pg8 {
#define PG8_LAS __attribute__((address_space(3)))
typedef unsigned short bf16_t;
typedef short bf16x8 __attribute__((ext_vector_type(8)));
typedef float f32x4 __attribute__((ext_vector_type(4)));
typedef unsigned u32x4 __attribute__((ext_vector_type(4)));
typedef unsigned u32x2 __attribute__((ext_vector_type(2)));
constexpr int BM = 256, BK = 64, HALF = 128, HTB = HALF * BK * 2, STAGE_BYTES = 8 * HTB, NXCD = 8, WGM = 4;

__host__ __device__ __forceinline__ int lds_byte(int r, int c) { const int st = (r >> 4) * 2 + (c >> 5), rr = r & 15, cc = c & 31, ob = rr * 64 + cc * 2; return st * 1024 + (ob ^ (((ob >> 9) & 1) << 5)); }
__host__ __device__ __forceinline__ void stage_rc(int b, int& R, int& C) { const int st = b / 1024, sb = b % 1024, swz = sb ^ (((sb >> 9) & 1) << 5); R = (st >> 1) * 16 + swz / 64; C = (st & 1) * 32 + (swz % 64) / 2; }
__host__ __device__ __forceinline__ int perm32(int rho) { const int n = rho >> 4, i = rho & 15; return 8 * (i >> 2) + 4 * n + (i & 3); }

struct Unit { int pm, pn; };
struct Gemm { const bf16_t* A; const bf16_t* Bt; int M, N, K; };

struct StaticOrder {
    int nM, nN, nwg, G, c;
    __host__ __device__ void init(int M, int N, int G_, int c_) { nM = M / BM; nN = N / BM; nwg = nM * nN; G = G_; c = c_; }
    __host__ __device__ bool next(int i, Unit& u) const {
        const long L = (long)i * G + c; if (L >= nwg) return false;
        int wgid = (int)L; { const int q = nwg / NXCD, r = nwg % NXCD, xcd = wgid % NXCD, off = wgid / NXCD; wgid = (xcd < r ? xcd * (q + 1) : r * (q + 1) + (xcd - r) * q) + off; }
        const int nig = WGM * nN, gid = wgid / nig, fm = gid * WGM, gsz = (nM - fm) < WGM ? (nM - fm) : WGM;
        u.pm = fm + ((wgid % nig) % gsz); u.pn = (wgid % nig) / gsz; return true;
    }
    __device__ __forceinline__ void a_ready(const Unit&) const {}
    __device__ __forceinline__ void done(const Unit&) const {}
};

template <class Epi, class Sched, bool ALIGN_EPI = false, bool SP2 = false>
__device__ __forceinline__ void gemm_phase(PG8_LAS unsigned char* lds, const Gemm g, const Sched& S, const Epi& E) {
    int tid = threadIdx.x; asm volatile("" : "+v"(tid));
    const int wid = __builtin_amdgcn_readfirstlane(tid >> 6), lane = tid & 63, wr = wid >> 2, wc = wid & 3, fr = lane & 15, fq = lane >> 4;
    const int K = g.K, nt = K / BK;
    unsigned voffA[2], voffB[2];
#pragma unroll
    for (int i = 0; i < 2; ++i) { int R, C; stage_rc(tid * 16 + i * 8192, R, C); const int Rb = Epi::PERM ? ((R & ~31) + perm32(R & 31)) : R;
        voffA[i] = (unsigned)(R * K + C) * 2u; voffB[i] = (unsigned)(Rb * K + C) * 2u; }
    const size_t kstep = (size_t)(BK * 2);
    const size_t hstep = (size_t)HALF * K * 2;
    const size_t tstep = 2 * hstep;
    const unsigned ldsw = (unsigned)wid * 1024u;
    const int aoff = lds_byte(wr * 64 + fr, fq * 8), boff = lds_byte(wc * 32 + fr, fq * 8);
#define PG8_SA(b, h) (((b) * 2 + (h)) * HTB)
#define PG8_SB(b, h) ((4 + (b) * 2 + (h)) * HTB)
#define PG8_STAGE(bufoff, gbase, voff) do { _Pragma("unroll") for (int _i = 0; _i < 2; ++_i) \
        __builtin_amdgcn_global_load_lds((const unsigned*)((const char*)(gbase) + (voff)[_i]), (PG8_LAS unsigned*)(lds + (bufoff) + ldsw + _i * 8192), 16, 0, 0); } while (0)
#define PG8_LDA(dst, b, h) do { _Pragma("unroll") for (int m = 0; m < 4; ++m) _Pragma("unroll") for (int k = 0; k < 2; ++k) dst[m][k] = *(const PG8_LAS bf16x8*)(lds + PG8_SA(b, h) + aoff + m * 2048 + k * 1024); } while (0)
#define PG8_LDB(dst, b, h) do { _Pragma("unroll") for (int n = 0; n < 2; ++n) _Pragma("unroll") for (int k = 0; k < 2; ++k) dst[n][k] = *(const PG8_LAS bf16x8*)(lds + PG8_SB(b, h) + boff + n * 2048 + k * 1024); } while (0)
#define PG8_MMA(ai, bj, At, Bt) do { __builtin_amdgcn_s_setprio(1); _Pragma("unroll") for (int m = 0; m < 4; ++m) _Pragma("unroll") for (int n = 0; n < 2; ++n) _Pragma("unroll") for (int k = 0; k < 2; ++k) \
        acc[ai][bj][m][n] = __builtin_amdgcn_mfma_f32_16x16x32_bf16(Bt[n][k], At[m][k], acc[ai][bj][m][n], 0, 0, 0); __builtin_amdgcn_s_setprio(0); } while (0)
#define PG8_WAIT_V(n) asm volatile("s_waitcnt vmcnt(" #n ")" ::: "memory")
#define PG8_WAIT_L(n) asm volatile("s_waitcnt lgkmcnt(" #n ")" ::: "memory")
#define PG8_BAR __builtin_amdgcn_s_barrier()
#define PG8_SCHED __builtin_amdgcn_sched_barrier(0)
    Unit cur, nxt; int ui = 0;
    if (!S.next(0, cur)) return;
    f32x4 acc[2][2][4][2];
#pragma unroll
    for (int a = 0; a < 2; ++a)
#pragma unroll
        for (int b = 0; b < 2; ++b)
#pragma unroll
            for (int m = 0; m < 4; ++m)
#pragma unroll
                for (int n = 0; n < 2; ++n) acc[a][b][m][n] = (f32x4){0.f, 0.f, 0.f, 0.f};
    bf16x8 At[4][2], B0[2][2], B1[2][2];
    const char* cA = (const char*)g.A + (size_t)cur.pm * tstep; const char* cB = (const char*)g.Bt + (size_t)cur.pn * tstep;
    S.a_ready(cur);
    if constexpr (SP2) {
        PG8_STAGE(PG8_SB(0, 0), cB, voffB); PG8_STAGE(PG8_SB(0, 1), cB + hstep, voffB); PG8_STAGE(PG8_SA(0, 0), cA, voffA); PG8_STAGE(PG8_SA(0, 1), cA + hstep, voffA);
        if (wr == 1) PG8_BAR;
        PG8_WAIT_V(2); PG8_BAR;
        PG8_STAGE(PG8_SB(1, 0), cB + kstep, voffB); PG8_STAGE(PG8_SA(1, 0), cA + kstep, voffA); PG8_STAGE(PG8_SB(1, 1), cB + hstep + kstep, voffB);
        PG8_WAIT_V(6); PG8_BAR;
    } else {
        PG8_STAGE(PG8_SB(0, 0), cB, voffB); PG8_STAGE(PG8_SA(0, 0), cA, voffA); PG8_STAGE(PG8_SB(0, 1), cB + hstep, voffB); PG8_STAGE(PG8_SA(0, 1), cA + hstep, voffA);
        if (wr == 1) PG8_BAR;
        PG8_WAIT_V(4); PG8_BAR;
        PG8_STAGE(PG8_SB(1, 0), cB + kstep, voffB); PG8_STAGE(PG8_SA(1, 0), cA + kstep, voffA); PG8_STAGE(PG8_SB(1, 1), cB + hstep + kstep, voffB);
        PG8_WAIT_V(6); PG8_BAR;
    }
    for (;;) {
        const bool has_next = S.next(ui + 1, nxt);
        const char* nA = has_next ? (const char*)g.A + (size_t)nxt.pm * tstep : cA; const char* nB = has_next ? (const char*)g.Bt + (size_t)nxt.pn * tstep : cB;
        for (int t = 0; t < nt; t += 2) {
            const bool last = (t == nt - 2);
            const char* a1 = cA + (size_t)(t + 1) * kstep;
            const char* a2 = last ? nA : cA + (size_t)(t + 2) * kstep; const char* b2 = last ? nB : cB + (size_t)(t + 2) * kstep;
            const char* a3 = a2 + kstep; const char* b3 = b2 + kstep;
            if (last && has_next) S.a_ready(nxt);
            if constexpr (SP2) {
            PG8_LDB(B0, 0, 0); PG8_LDB(B1, 0, 1); PG8_SCHED; PG8_LDA(At, 0, 0); PG8_STAGE(PG8_SA(1, 1), a1 + hstep, voffA);
            PG8_WAIT_V(8); PG8_WAIT_L(0); PG8_BAR; PG8_MMA(0, 0, At, B0); PG8_MMA(0, 1, At, B1); PG8_BAR; PG8_SCHED;
            PG8_LDA(At, 0, 1); PG8_STAGE(PG8_SB(0, 0), b2, voffB); PG8_STAGE(PG8_SB(0, 1), b2 + hstep, voffB); PG8_STAGE(PG8_SA(0, 0), a2, voffA);
            PG8_WAIT_V(8); PG8_WAIT_L(0); PG8_BAR; PG8_MMA(1, 0, At, B0); PG8_MMA(1, 1, At, B1); PG8_BAR; PG8_SCHED;
            PG8_LDB(B0, 1, 0); PG8_LDB(B1, 1, 1); PG8_SCHED; PG8_LDA(At, 1, 0); PG8_STAGE(PG8_SA(0, 1), a2 + hstep, voffA);
            PG8_WAIT_V(8); PG8_WAIT_L(0); PG8_BAR; PG8_MMA(0, 0, At, B0); PG8_MMA(0, 1, At, B1); PG8_BAR; PG8_SCHED;
            PG8_LDA(At, 1, 1); PG8_STAGE(PG8_SB(1, 0), b3, voffB); PG8_STAGE(PG8_SB(1, 1), b3 + hstep, voffB); PG8_STAGE(PG8_SA(1, 0), a3, voffA);
            PG8_WAIT_V(8); PG8_WAIT_L(0); PG8_BAR; PG8_MMA(1, 0, At, B0); PG8_MMA(1, 1, At, B1); PG8_BAR; PG8_SCHED;
            } else {
            PG8_LDB(B0, 0, 0); PG8_SCHED; PG8_LDA(At, 0, 0); PG8_STAGE(PG8_SA(1, 1), a1 + hstep, voffA);
            PG8_WAIT_L(8); PG8_BAR; PG8_WAIT_L(0); PG8_MMA(0, 0, At, B0); PG8_BAR; PG8_SCHED;
            PG8_LDB(B1, 0, 1); PG8_STAGE(PG8_SB(0, 0), b2, voffB);
            PG8_BAR; PG8_WAIT_L(0); PG8_MMA(0, 1, At, B1); PG8_BAR;
            PG8_LDA(At, 0, 1); PG8_STAGE(PG8_SA(0, 0), a2, voffA);
            PG8_BAR; PG8_WAIT_L(0); PG8_MMA(1, 0, At, B0); PG8_BAR; PG8_SCHED;
            PG8_STAGE(PG8_SB(0, 1), b2 + hstep, voffB);
            PG8_WAIT_V(6); PG8_BAR; PG8_MMA(1, 1, At, B1); PG8_BAR;
            PG8_LDB(B0, 1, 0); PG8_SCHED; PG8_LDA(At, 1, 0); PG8_STAGE(PG8_SA(0, 1), a2 + hstep, voffA);
            PG8_WAIT_L(8); PG8_BAR; PG8_WAIT_L(0); PG8_MMA(0, 0, At, B0); PG8_BAR; PG8_SCHED;
            PG8_LDB(B1, 1, 1); PG8_STAGE(PG8_SB(1, 0), b3, voffB);
            PG8_BAR; PG8_WAIT_L(0); PG8_MMA(0, 1, At, B1); PG8_BAR;
            PG8_LDA(At, 1, 1); PG8_STAGE(PG8_SA(1, 0), a3, voffA);
            PG8_BAR; PG8_WAIT_L(0); PG8_MMA(1, 0, At, B0); PG8_BAR; PG8_SCHED;
            PG8_STAGE(PG8_SB(1, 1), b3 + hstep, voffB);
            PG8_WAIT_V(6); PG8_BAR; PG8_MMA(1, 1, At, B1); PG8_BAR;
            }
        }
        if constexpr (ALIGN_EPI) { if (wr == 0) PG8_BAR; }
        if constexpr (!Epi::AFTER_DRAIN) { E(acc, cur, wr, wc, fr, fq); S.done(cur); }
        if (!has_next) break;
#pragma unroll
        for (int a = 0; a < 2; ++a)
#pragma unroll
            for (int b = 0; b < 2; ++b)
#pragma unroll
                for (int m = 0; m < 4; ++m)
#pragma unroll
                    for (int n = 0; n < 2; ++n) acc[a][b][m][n] = (f32x4){0.f, 0.f, 0.f, 0.f};
        cur = nxt; cA = nA; cB = nB; ++ui;
        if constexpr (ALIGN_EPI) { if (wr == 1) PG8_BAR; }
    }
    PG8_WAIT_V(0);
    if constexpr (!ALIGN_EPI) { if (wr == 0) PG8_BAR; }
    PG8_BAR;
    if constexpr (Epi::AFTER_DRAIN) { E.fused(acc, cur, wr, wc, fr, fq, lds, wid, lane); S.done(cur); }
#undef PG8_SA
#undef PG8_SB
#undef PG8_STAGE
#undef PG8_LDA
#undef PG8_LDB
#undef PG8_MMA
#undef PG8_WAIT_V
#undef PG8_WAIT_L
#undef PG8_BAR
#undef PG8_SCHED
}
}

#define GAS __attribute__((address_space(1)))
#define LAS __attribute__((address_space(3)))
typedef unsigned short bf16;
typedef unsigned v4u __attribute__((ext_vector_type(4)));
typedef unsigned v2u __attribute__((ext_vector_type(2)));
typedef float f32x4 __attribute__((ext_vector_type(4)));
typedef float f32x2_t __attribute__((ext_vector_type(2)));
typedef __bf16 bf16x2_t __attribute__((ext_vector_type(2)));

constexpr int DM = 1024, NPB = 8, SEQ = 4096, NSB = 32, DSEQ = 8, LB = 2048;
constexpr int NP = NPB * SEQ, NS = NSB * DSEQ, NTOK = NP + NS;
constexpr int AW = 512, CC = 512, NH = 8, HD = 64, INC = 2560, CK = 31;
constexpr int NKEYS = 128, PH = 8, PQD = 2048;
constexpr float ALPHA = 1.18920711500272f, LN_EPS = 1e-5f;
constexpr size_t O_Y = 0, O_KP = (size_t)NTOK * DM, O_VP = O_KP + (size_t)NPB * 2048 * 512, O_CP = O_VP + (size_t)NPB * 2048 * 512,
                 O_KS = O_CP + (size_t)NPB * 30 * 512, O_VS = O_KS + (size_t)NSB * 2048 * 512, O_CS = O_VS + (size_t)NSB * 2048 * 512, O_END = O_CS + (size_t)NSB * 30 * 512;
static_assert(O_END == 118317056ull, "output map");
constexpr size_t MiB = 1u << 20;
constexpr size_t WS_CTL = 0, WS_WT1 = 1 * MiB, WS_WT2 = 6 * MiB, WS_WT3 = 8 * MiB, WS_SK = 12 * MiB, WS_EU = 13 * MiB, WS_EV = 45 * MiB,
                 WS_XB = 77 * MiB, WS_QKVG = 142 * MiB, WS_MIX = 271 * MiB, WS_H = 336 * MiB, WS_END = 465 * MiB;
constexpr size_t QSZ = (size_t)NTOK * 512 * 2;
static_assert(WS_XB + (size_t)NTOK * DM * 2 <= WS_QKVG && WS_QKVG + 4 * QSZ <= WS_MIX && WS_QKVG + (size_t)NTOK * PQD * 2 <= WS_MIX && WS_MIX + (size_t)NTOK * DM * 2 <= WS_H && WS_H + (size_t)NTOK * DM * 4 <= WS_END, "ws map");
static_assert(WS_MIX + (size_t)NTOK * 128 * 8 <= WS_H, "idx+gate overlay");

constexpr int NWAVES = 8, NTHREADS = 512;
constexpr int LDS_BYTES = 147456;

struct Params { const float* in[19]; float* out; unsigned char* ws; };

__device__ __forceinline__ unsigned cvtpk(float lo, float hi) { f32x2_t v = {lo, hi}; bf16x2_t b = __builtin_convertvector(v, bf16x2_t); return __builtin_bit_cast(unsigned, b); }
__device__ __forceinline__ float bflo(unsigned u) { return __uint_as_float(u << 16); }
__device__ __forceinline__ float bfhi(unsigned u) { return __uint_as_float(u & 0xffff0000u); }
__device__ __forceinline__ float dot2(unsigned a, unsigned b, float c) { return __builtin_amdgcn_fdot2_f32_bf16(__builtin_bit_cast(bf16x2_t, a), __builtin_bit_cast(bf16x2_t, b), c, false); }
__device__ __forceinline__ float wave_sum(float v) {
#pragma unroll
    for (int o = 1; o < 64; o <<= 1) v += __shfl_xor(v, o);
    return v;
}
__device__ __forceinline__ float wave_max(float v) {
#pragma unroll
    for (int o = 1; o < 64; o <<= 1) v = fmaxf(v, __shfl_xor(v, o));
    return v;
}
__device__ __forceinline__ unsigned wave_maxu(unsigned v) {
#pragma unroll
    for (int o = 1; o < 64; o <<= 1) { const unsigned w = (unsigned)__shfl_xor((int)v, o); v = v > w ? v : w; }
    return v;
}
#define LDS_WAIT() asm volatile("s_waitcnt lgkmcnt(0)" ::: "memory")

__device__ __forceinline__ void p0_transpose_item(const float* W, int N, int K, int srcn0, bf16* WT, int dstn0, int k0, LAS float* scr, int lane) {
#pragma unroll 8
    for (int i = 0; i < 32; ++i) { const int kk = 2 * i + (lane >> 5); scr[kk * 33 + (lane & 31)] = W[(size_t)(k0 + kk) * N + srcn0 + (lane & 31)]; }
    LDS_WAIT(); asm volatile("" ::: "memory");
    const int c = lane & 7;
#pragma unroll
    for (int j = 0; j < 4; ++j) { const int n = (lane >> 3) + 8 * j; const LAS float* s = scr + (8 * c) * 33 + n;
        v4u o; o.x = cvtpk(s[0 * 33], s[1 * 33]); o.y = cvtpk(s[2 * 33], s[3 * 33]); o.z = cvtpk(s[4 * 33], s[5 * 33]); o.w = cvtpk(s[6 * 33], s[7 * 33]);
        *(v4u*)(WT + (size_t)(dstn0 + n) * K + k0 + 8 * c) = o; }
    LDS_WAIT(); asm volatile("" ::: "memory");
}
__device__ __forceinline__ int w1_src_col(int n0) {
    if (n0 < 1536) return n0;
    const int t = n0 - 1536, j = t >> 8, c = t & 255;
    return c < 128 ? 1536 + 128 * j + c : 2048 + 128 * j + (c - 128);
}
__device__ __forceinline__ void rows4_load(const float* src, f32x4 (&v)[16], int lane) {
    const f32x4* s = (const f32x4*)src + lane;
#pragma unroll
    for (int j = 0; j < 16; ++j) v[j] = s[64 * j];
}
__device__ __forceinline__ void rows4_store_bf16(const f32x4 (&v)[16], bf16* dst, int lane) {
    v2u* d = (v2u*)dst + lane;
#pragma unroll
    for (int j = 0; j < 16; ++j) { v2u o; o.x = cvtpk(v[j].x, v[j].y); o.y = cvtpk(v[j].z, v[j].w); d[64 * j] = o; }
}
__device__ __forceinline__ void rows4_to_bf16(const float* src, bf16* dst, int lane) { f32x4 v[16]; rows4_load(src, v, lane); rows4_store_bf16(v, dst, lane); }

typedef int v6i_t __attribute__((ext_vector_type(6)));
typedef float v32f_t __attribute__((ext_vector_type(32)));
typedef float v16f_t __attribute__((ext_vector_type(16)));
typedef unsigned v3u __attribute__((ext_vector_type(3)));
__device__ __forceinline__ void rows2_load(const float* src, f32x4 (&v)[8], int lane) {
    const int lp = lane & 31, hf = lane >> 5;
    const f32x4* s = (const f32x4*)(src + (size_t)hf * DM + 32 * lp);
#pragma unroll
    for (int j = 0; j < 8; ++j) v[j] = s[j];
}
__device__ __forceinline__ void rows2_encode_fp6(const f32x4 (&v)[8], unsigned char* dst, float* scale_out, int lane) {
    const int lp = lane & 31, hf = lane >> 5;
    float m = 0.f;
#pragma unroll
    for (int j = 0; j < 8; ++j) m = fmaxf(m, fmaxf(fmaxf(fabsf(v[j].x), fabsf(v[j].y)), fmaxf(fabsf(v[j].z), fabsf(v[j].w))));
#pragma unroll
    for (int o = 1; o < 32; o <<= 1) m = fmaxf(m, __shfl_xor(m, o));
    const float sc = m > 0.f ? m * (1.f / 7.5f) : 1.f, inv = 1.f / sc;
    unsigned long long acc64 = 0ull; int nb = 0; unsigned pkw[6]; int wi = 0;
#pragma unroll
    for (int j = 0; j < 8; ++j) {
        const float f4[4] = {v[j].x * inv, v[j].y * inv, v[j].z * inv, v[j].w * inv};
#pragma unroll
        for (int c = 0; c < 4; ++c) {
            const float a_ = fminf(fabsf(f4[c]), 7.5f);
            const float cf = a_ < 1.f ? a_ * 8.f : (a_ < 2.f ? 8.f + (a_ - 1.f) * 8.f : (a_ < 4.f ? 16.f + (a_ - 2.f) * 4.f : 24.f + (a_ - 4.f) * 2.f));
            unsigned code = (unsigned)__builtin_rintf(cf); if (code > 31u) code = 31u;
            if (f4[c] < 0.f) code |= 32u;
            acc64 |= (unsigned long long)code << nb; nb += 6;
            if (nb >= 32) { pkw[wi++] = (unsigned)acc64; acc64 >>= 32; nb -= 32; }
        }
    }
    v6i_t pk; pk[0] = (int)pkw[0]; pk[1] = (int)pkw[1]; pk[2] = (int)pkw[2]; pk[3] = (int)pkw[3]; pk[4] = (int)pkw[4]; pk[5] = (int)pkw[5];
    v2u* d = (v2u*)(dst + (size_t)hf * 768 + 24 * lp);
    v2u w; w.x = (unsigned)pk[0]; w.y = (unsigned)pk[1]; d[0] = w; w.x = (unsigned)pk[2]; w.y = (unsigned)pk[3]; d[1] = w; w.x = (unsigned)pk[4]; w.y = (unsigned)pk[5]; d[2] = w;
    if (lp == 0) scale_out[hf] = sc;
}

struct EpiInProj {
    static constexpr bool PERM = true, AFTER_DRAIN = false;
    bf16 *qb, *gb; float* out;
    __device__ __forceinline__ void operator()(const f32x4 (&acc)[2][2][4][2], const pg8::Unit& u, int wr, int wc, int fr, int fq) const {
        const int pn = u.pn;
#pragma unroll
        for (int ai = 0; ai < 2; ++ai)
#pragma unroll
            for (int m = 0; m < 4; ++m) {
                const int row = u.pm * 256 + ai * 128 + wr * 64 + m * 16 + fr;
                long kvrow = -1, cvrow = -1;
                bool samp = row >= NP;
                if (!samp) { const int b = row >> 12, t = row & 4095; if (t >= 2048) kvrow = (long)b * 2048 + (t - 2048); if (t >= SEQ - 30) cvrow = (long)b * 30 + (t - (SEQ - 30)); }
                else { const int s = row - NP, b = s >> 3, tt = s & 7; kvrow = (long)b * 2048 + 2040 + tt; cvrow = (long)b * 30 + 22 + tt; }
                if (pn < 6) {
                    const int which = pn >> 1;
                    bf16* dst = qb + (size_t)which * ((size_t)NTOK * 512) + (size_t)row * 512;
                    const size_t fbase = samp ? O_KS : O_KP, fstride = samp ? (O_VS - O_KS) : (O_VP - O_KP);
                    const bool dof = (which != 0) && (kvrow >= 0);
                    float* fo = out + fbase + (size_t)(which == 2 ? 1 : 0) * fstride + (size_t)(kvrow < 0 ? 0 : kvrow) * 512;
#pragma unroll
                    for (int bj = 0; bj < 2; ++bj) {
                        const int col = (pn & 1) * 256 + bj * 128 + wc * 32 + fq * 8;
                        const f32x4 v0 = acc[ai][bj][m][0], v1 = acc[ai][bj][m][1];
                        v4u o; o.x = cvtpk(v0.x, v0.y); o.y = cvtpk(v0.z, v0.w); o.z = cvtpk(v1.x, v1.y); o.w = cvtpk(v1.z, v1.w);
                        *(v4u*)(dst + col) = o;
                        if (dof) { *(f32x4*)(fo + col) = v0; *(f32x4*)(fo + col + 4) = v1; }
                    }
                } else {
                    const int j = pn - 6;
                    const bool dof = cvrow >= 0;
                    float* fo = out + (samp ? O_CS : O_CP) + (size_t)(cvrow < 0 ? 0 : cvrow) * 512;
                    const int ch = j * 128 + wc * 32 + fq * 8;
                    f32x4 r[2];
#pragma unroll
                    for (int n = 0; n < 2; ++n) {
                        const f32x4 a = acc[ai][0][m][n], g = acc[ai][1][m][n];
                        r[n].x = a.x / (1.f + __expf(-g.x)); r[n].y = a.y / (1.f + __expf(-g.y)); r[n].z = a.z / (1.f + __expf(-g.z)); r[n].w = a.w / (1.f + __expf(-g.w));
                    }
                    v4u o; o.x = cvtpk(r[0].x, r[0].y); o.y = cvtpk(r[0].z, r[0].w); o.z = cvtpk(r[1].x, r[1].y); o.w = cvtpk(r[1].z, r[1].w);
                    *(v4u*)(gb + (size_t)row * 512 + ch) = o;
                    if (dof) { *(f32x4*)(fo + ch) = r[0]; *(f32x4*)(fo + ch + 4) = r[1]; }
                }
            }
    }
};
struct EpiResid {
    static constexpr bool PERM = true, AFTER_DRAIN = false;
    const bf16* XBp; bf16* H;
    __device__ __forceinline__ void operator()(const f32x4 (&acc)[2][2][4][2], const pg8::Unit& u, int wr, int wc, int fr, int fq) const {
#pragma unroll
        for (int ai = 0; ai < 2; ++ai)
#pragma unroll
            for (int m = 0; m < 4; ++m) {
                const int row = u.pm * 256 + ai * 128 + wr * 64 + m * 16 + fr;
#pragma unroll
                for (int bj = 0; bj < 2; ++bj) {
                    const int col = u.pn * 256 + bj * 128 + wc * 32 + fq * 8;
                    const v4u xv = *(const v4u*)(XBp + (size_t)row * DM + col);
                    const f32x4 a0 = acc[ai][bj][m][0], a1 = acc[ai][bj][m][1];
                    v4u o;
                    o.x = cvtpk(ALPHA * bflo(xv.x) + a0.x, ALPHA * bfhi(xv.x) + a0.y); o.y = cvtpk(ALPHA * bflo(xv.y) + a0.z, ALPHA * bfhi(xv.y) + a0.w);
                    o.z = cvtpk(ALPHA * bflo(xv.z) + a1.x, ALPHA * bfhi(xv.z) + a1.y); o.w = cvtpk(ALPHA * bflo(xv.w) + a1.z, ALPHA * bfhi(xv.w) + a1.w);
                    *(v4u*)(H + (size_t)row * DM + col) = o;
                }
            }
    }
};
struct EpiPlainBf16 {
    static constexpr bool PERM = true, AFTER_DRAIN = false;
    bf16* O; int ldc;
    __device__ __forceinline__ void operator()(const f32x4 (&acc)[2][2][4][2], const pg8::Unit& u, int wr, int wc, int fr, int fq) const {
#pragma unroll
        for (int ai = 0; ai < 2; ++ai)
#pragma unroll
            for (int m = 0; m < 4; ++m) {
                const int row = u.pm * 256 + ai * 128 + wr * 64 + m * 16 + fr;
#pragma unroll
                for (int bj = 0; bj < 2; ++bj) {
                    const int col = u.pn * 256 + bj * 128 + wc * 32 + fq * 8;
                    const f32x4 v0 = acc[ai][bj][m][0], v1 = acc[ai][bj][m][1];
                    v4u o; o.x = cvtpk(v0.x, v0.y); o.y = cvtpk(v0.z, v0.w); o.z = cvtpk(v1.x, v1.y); o.w = cvtpk(v1.z, v1.w);
                    *(v4u*)(O + (size_t)row * ldc + col) = o;
                }
            }
    }
};


__device__ __forceinline__ void conv_task(const __amdgpu_buffer_rsrc_t rs, unsigned gb_off, unsigned csb_off, const LAS float* wl, const float* cb, const float* lg, const float* lb, bf16* MIX, int task, int lane) {
    const bool samp = task >= 4096;
    const int b = samp ? task - 4096 : task >> 9, t0 = samp ? 0 : (task & 511) * 8;
    const size_t rowbase = samp ? (size_t)NP + (size_t)b * 8 : (size_t)b * 4096;
    f32x2_t acc2[8][4];
    f32x4 wA[8], wB[8];
#pragma unroll
    for (int tt = 0; tt < 8; ++tt) {
        wA[tt] = (f32x4){0.f, 0.f, 0.f, 0.f}; wB[tt] = (f32x4){0.f, 0.f, 0.f, 0.f};
#pragma unroll
        for (int c = 0; c < 4; ++c) acc2[tt][c] = (f32x2_t){0.f, 0.f};
    }
    v4u cur[16];
    const unsigned baseB = gb_off + (unsigned)((int)rowbase + t0 - 30) * 1024u;
    const unsigned baseA = samp ? csb_off + (unsigned)(b * 30) * 1024u : baseB;
    const int rmin = samp ? 0 : (30 - t0 > 0 ? 30 - t0 : 0);
#define CONV_LOADROW(RR, DST) do { const int rr_ = (RR); \
            const unsigned bs_ = rr_ < 30 ? baseA : baseB; const bool ok_ = (rr_ >= rmin) & (rr_ < 38); \
            const unsigned ro_ = ok_ ? bs_ + (unsigned)rr_ * 1024u : 0x80000000u; \
            DST = __builtin_amdgcn_raw_buffer_load_b128(rs, (int)(ro_ + lane16), 0, 0); } while (0)
    const unsigned lane16 = 16u * (unsigned)lane;
#pragma unroll
    for (int i = 0; i < 16; ++i) CONV_LOADROW(i, cur[i]);
    { const LAS f32x4* wp = (const LAS f32x4*)(wl + 8 * lane); wA[0] = wp[0]; wB[0] = wp[1]; }
#define CONV_FMA(I, TT) do { const int sl_ = ((I) - (TT)) & 7; \
                acc2[TT][0] = __builtin_elementwise_fma((f32x2_t){wA[sl_].x, wA[sl_].y}, x01, acc2[TT][0]); \
                acc2[TT][1] = __builtin_elementwise_fma((f32x2_t){wA[sl_].z, wA[sl_].w}, x23, acc2[TT][1]); \
                acc2[TT][2] = __builtin_elementwise_fma((f32x2_t){wB[sl_].x, wB[sl_].y}, x45, acc2[TT][2]); \
                acc2[TT][3] = __builtin_elementwise_fma((f32x2_t){wB[sl_].z, wB[sl_].w}, x67, acc2[TT][3]); } while (0)
#define CONV_ROW(I, RR, REFILL) do { const int rr = (RR); \
            const v4u u = cur[I]; \
            const f32x2_t x01 = {bflo(u.x), bfhi(u.x)}, x23 = {bflo(u.y), bfhi(u.y)}, x45 = {bflo(u.z), bfhi(u.z)}, x67 = {bflo(u.w), bfhi(u.w)}; \
            if (REFILL) CONV_LOADROW(rr + 16, cur[I]); \
            CONV_FMA(I, 7); \
            __builtin_amdgcn_sched_barrier(0); \
            { const int kk = rr + 1 > 31 ? 31 : rr + 1; const LAS f32x4* wp = (const LAS f32x4*)(wl + kk * 512 + 8 * lane); wA[((I) + 1) & 7] = wp[0]; wB[((I) + 1) & 7] = wp[1]; }     \
            __builtin_amdgcn_sched_barrier(0); \
            CONV_FMA(I, 0); CONV_FMA(I, 1); CONV_FMA(I, 2); CONV_FMA(I, 3); CONV_FMA(I, 4); CONV_FMA(I, 5); CONV_FMA(I, 6); \
            __builtin_amdgcn_sched_barrier(0); } while (0)
#pragma unroll 1
    for (int c0 = 0; c0 < 32; c0 += 16) {
#pragma unroll
        for (int i = 0; i < 16; ++i) CONV_ROW(i, c0 + i, true);
    }
#pragma unroll
    for (int i = 0; i < 8; ++i) CONV_ROW(i, 32 + i, false);
#undef CONV_ROW
#undef CONV_FMA
#undef CONV_LOADROW
    float acc[8][8];
#pragma unroll
    for (int tt = 0; tt < 8; ++tt)
#pragma unroll
        for (int c = 0; c < 4; ++c) { acc[tt][2 * c] = acc2[tt][c].x; acc[tt][2 * c + 1] = acc2[tt][c].y; }
    const f32x4 cb0 = *(const f32x4*)(cb + 8 * lane), cb1 = *(const f32x4*)(cb + 8 * lane + 4);
    const f32x4 lg0 = *(const f32x4*)(lg + 8 * lane), lg1 = *(const f32x4*)(lg + 8 * lane + 4);
    const f32x4 lb0 = *(const f32x4*)(lb + 8 * lane), lb1 = *(const f32x4*)(lb + 8 * lane + 4);
    const float cbv[8] = {cb0.x, cb0.y, cb0.z, cb0.w, cb1.x, cb1.y, cb1.z, cb1.w};
    const float lgv[8] = {lg0.x, lg0.y, lg0.z, lg0.w, lg1.x, lg1.y, lg1.z, lg1.w};
    const float lbv[8] = {lb0.x, lb0.y, lb0.z, lb0.w, lb1.x, lb1.y, lb1.z, lb1.w};
#pragma unroll
    for (int tt = 0; tt < 8; ++tt) {
        float y[8]; float s1 = 0.f;
#pragma unroll
        for (int c = 0; c < 8; ++c) { y[c] = acc[tt][c] + cbv[c]; s1 += y[c]; }
        const float mean = wave_sum(s1) * (1.f / 512.f);
        float s2 = 0.f;
#pragma unroll
        for (int c = 0; c < 8; ++c) { y[c] -= mean; s2 += y[c] * y[c]; }
        const float rstd = rsqrtf(wave_sum(s2) * (1.f / 512.f) + LN_EPS);
        float z[8];
#pragma unroll
        for (int c = 0; c < 8; ++c) { const float v = y[c] * rstd * lgv[c] + lbv[c]; z[c] = v / (1.f + __expf(-v)); }
        v4u o; o.x = cvtpk(z[0], z[1]); o.y = cvtpk(z[2], z[3]); o.z = cvtpk(z[4], z[5]); o.w = cvtpk(z[6], z[7]);
        *(v4u*)(MIX + (rowbase + t0 + tt) * 1024 + 512 + 8 * lane) = o;
    }
}

__device__ __forceinline__ void ln1_rows4(const bf16* H, bf16* X1B, const float* g, const float* bt, int r, int lane) {
    const v4u* hr = (const v4u*)(H + (size_t)r * DM) + 2 * lane;
    v4u hv[4][2];
#pragma unroll
    for (int u = 0; u < 4; ++u) { hv[u][0] = hr[u * 128]; hv[u][1] = hr[u * 128 + 1]; }
    const f32x4* gp = (const f32x4*)g + 4 * lane; const f32x4* bp = (const f32x4*)bt + 4 * lane;
    float gv[16], bv[16];
#pragma unroll
    for (int q = 0; q < 4; ++q) { const f32x4 a = gp[q], b = bp[q]; gv[4 * q] = a.x; gv[4 * q + 1] = a.y; gv[4 * q + 2] = a.z; gv[4 * q + 3] = a.w; bv[4 * q] = b.x; bv[4 * q + 1] = b.y; bv[4 * q + 2] = b.z; bv[4 * q + 3] = b.w; }
#pragma unroll
    for (int u = 0; u < 4; ++u) {
        float v[16];
#pragma unroll
        for (int k = 0; k < 2; ++k) { const v4u a = hv[u][k];
            v[8 * k] = bflo(a.x); v[8 * k + 1] = bfhi(a.x); v[8 * k + 2] = bflo(a.y); v[8 * k + 3] = bfhi(a.y); v[8 * k + 4] = bflo(a.z); v[8 * k + 5] = bfhi(a.z); v[8 * k + 6] = bflo(a.w); v[8 * k + 7] = bfhi(a.w); }
        float s = 0.f;
#pragma unroll
        for (int i = 0; i < 16; ++i) s += v[i];
        const float mean = wave_sum(s) * (1.f / DM); float s2 = 0.f;
#pragma unroll
        for (int i = 0; i < 16; ++i) { v[i] -= mean; s2 += v[i] * v[i]; }
        const float rstd = rsqrtf(wave_sum(s2) * (1.f / DM) + LN_EPS);
        float o[16];
#pragma unroll
        for (int i = 0; i < 16; ++i) o[i] = v[i] * rstd * gv[i] + bv[i];
        v4u w0, w1;
        w0.x = cvtpk(o[0], o[1]); w0.y = cvtpk(o[2], o[3]); w0.z = cvtpk(o[4], o[5]); w0.w = cvtpk(o[6], o[7]);
        w1.x = cvtpk(o[8], o[9]); w1.y = cvtpk(o[10], o[11]); w1.z = cvtpk(o[12], o[13]); w1.w = cvtpk(o[14], o[15]);
        v4u* od = (v4u*)(X1B + (size_t)(r + u) * DM) + 2 * lane; od[0] = w0; od[1] = w1;
    }
}

__device__ __forceinline__ unsigned f2key(float f) { const unsigned u = __float_as_uint(f); return (u & 0x80000000u) ? ~u : (u | 0x80000000u); }
__device__ __forceinline__ float key2f(unsigned k) { const unsigned u = (k & 0x80000000u) ? (k & 0x7fffffffu) : ~k; return __uint_as_float(u); }
__device__ __forceinline__ unsigned umax2(unsigned a, unsigned b) { return a > b ? a : b; }
__device__ __forceinline__ unsigned umin2(unsigned a, unsigned b) { return a < b ? a : b; }

typedef short bf16x8_t __attribute__((ext_vector_type(8)));
typedef float f32x16_t __attribute__((ext_vector_type(16)));
typedef short s16x4_t __attribute__((ext_vector_type(4)));
__device__ __forceinline__ int crow(int r, int hi) { return (r & 3) + 8 * (r >> 2) + 4 * hi; }
__device__ __forceinline__ s16x4_t vtr(const LAS unsigned char* p) { return __builtin_bit_cast(s16x4_t, __builtin_amdgcn_ds_read_tr16_b64_v4i16((LAS s16x4_t*)p)); }
struct AttnArgs { const bf16* QB; const bf16* KB; const bf16* VB; const float* ck; const float* cv; const float* out; bf16* OP; float* LSE; };
__device__ __forceinline__ bf16x8_t cvt8(const f32x4 a, const f32x4 b) { const v4u u = {cvtpk(a.x, a.y), cvtpk(a.z, a.w), cvtpk(b.x, b.y), cvtpk(b.z, b.w)}; return __builtin_bit_cast(bf16x8_t, u); }
template <bool SAMP, bool FULL>
__device__ __forceinline__ void attn_mfma_task(const AttnArgs& A, int task, LAS unsigned char* vbuf, int lane) {
    int b, h, br, res, i0, nq;
    if constexpr (!SAMP) {
        const int ti = task & 127; int rest = task >> 7; br = rest % 3; rest /= 3; h = rest & 7; b = rest >> 3;
        const int sh_ = 2 * br; res = ti >> (7 - sh_); i0 = (ti & ((128 >> sh_) - 1)) * 32; nq = 32;
    } else {
        const int sub = task % 13; int rest = task / 13; h = rest & 7; b = rest >> 3;
        if (sub == 0) { br = 0; res = 0; i0 = 2048; nq = 8; } else if (sub < 5) { br = 1; res = sub - 1; i0 = 512; nq = 2; } else { br = 2; res = sub - 5; i0 = 128; nq = 1; }
    }
    const int sh = 2 * br;
    const int q = lane & 31, hi = lane >> 5;
    const size_t rowb = (size_t)b * 4096;
    auto srow = [&](const float* cache, size_t onew, int pp) -> const float* {
        const int pc = pp > 2055 ? 2055 : pp;
        return pc < LB ? cache + ((size_t)b * 2048 + pc) * 512 + h * 64 : A.out + onew + ((size_t)b * 2048 + pc - 8) * 512 + h * 64;
    };
    const int iq = i0 + (q < nq ? q : nq - 1);
    const int posq = res + (iq << sh);
    const size_t qrow = SAMP ? (size_t)NP + (size_t)b * 8 + (posq - LB) : rowb + posq;
    bf16x8_t qf[4];
    { const bf16* qp = A.QB + qrow * 512 + h * 64 + 8 * hi;
#pragma unroll
      for (int ks = 0; ks < 4; ++ks) qf[ks] = *(const bf16x8_t*)(qp + 16 * ks); }
    const int tstart = FULL ? 0 : (i0 >= 128 ? 0 : ((128 - i0) >> 5));
    const int vc = lane & 7, vr = lane >> 3;
    const int vdst = (vc >> 2) * 2048 + vr * 64 + (vc & 3) * 16;
    v4u vreg[4];
    auto loadv = [&](int t) {
#pragma unroll
        for (int i_ = 0; i_ < 4; ++i_) {
            const int j_ = i0 - 128 + 32 * t + vr + 8 * i_;
            if constexpr (!SAMP) { vreg[i_] = *(const v4u*)(A.VB + (rowb + res + ((size_t)j_ << sh)) * 512 + h * 64 + 8 * vc); }
            else { const f32x4* vp_ = (const f32x4*)(srow(A.cv, O_VS, res + (j_ << sh)) + 8 * vc); vreg[i_] = __builtin_bit_cast(v4u, cvt8(vp_[0], vp_[1])); }
        }
    };
    if (tstart == 0) loadv(0); else if (tstart == 1) loadv(1); else if (tstart == 2) loadv(2); else if (tstart == 3) loadv(3); else loadv(4);
    f32x16_t sc[5];
    float mx = -INFINITY;
    bf16x8_t kall[FULL ? 5 : 1][4];
    if constexpr (FULL) {
#pragma unroll
        for (int t = 0; t < 5; ++t) {
            const int j = i0 - 128 + 32 * t + q;
            if constexpr (!SAMP) {
                const bf16* kp = A.KB + (rowb + res + ((size_t)j << sh)) * 512 + h * 64 + 8 * hi;
#pragma unroll
                for (int ks = 0; ks < 4; ++ks) kall[t][ks] = *(const bf16x8_t*)(kp + 16 * ks);
            } else {
                const f32x4* kp = (const f32x4*)(srow(A.ck, O_KS, res + (j << sh)) + 8 * hi);
#pragma unroll
                for (int ks = 0; ks < 4; ++ks) kall[t][ks] = cvt8(kp[4 * ks], kp[4 * ks + 1]);
            }
        }
        __builtin_amdgcn_sched_barrier(0);
    }
#pragma unroll
    for (int t = 0; t < 5; ++t) {
        if (t >= tstart) {
            const int j = i0 - 128 + 32 * t + q;
            bf16x8_t kf[4];
            if constexpr (FULL) {
#pragma unroll
                for (int ks = 0; ks < 4; ++ks) kf[ks] = kall[t][ks];
            } else if constexpr (!SAMP) {
                const bf16* kp = A.KB + (rowb + res + ((size_t)j << sh)) * 512 + h * 64 + 8 * hi;
#pragma unroll
                for (int ks = 0; ks < 4; ++ks) kf[ks] = *(const bf16x8_t*)(kp + 16 * ks);
            } else {
                const f32x4* kp = (const f32x4*)(srow(A.ck, O_KS, res + (j << sh)) + 8 * hi);
#pragma unroll
                for (int ks = 0; ks < 4; ++ks) kf[ks] = cvt8(kp[4 * ks], kp[4 * ks + 1]);
            }
            f32x16_t a = {0.f, 0.f, 0.f, 0.f, 0.f, 0.f, 0.f, 0.f, 0.f, 0.f, 0.f, 0.f, 0.f, 0.f, 0.f, 0.f};
#pragma unroll
            for (int ks = 0; ks < 4; ++ks) a = __builtin_amdgcn_mfma_f32_32x32x16_bf16(kf[ks], qf[ks], a, 0, 0, 0);
#pragma unroll
            for (int r = 0; r < 16; ++r) {
                float v = a[r] * 0.125f;
                if (t == 0) { if (crow(r, hi) < q) v = -INFINITY; }
                if (t == 4) { if (crow(r, hi) > q) v = -INFINITY; }
                a[r] = v; mx = fmaxf(mx, v);
            }
            sc[t] = a;
        } else {
#pragma unroll
            for (int r = 0; r < 16; ++r) sc[t][r] = -INFINITY;
        }
    }
    mx = fmaxf(mx, __shfl_xor(mx, 32));
    float l = 0.f;
#pragma unroll
    for (int t = 0; t < 5; ++t)
#pragma unroll
        for (int r = 0; r < 16; ++r) { const float pv = __expf(sc[t][r] - mx); sc[t][r] = pv; l += pv; }
    l += __shfl_xor(l, 32);
    f32x16_t o0 = {0.f, 0.f, 0.f, 0.f, 0.f, 0.f, 0.f, 0.f, 0.f, 0.f, 0.f, 0.f, 0.f, 0.f, 0.f, 0.f}, o1 = o0;
    const int vb = ((lane >> 4) & 1) * 32 + (lane & 3) * 8 + (4 * hi + ((lane & 15) >> 2)) * 64;
#pragma unroll
    for (int t = 0; t < 5; ++t) {
        if (t >= tstart) {
            LAS unsigned char* buf = vbuf + (t & 1) * 4096;
#pragma unroll
            for (int i = 0; i < 4; ++i) *(LAS v4u*)(buf + vdst + i * 512) = vreg[i];
            if (t < 4) loadv(t + 1);
            LDS_WAIT();
            unsigned pw_[8];
#pragma unroll
            for (int k = 0; k < 8; ++k) pw_[k] = cvtpk(sc[t][2 * k], sc[t][2 * k + 1]);
            const v4u pa0u = {pw_[0], pw_[1], pw_[2], pw_[3]}, pa1u = {pw_[4], pw_[5], pw_[6], pw_[7]};
            const bf16x8_t pa0 = __builtin_bit_cast(bf16x8_t, pa0u), pa1 = __builtin_bit_cast(bf16x8_t, pa1u);
            const LAS unsigned char* vp = buf + vb;
            s16x4_t lo, hh;
#define ATT_VFR() (bf16x8_t){lo[0], lo[1], lo[2], lo[3], hh[0], hh[1], hh[2], hh[3]}
            lo = vtr(vp);               hh = vtr(vp + 512);         o0 = __builtin_amdgcn_mfma_f32_32x32x16_bf16(pa0, ATT_VFR(), o0, 0, 0, 0);
            lo = vtr(vp + 1024);        hh = vtr(vp + 1024 + 512);  o0 = __builtin_amdgcn_mfma_f32_32x32x16_bf16(pa1, ATT_VFR(), o0, 0, 0, 0);
            lo = vtr(vp + 2048);        hh = vtr(vp + 2048 + 512);  o1 = __builtin_amdgcn_mfma_f32_32x32x16_bf16(pa0, ATT_VFR(), o1, 0, 0, 0);
            lo = vtr(vp + 3072);        hh = vtr(vp + 3072 + 512);  o1 = __builtin_amdgcn_mfma_f32_32x32x16_bf16(pa1, ATT_VFR(), o1, 0, 0, 0);
#undef ATT_VFR
            LDS_WAIT();
        }
    }
    const float rl = 1.f / l;
#pragma unroll
    for (int r = 0; r < 16; ++r) {
        const int qq = crow(r, hi);
        const float ri = __shfl(rl, qq);
        const int pp = res + ((i0 + qq) << sh);
        const size_t orow_ = SAMP ? (size_t)NP + (size_t)b * 8 + (pp - LB) : rowb + pp;
        if (qq < nq) {
            bf16* orow = A.OP + ((size_t)br * NTOK + orow_) * 512 + h * 64 + q;
            orow[0] = (bf16)(cvtpk(o0[r] * ri, 0.f) & 0xffffu);
            orow[32] = (bf16)(cvtpk(o1[r] * ri, 0.f) & 0xffffu);
        }
    }
    if (hi == 0 && q < nq) A.LSE[((size_t)br * NTOK + qrow) * 8 + h] = mx + __logf(l);
}
constexpr int ATT_KIMG = 0, ATT_VIMG = 49152, ATT_VPLANE = 24576, ATT_OTILE = 98304;
__device__ __forceinline__ void attn_block_phase(const AttnArgs& A, LAS unsigned char* lds, int G, int tid, int wave, int lane) {
    constexpr int NUNIT = NPB * NH * 3 * 16;
    asm volatile("" : "+v"(lane));
    const int q = lane & 31, hi = lane >> 5;
    const int srow0 = wave * 8 + (lane >> 3), sch = lane & 7;
    v4u pk_[6], pv_[6];
    auto decode = [&](int unit, int& b, int& h, int& br, int& res, int& i0u) {
        const int uu = unit & 15; int rest = unit >> 4; br = rest % 3; rest /= 3; h = rest & 7; b = rest >> 3;
        const int sh_ = 2 * br, upr = 16 >> sh_; res = uu / upr; i0u = (uu % upr) * 256;
    };
    auto request = [&](int unit) {
        int b, h, br, res, i0u; decode(unit, b, h, br, res, i0u); const int sh = 2 * br; const size_t rowb = (size_t)b * 4096;
#pragma unroll
        for (int p_ = 0; p_ < 6; ++p_) {
            const int row = srow0 + 64 * p_, j = i0u - 128 + row;
            if (j >= 0) { const size_t o = (rowb + res + ((size_t)j << sh)) * 512 + h * 64 + 8 * sch; pk_[p_] = *(const v4u*)(A.KB + o); pv_[p_] = *(const v4u*)(A.VB + o); }
        }
    };
    auto commit = [&](int unit) {
        int b, h, br, res, i0u; decode(unit, b, h, br, res, i0u);
#pragma unroll
        for (int p_ = 0; p_ < 6; ++p_) {
            const int row = srow0 + 64 * p_, j = i0u - 128 + row;
            if (j >= 0) {
                *(LAS v4u*)(lds + ATT_KIMG + row * 128 + ((sch ^ (row & 7)) << 4)) = pk_[p_];
                *(LAS v4u*)(lds + ATT_VIMG + (sch >> 2) * ATT_VPLANE + row * 64 + (sch & 3) * 16) = pv_[p_];
            }
        }
    };
    int unit = (int)blockIdx.x;
    if (unit < NUNIT) request(unit);
    bf16x8_t qf[4];
    auto request_q = [&](int u_) {
        int b, h, br, res, i0u; decode(u_, b, h, br, res, i0u); const int sh = 2 * br; const size_t rowb = (size_t)b * 4096;
        const bf16* qp = A.QB + (rowb + res + ((size_t)(i0u + 32 * wave + q) << sh)) * 512 + h * 64 + 8 * hi;
#pragma unroll
        for (int ks = 0; ks < 4; ++ks) qf[ks] = *(const bf16x8_t*)(qp + 16 * ks);
    };
    if (unit < NUNIT) request_q(unit);
    constexpr float SC2 = 0.125f * 1.4426950408889634f;
    for (; unit < NUNIT; unit += G) {
        int b, h, br, res, i0u; decode(unit, b, h, br, res, i0u); const int sh = 2 * br; const size_t rowb = (size_t)b * 4096;
        __syncthreads();
        commit(unit);
        __syncthreads();
        if (unit + G < NUNIT) request(unit + G);
        const int i0 = i0u + 32 * wave;
        const int tstart = i0 >= 128 ? 0 : ((128 - i0) >> 5);
        f32x16_t sc[5]; float mx = -INFINITY;
#pragma unroll
        for (int t = 0; t < 5; ++t) {
            if (t >= tstart) {
                const int row = 32 * (wave + t) + q;
                bf16x8_t kf[4];
#pragma unroll
                for (int ks = 0; ks < 4; ++ks) kf[ks] = *(const LAS bf16x8_t*)(lds + ATT_KIMG + row * 128 + (((2 * ks + hi) ^ (row & 7)) << 4));
                f32x16_t a = {0.f, 0.f, 0.f, 0.f, 0.f, 0.f, 0.f, 0.f, 0.f, 0.f, 0.f, 0.f, 0.f, 0.f, 0.f, 0.f};
#pragma unroll
                for (int ks = 0; ks < 4; ++ks) a = __builtin_amdgcn_mfma_f32_32x32x16_bf16(kf[ks], qf[ks], a, 0, 0, 0);
#pragma unroll
                for (int r = 0; r < 16; ++r) {
                    float v = a[r];
                    if (t == 0) { if (crow(r, hi) < q) v = -INFINITY; }
                    if (t == 4) { if (crow(r, hi) > q) v = -INFINITY; }
                    a[r] = v; mx = fmaxf(mx, v);
                }
                sc[t] = a;
            } else {
#pragma unroll
                for (int r = 0; r < 16; ++r) sc[t][r] = -INFINITY;
            }
        }
        if (unit + G < NUNIT) request_q(unit + G);
        mx = fmaxf(mx, __shfl_xor(mx, 32));
        const float mb = mx * SC2;
        float l = 0.f;
        unsigned pkp[5][8];
#pragma unroll
        for (int t = 0; t < 5; ++t)
#pragma unroll
            for (int k = 0; k < 8; ++k) { const float p0 = __builtin_amdgcn_exp2f(fmaf(sc[t][2 * k], SC2, -mb)), p1 = __builtin_amdgcn_exp2f(fmaf(sc[t][2 * k + 1], SC2, -mb)); l += p0 + p1; pkp[t][k] = cvtpk(p0, p1); }
        l += __shfl_xor(l, 32);
        f32x16_t o0 = {0.f, 0.f, 0.f, 0.f, 0.f, 0.f, 0.f, 0.f, 0.f, 0.f, 0.f, 0.f, 0.f, 0.f, 0.f, 0.f}, o1 = o0;
        const int vb = ((lane >> 4) & 1) * 32 + (lane & 3) * 8 + (4 * hi + ((lane & 15) >> 2)) * 64;
#pragma unroll
        for (int t = 0; t < 5; ++t) {
            if (t >= tstart) {
                const v4u pa0u = {pkp[t][0], pkp[t][1], pkp[t][2], pkp[t][3]}, pa1u = {pkp[t][4], pkp[t][5], pkp[t][6], pkp[t][7]};
                const bf16x8_t pa0 = __builtin_bit_cast(bf16x8_t, pa0u), pa1 = __builtin_bit_cast(bf16x8_t, pa1u);
                const LAS unsigned char* vp = lds + ATT_VIMG + 32 * (wave + t) * 64 + vb;
                s16x4_t lo, hh;
#define ATT_VFR() (bf16x8_t){lo[0], lo[1], lo[2], lo[3], hh[0], hh[1], hh[2], hh[3]}
                lo = vtr(vp);                      hh = vtr(vp + 512);                      o0 = __builtin_amdgcn_mfma_f32_32x32x16_bf16(ATT_VFR(), pa0, o0, 0, 0, 0);
                lo = vtr(vp + 1024);               hh = vtr(vp + 1024 + 512);               o0 = __builtin_amdgcn_mfma_f32_32x32x16_bf16(ATT_VFR(), pa1, o0, 0, 0, 0);
                lo = vtr(vp + ATT_VPLANE);         hh = vtr(vp + ATT_VPLANE + 512);         o1 = __builtin_amdgcn_mfma_f32_32x32x16_bf16(ATT_VFR(), pa0, o1, 0, 0, 0);
                lo = vtr(vp + ATT_VPLANE + 1024);  hh = vtr(vp + ATT_VPLANE + 1024 + 512);  o1 = __builtin_amdgcn_mfma_f32_32x32x16_bf16(ATT_VFR(), pa1, o1, 0, 0, 0);
#undef ATT_VFR
            }
        }
        const float rl = 1.f / l;
        const size_t orow_ = rowb + res + ((size_t)(i0 + q) << sh);
        {
            LAS unsigned char* ot = lds + ATT_OTILE + wave * 4096;
            const int fq_ = (q >> 1) & 7;
#pragma unroll
            for (int g = 0; g < 4; ++g) {
                v2u w0, w1;
                w0.x = cvtpk(o0[4 * g] * rl, o0[4 * g + 1] * rl); w0.y = cvtpk(o0[4 * g + 2] * rl, o0[4 * g + 3] * rl);
                w1.x = cvtpk(o1[4 * g] * rl, o1[4 * g + 1] * rl); w1.y = cvtpk(o1[4 * g + 2] * rl, o1[4 * g + 3] * rl);
                *(LAS v2u*)(ot + q * 128 + ((g ^ fq_) << 4) + 8 * hi) = w0;
                *(LAS v2u*)(ot + q * 128 + (((4 + g) ^ fq_) << 4) + 8 * hi) = w1;
            }
            LDS_WAIT();
#pragma unroll
            for (int i = 0; i < 4; ++i) {
                const int r = 8 * i + (lane >> 3), c = lane & 7;
                const v4u w = *(const LAS v4u*)(ot + r * 128 + ((c ^ ((r >> 1) & 7)) << 4));
                *(v4u*)(A.OP + ((size_t)br * NTOK + rowb + res + ((size_t)(i0 + r) << sh)) * 512 + h * 64 + 8 * c) = w;
            }
            LDS_WAIT();
        }
        if (hi == 0) A.LSE[((size_t)br * NTOK + orow_) * 8 + h] = mx * 0.125f + __logf(l);
    }
}
__device__ __forceinline__ void attn_merge_row(const bf16* OP, const float* LSE, bf16* MIX, int r, int lane) {
    const int h = lane >> 3;
    const float l0 = LSE[((size_t)0 * NTOK + r) * 8 + h], l1 = LSE[((size_t)1 * NTOK + r) * 8 + h], l2 = LSE[((size_t)2 * NTOK + r) * 8 + h];
    const float m = fmaxf(l0, fmaxf(l1, l2));
    float w0 = __expf(l0 - m), w1 = __expf(l1 - m), w2 = __expf(l2 - m);
    const float inv = 1.f / (w0 + w1 + w2); w0 *= inv; w1 *= inv; w2 *= inv;
    const v4u a = *(const v4u*)(OP + ((size_t)0 * NTOK + r) * 512 + 8 * lane), bq = *(const v4u*)(OP + ((size_t)1 * NTOK + r) * 512 + 8 * lane), c = *(const v4u*)(OP + ((size_t)2 * NTOK + r) * 512 + 8 * lane);
    v4u o;
    o.x = cvtpk(w0 * bflo(a.x) + w1 * bflo(bq.x) + w2 * bflo(c.x), w0 * bfhi(a.x) + w1 * bfhi(bq.x) + w2 * bfhi(c.x));
    o.y = cvtpk(w0 * bflo(a.y) + w1 * bflo(bq.y) + w2 * bflo(c.y), w0 * bfhi(a.y) + w1 * bfhi(bq.y) + w2 * bfhi(c.y));
    o.z = cvtpk(w0 * bflo(a.z) + w1 * bflo(bq.z) + w2 * bflo(c.z), w0 * bfhi(a.z) + w1 * bfhi(bq.z) + w2 * bfhi(c.z));
    o.w = cvtpk(w0 * bflo(a.w) + w1 * bflo(bq.w) + w2 * bflo(c.w), w0 * bfhi(a.w) + w1 * bfhi(bq.w) + w2 * bfhi(c.w));
    *(v4u*)(MIX + (size_t)r * 1024 + 8 * lane) = o;
}

__device__ __forceinline__ void cswap(unsigned& a, unsigned& b) { const unsigned hi_ = a > b ? a : b, lo_ = a > b ? b : a; a = hi_; b = lo_; }
__device__ __forceinline__ void sort16_desc(unsigned (&x)[16]) {
#pragma unroll
    for (int k = 2; k <= 16; k <<= 1)
#pragma unroll
        for (int j = k >> 1; j > 0; j >>= 1)
#pragma unroll
            for (int i = 0; i < 16; ++i) { const int l = i ^ j; if (l > i) { if ((i & k) == 0) cswap(x[i], x[l]); else cswap(x[l], x[i]); } }
}
__device__ __forceinline__ void merge16_desc(unsigned (&a)[16], const unsigned (&b)[16]) {
#pragma unroll
    for (int i = 0; i < 16; ++i) a[i] = umax2(a[i], b[15 - i]);
#pragma unroll
    for (int j = 8; j > 0; j >>= 1)
#pragma unroll
        for (int i = 0; i < 16; ++i) { const int l = i ^ j; if (l > i) cswap(a[i], a[l]); }
}
__device__ __forceinline__ void pair_merge16(unsigned (&a)[16]) {
    unsigned pb[16];
#pragma unroll
    for (int i = 0; i < 16; ++i) pb[i] = (unsigned)__shfl_xor((int)a[i], 32);
    merge16_desc(a, pb);
}
struct CacheCopy { const f32x4* ck; const f32x4* cv; f32x4* ok; f32x4* ov; };
__device__ __forceinline__ void top16_of_half(const bf16* PQ, const LAS unsigned char* skl, int token0, int h, int p, int lane, unsigned (&top)[16], const CacheCopy& cc, int slot0) {
    const int tok = lane & 31, hi = lane >> 5;
    const bf16* qp = PQ + (size_t)(token0 + tok) * PQD + h * 256 + p * 128 + 8 * hi;
    bf16x8_t bq[8];
#pragma unroll
    for (int ks = 0; ks < 8; ++ks) bq[ks] = *(const bf16x8_t*)(qp + 16 * ks);
    unsigned g0[16];
    constexpr long CPB = 2040L * 128, CTOT = NSB * CPB;
    int ci[2]; f32x4 ca[2], cb[2];
#pragma unroll 1
    for (int kt = 0; kt < 4; ++kt) {
        if (kt > 0) {
#pragma unroll
            for (int u = 0; u < 2; ++u) { cc.ok[ci[u]] = ca[u]; cc.ov[ci[u]] = cb[u]; }
        }
#pragma unroll
        for (int u = 0; u < 2; ++u) {
            int idx = (slot0 + kt) * 128 + lane + 64 * u; if (idx >= (int)CTOT) idx = (int)CTOT - 1;
            const int b = idx / (int)CPB, rem = idx - b * (int)CPB; ci[u] = b * 2048 * 128 + rem; ca[u] = cc.ck[ci[u] + 8 * 128]; cb[u] = cc.cv[ci[u] + 8 * 128];
        }
        f32x16_t a = {0.f, 0.f, 0.f, 0.f, 0.f, 0.f, 0.f, 0.f, 0.f, 0.f, 0.f, 0.f, 0.f, 0.f, 0.f, 0.f};
#pragma unroll
        for (int ks = 0; ks < 8; ++ks) { const int row = p * 128 + 32 * kt + tok; const bf16x8_t ka = *(const LAS bf16x8_t*)(skl + row * 256 + (((2 * ks + hi) ^ (row & 15)) << 4)); a = __builtin_amdgcn_mfma_f32_32x32x16_bf16(ka, bq[ks], a, 0, 0, 0); }
        unsigned x[16];
#pragma unroll
        for (int r = 0; r < 16; ++r) x[r] = (f2key(a[r]) & ~127u) | (unsigned)(32 * kt + crow(r, hi));
        sort16_desc(x);
        if (kt == 0) {
#pragma unroll
            for (int i = 0; i < 16; ++i) g0[i] = x[i];
        } else { merge16_desc(g0, x); }
    }
    pair_merge16(g0);
#pragma unroll
    for (int u = 0; u < 2; ++u) { cc.ok[ci[u]] = ca[u]; cc.ov[ci[u]] = cb[u]; }
#pragma unroll
    for (int i = 0; i < 16; ++i) top[i] = g0[i];
}
__device__ __forceinline__ void topk_mfma_task(const bf16* PQ, const LAS unsigned char* skl, int* IDX, float* GATE, int tile, int h, int lane, const CacheCopy& cc) {
    const int token0 = tile * 32;
    const int tok = lane & 31, hi = lane >> 5;
    unsigned t0[16], t1[16];
    const int slot0 = (tile * 8 + h) * 8;
    top16_of_half(PQ, skl, token0, h, 0, lane, t0, cc, slot0);
    top16_of_half(PQ, skl, token0, h, 1, lane, t1, cc, slot0 + 4);
    float v0[16], v1[16];
#pragma unroll
    for (int i = 0; i < 16; ++i) { v0[i] = key2f(t0[i] & ~127u); v1[i] = key2f(t1[i] & ~127u); }
    unsigned ca[16], cb[16];
#define CAND(dst, i0_, j0_, i1_, j1_, pad1) do { const float a_ = hi ? v0[i1_] : v0[i0_], b_ = hi ? v1[j1_] : v1[j0_]; \
        const unsigned pa_ = hi ? (t0[i1_] & 127u) : (t0[i0_] & 127u), pb_ = hi ? (t1[j1_] & 127u) : (t1[j0_] & 127u); \
        const unsigned fx_ = umin2((unsigned)fmaxf(fmaf(a_ + b_, 4096.f, 131072.5f), 0.f), 262143u);     \
        const unsigned k_ = (fx_ << 14) | (pa_ << 7) | pb_; dst = ((pad1) && hi) ? 0u : k_; } while (0)
    CAND(ca[0], 0, 0, 1, 0, 0);  CAND(ca[1], 0, 1, 1, 1, 0);  CAND(ca[2], 0, 2, 1, 2, 0);  CAND(ca[3], 0, 3, 1, 3, 0);
    CAND(ca[4], 0, 4, 1, 4, 0);  CAND(ca[5], 0, 5, 1, 5, 0);  CAND(ca[6], 0, 6, 1, 6, 0);  CAND(ca[7], 0, 7, 1, 7, 0);
    CAND(ca[8], 0, 8, 3, 0, 0);  CAND(ca[9], 0, 9, 3, 1, 0);  CAND(ca[10], 0, 10, 3, 2, 0); CAND(ca[11], 0, 11, 3, 3, 0);
    CAND(ca[12], 0, 12, 5, 0, 0); CAND(ca[13], 0, 13, 5, 1, 0); CAND(ca[14], 0, 14, 6, 0, 0); CAND(ca[15], 0, 15, 6, 1, 0);
    CAND(cb[0], 2, 0, 7, 0, 0);  CAND(cb[1], 2, 1, 7, 1, 0);  CAND(cb[2], 2, 2, 0, 0, 1);  CAND(cb[3], 2, 3, 0, 0, 1);
    CAND(cb[4], 2, 4, 0, 0, 1);  CAND(cb[5], 4, 0, 0, 0, 1);  CAND(cb[6], 4, 1, 0, 0, 1);  CAND(cb[7], 4, 2, 0, 0, 1);
    CAND(cb[8], 8, 0, 0, 0, 1);  CAND(cb[9], 9, 0, 0, 0, 1);  CAND(cb[10], 10, 0, 0, 0, 1); CAND(cb[11], 11, 0, 0, 0, 1);
    CAND(cb[12], 12, 0, 0, 0, 1); CAND(cb[13], 13, 0, 0, 0, 1); CAND(cb[14], 14, 0, 0, 0, 1); CAND(cb[15], 15, 0, 0, 0, 1);
#undef CAND
    sort16_desc(ca); sort16_desc(cb);
    merge16_desc(ca, cb);
    pair_merge16(ca);
    float g[16]; float sum = 0.f;
    const float gm = (float)(ca[0] >> 14);
#pragma unroll
    for (int k = 0; k < 16; ++k) { g[k] = __expf(((float)(ca[k] >> 14) - gm) * (1.f / 4096.f)); sum += g[k]; }
    const float inv = 1.f / sum;
    v4u e0, e1; f32x4 g0, g1;
    e0.x = (hi ? ca[8] : ca[0]) & 0x3fffu; e0.y = (hi ? ca[9] : ca[1]) & 0x3fffu; e0.z = (hi ? ca[10] : ca[2]) & 0x3fffu; e0.w = (hi ? ca[11] : ca[3]) & 0x3fffu;
    e1.x = (hi ? ca[12] : ca[4]) & 0x3fffu; e1.y = (hi ? ca[13] : ca[5]) & 0x3fffu; e1.z = (hi ? ca[14] : ca[6]) & 0x3fffu; e1.w = (hi ? ca[15] : ca[7]) & 0x3fffu;
    g0.x = (hi ? g[8] : g[0]) * inv; g0.y = (hi ? g[9] : g[1]) * inv; g0.z = (hi ? g[10] : g[2]) * inv; g0.w = (hi ? g[11] : g[3]) * inv;
    g1.x = (hi ? g[12] : g[4]) * inv; g1.y = (hi ? g[13] : g[5]) * inv; g1.z = (hi ? g[14] : g[6]) * inv; g1.w = (hi ? g[15] : g[7]) * inv;
    const size_t o = (size_t)(token0 + tok) * 128 + h * 16 + 8 * hi;
    *(v4u*)(IDX + o) = e0; *(v4u*)(IDX + o + 4) = e1;
    *(f32x4*)(GATE + o) = g0; *(f32x4*)(GATE + o + 4) = g1;
}

__device__ __forceinline__ float gelu_erf(float x) { return 0.5f * x * (1.f + erff(x * 0.70710678118654752f)); }
__device__ __forceinline__ int rdlane_i(int v, int l) { return __builtin_amdgcn_readlane(v, l); }
__device__ __forceinline__ float rdlane_f(float v, int l) { return __int_as_float(__builtin_amdgcn_readlane(__float_as_int(v), l)); }
__device__ __forceinline__ void peer_finish_token6(f32x2_t (&acc2)[16], const bf16* X1B, const float* g2, const float* b2, float* Y, int r, int lane) {
    const int lp = lane & 31, hf = lane >> 5;
    float acc[32];
#pragma unroll
    for (int i = 0; i < 16; ++i) { acc[2 * i] = acc2[i].x; acc[2 * i + 1] = acc2[i].y; }
#pragma unroll
    for (int i = 0; i < 32; ++i) acc[i] += __shfl_xor(acc[i], 32);
    const v4u* hp = (const v4u*)(X1B + (size_t)r * DM) + 4 * lp;
    float z[32];
#pragma unroll
    for (int k = 0; k < 4; ++k) { const v4u a = hp[k];
        z[8 * k + 0] = bflo(a.x); z[8 * k + 1] = bfhi(a.x); z[8 * k + 2] = bflo(a.y); z[8 * k + 3] = bfhi(a.y); z[8 * k + 4] = bflo(a.z); z[8 * k + 5] = bfhi(a.z); z[8 * k + 6] = bflo(a.w); z[8 * k + 7] = bfhi(a.w); }
    float s = 0.f;
#pragma unroll
    for (int i = 0; i < 32; ++i) { z[i] = ALPHA * z[i] + acc[i]; s += z[i]; }
    const float mean = wave_sum(s) * (0.5f / DM); float s2 = 0.f;
#pragma unroll
    for (int i = 0; i < 32; ++i) { z[i] -= mean; s2 += z[i] * z[i]; }
    const float rstd = rsqrtf(wave_sum(s2) * (0.5f / DM) + LN_EPS);
    const int c0 = 32 * lp + 16 * hf;
    const f32x4* gp = (const f32x4*)(g2 + c0); const f32x4* bp = (const f32x4*)(b2 + c0);
    f32x4* yp = (f32x4*)(Y + (size_t)r * DM + c0);
#pragma unroll
    for (int q = 0; q < 4; ++q) {
        const f32x4 gv = gp[q], bv = bp[q];
        f32x4 o;
        o.x = (hf ? z[16 + 4 * q] : z[4 * q]) * rstd * gv.x + bv.x; o.y = (hf ? z[16 + 4 * q + 1] : z[4 * q + 1]) * rstd * gv.y + bv.y;
        o.z = (hf ? z[16 + 4 * q + 2] : z[4 * q + 2]) * rstd * gv.z + bv.z; o.w = (hf ? z[16 + 4 * q + 3] : z[4 * q + 3]) * rstd * gv.w + bv.w;
        yp[q] = o;
    }
}
__device__ __forceinline__ void peer_phase6(const bf16* X1B, const int* IDX, const float* GATE, const unsigned char* EU6, const unsigned char* EV6, const float* SU, const float* SV,
                                            const float* g2, const float* b2, float* Y, int gw, int NGW, int lane, LAS unsigned char* wl, LAS unsigned char* lds0, int wave, int nblk) {
    constexpr int TT = 2;
    LAS unsigned char* xl = wl;
    LAS v2u* Q = (LAS v2u*)(wl + TT * 4096);
    const __amdgpu_buffer_rsrc_t rsu = __builtin_amdgcn_make_buffer_rsrc((void*)EU6, 0, 16384 * 768, 0x00020000);
    const __amdgpu_buffer_rsrc_t rsv = __builtin_amdgcn_make_buffer_rsrc((void*)EV6, 0, 16384 * 768, 0x00020000);
    const int full = NTOK / (TT * NGW);
#define P6_XSTORE(BASE, A, B) do { LAS f32x4* xd_ = (LAS f32x4*)(BASE) + (4 * (lane & 1)) * 32 + (lane >> 1); \
        f32x4 f_; f_.x = bflo(A.x); f_.y = bfhi(A.x); f_.z = bflo(A.y); f_.w = bfhi(A.y); xd_[0] = f_; \
        f_.x = bflo(A.z); f_.y = bfhi(A.z); f_.z = bflo(A.w); f_.w = bfhi(A.w); xd_[32] = f_; \
        f_.x = bflo(B.x); f_.y = bfhi(B.x); f_.z = bflo(B.y); f_.w = bfhi(B.y); xd_[64] = f_; \
        f_.x = bflo(B.z); f_.y = bfhi(B.z); f_.z = bflo(B.w); f_.w = bfhi(B.w); xd_[96] = f_; } while (0)
#pragma unroll 1
    for (int pass = 0; pass < full; ++pass) {
        asm volatile("" : "+v"(lane));
        const int lp = lane & 31, hf = lane >> 5; const int voff24 = lp * 24;
        const int tok0 = (pass * NGW + gw) * TT; constexpr int T = TT;
        int e[2 * TT]; float g[2 * TT];
#pragma unroll
        for (int t = 0; t < TT; ++t) {
            if (t < T) {
                const size_t o = (size_t)(tok0 + t) * 128;
                e[2 * t] = IDX[o + lane]; e[2 * t + 1] = IDX[o + 64 + lane]; g[2 * t] = GATE[o + lane]; g[2 * t + 1] = GATE[o + 64 + lane];
                const v4u* xp = (const v4u*)(X1B + (size_t)(tok0 + t) * DM) + 2 * lane; const v4u a = xp[0], b = xp[1];
                P6_XSTORE(xl + t * 4096, a, b);
            } else { e[2 * t] = 1 << 20; e[2 * t + 1] = 1 << 20; g[2 * t] = 0.f; g[2 * t + 1] = 0.f; }
        }
        int pos[2 * TT];
#pragma unroll
        for (int r = 0; r < 2 * TT; ++r) pos[r] = 0;
        unsigned base[TT];
#pragma unroll
        for (int t = 0; t < TT; ++t) base[t] = 0u;
#pragma unroll 1
        for (int sl = 0; sl < 64; ++sl) {
#pragma unroll
            for (int r = 0; r < 2 * TT; ++r) {
                const bool hit = (e[r] >> 8) == sl;
                const unsigned long long m = __ballot(hit);
                const unsigned below = __builtin_amdgcn_mbcnt_hi((unsigned)(m >> 32), __builtin_amdgcn_mbcnt_lo((unsigned)m, 0u));
                if (hit) pos[r] = (int)(base[r >> 1] + below);
                base[r >> 1] += (unsigned)__popcll(m);
            }
        }
#pragma unroll
        for (int r = 0; r < 2 * TT; ++r) if ((e[r] >> 8) < 64) { v2u ent; ent.x = (unsigned)e[r]; ent.y = __float_as_uint(g[r]); Q[(r >> 1) * 128 + pos[r]] = ent; }
        LDS_WAIT();
        f32x2_t acc0[16], acc1[16];
#pragma unroll
        for (int i = 0; i < 16; ++i) { acc0[i] = (f32x2_t){0.f, 0.f}; acc1[i] = (f32x2_t){0.f, 0.f}; }
        v4u ub[4], vb[4]; v2u ub2[4], vb2[4];
        float gA, suA, svA;
#define P6_FETCH(QOFF) do { \
            const v2u ql_ = Q[(QOFF) + 2 * (lane & 3) + hf]; const int el_ = (int)ql_.x; gA = __uint_as_float(ql_.y); \
            _Pragma("unroll") for (int s_ = 0; s_ < 4; ++s_) { \
                const int ea_ = __builtin_amdgcn_readfirstlane((int)Q[(QOFF) + 2 * s_].x), eb_ = __builtin_amdgcn_readfirstlane((int)Q[(QOFF) + 2 * s_ + 1].x); \
                const int vo_ = (hf ? eb_ : ea_) * 768 + voff24; \
                ub[s_] = __builtin_amdgcn_raw_buffer_load_b128(rsu, vo_, 0, 0); ub2[s_] = __builtin_amdgcn_raw_buffer_load_b64(rsu, vo_ + 16, 0, 0); \
                vb[s_] = __builtin_amdgcn_raw_buffer_load_b128(rsv, vo_, 0, 0); vb2[s_] = __builtin_amdgcn_raw_buffer_load_b64(rsv, vo_ + 16, 0, 0); } \
            suA = SU[el_]; svA = SV[el_]; } while (0)
#define P6_CVT(RA, RB) __builtin_amdgcn_cvt_scalef32_pk32_f32_fp6((v6i_t){(int)RA.x, (int)RA.y, (int)RA.z, (int)RA.w, (int)RB.x, (int)RB.y}, 1.0f)
#define P6_MATH(TI, ACC) do { \
            f32x4 xq_[8]; \
            { const LAS f32x4* xp_ = (const LAS f32x4*)(xl + (TI) * 4096) + lp; \
              _Pragma("unroll") for (int k_ = 0; k_ < 8; ++k_) xq_[k_] = xp_[32 * k_]; } \
            float part[4]; \
            _Pragma("unroll") for (int s_ = 0; s_ < 4; ++s_) { const v32f_t uf_ = P6_CVT(ub[s_], ub2[s_]); f32x2_t d01_ = {0.f, 0.f}, d23_ = {0.f, 0.f}; \
                _Pragma("unroll") for (int k_ = 0; k_ < 8; ++k_) { \
                    d01_ = __builtin_elementwise_fma((f32x2_t){uf_[4 * k_], uf_[4 * k_ + 1]}, (f32x2_t){xq_[k_].x, xq_[k_].y}, d01_); \
                    d23_ = __builtin_elementwise_fma((f32x2_t){uf_[4 * k_ + 2], uf_[4 * k_ + 3]}, (f32x2_t){xq_[k_].z, xq_[k_].w}, d23_); } \
                part[s_] = (d01_.x + d01_.y) + (d23_.x + d23_.y); } \
            _Pragma("unroll") for (int off_ = 2; off_ >= 1; off_ >>= 1) { const bool up_ = (lane & off_) != 0; \
                _Pragma("unroll") for (int i_ = 0; i_ < off_; ++i_) { float pa_ = part[i_], pb_ = part[i_ + off_]; asm("" : "+v"(pa_), "+v"(pb_)); const float keep_ = up_ ? pb_ : pa_; const float send_ = up_ ? pa_ : pb_; part[i_] = keep_ + __shfl_xor(send_, off_); } } \
            float tot_ = part[0]; tot_ += __shfl_xor(tot_, 4); tot_ += __shfl_xor(tot_, 8); tot_ += __shfl_xor(tot_, 16);         \
            const float coefv_ = gA * svA * gelu_erf(suA * tot_); \
            _Pragma("unroll") for (int s_ = 0; s_ < 4; ++s_) { const float cf_ = __shfl(coefv_, (lane & 32) | s_); const f32x2_t cf2_ = {cf_, cf_}; const v32f_t vf_ = P6_CVT(vb[s_], vb2[s_]); \
                _Pragma("unroll") for (int i_ = 0; i_ < 16; ++i_) ACC[i_] = __builtin_elementwise_fma((f32x2_t){vf_[2 * i_], vf_[2 * i_ + 1]}, cf2_, ACC[i_]); } \
        } while (0)
#define P6_SB() __builtin_amdgcn_sched_barrier(0)
#define P6_ROUND(TI, ACC, QNEXT) do { \
            int von_[4]; \
            const v2u qn_ = Q[(QNEXT) + 2 * (lane & 3) + hf]; \
            _Pragma("unroll") for (int s_ = 0; s_ < 4; ++s_) { \
                const int ea_ = __builtin_amdgcn_readfirstlane((int)Q[(QNEXT) + 2 * s_].x), eb_ = __builtin_amdgcn_readfirstlane((int)Q[(QNEXT) + 2 * s_ + 1].x); \
                von_[s_] = (hf ? eb_ : ea_) * 768 + voff24; } \
            f32x4 xq_[8]; \
            { const LAS f32x4* xp_ = (const LAS f32x4*)(xl + (TI) * 4096) + lp; \
              _Pragma("unroll") for (int k_ = 0; k_ < 8; ++k_) xq_[k_] = xp_[32 * k_]; } \
            float part[4]; \
            _Pragma("unroll") for (int s_ = 0; s_ < 4; ++s_) { const v32f_t uf_ = P6_CVT(ub[s_], ub2[s_]); P6_SB(); \
                ub[s_] = __builtin_amdgcn_raw_buffer_load_b128(rsu, von_[s_], 0, 0); ub2[s_] = __builtin_amdgcn_raw_buffer_load_b64(rsu, von_[s_] + 16, 0, 0); P6_SB(); \
                f32x2_t d01_ = {0.f, 0.f}, d23_ = {0.f, 0.f}; \
                _Pragma("unroll") for (int k_ = 0; k_ < 8; ++k_) { \
                    d01_ = __builtin_elementwise_fma((f32x2_t){uf_[4 * k_], uf_[4 * k_ + 1]}, (f32x2_t){xq_[k_].x, xq_[k_].y}, d01_); \
                    d23_ = __builtin_elementwise_fma((f32x2_t){uf_[4 * k_ + 2], uf_[4 * k_ + 3]}, (f32x2_t){xq_[k_].z, xq_[k_].w}, d23_); } \
                part[s_] = (d01_.x + d01_.y) + (d23_.x + d23_.y); } \
            _Pragma("unroll") for (int off_ = 2; off_ >= 1; off_ >>= 1) { const bool up_ = (lane & off_) != 0; \
                _Pragma("unroll") for (int i_ = 0; i_ < off_; ++i_) { float pa_ = part[i_], pb_ = part[i_ + off_]; asm("" : "+v"(pa_), "+v"(pb_)); const float keep_ = up_ ? pb_ : pa_; const float send_ = up_ ? pa_ : pb_; part[i_] = keep_ + __shfl_xor(send_, off_); } } \
            float tot_ = part[0]; tot_ += __shfl_xor(tot_, 4); tot_ += __shfl_xor(tot_, 8); tot_ += __shfl_xor(tot_, 16); \
            const float coefv_ = gA * svA * gelu_erf(suA * tot_); \
            P6_SB(); gA = __uint_as_float(qn_.y); suA = SU[(int)qn_.x]; svA = SV[(int)qn_.x]; P6_SB(); \
            _Pragma("unroll") for (int s_ = 0; s_ < 4; ++s_) { const float cf_ = __shfl(coefv_, (lane & 32) | s_); const f32x2_t cf2_ = {cf_, cf_}; const v32f_t vf_ = P6_CVT(vb[s_], vb2[s_]); P6_SB(); \
                vb[s_] = __builtin_amdgcn_raw_buffer_load_b128(rsv, von_[s_], 0, 0); vb2[s_] = __builtin_amdgcn_raw_buffer_load_b64(rsv, von_[s_] + 16, 0, 0); P6_SB(); \
                _Pragma("unroll") for (int i_ = 0; i_ < 16; ++i_) ACC[i_] = __builtin_elementwise_fma((f32x2_t){vf_[2 * i_], vf_[2 * i_ + 1]}, cf2_, ACC[i_]); } \
        } while (0)
        if (T == 2) {
            P6_SB(); P6_FETCH(0); P6_SB();
#pragma unroll 1
            for (int jj = 0; jj < 16; ++jj) {
                P6_ROUND(0, acc0, 128 + 8 * jj); P6_SB();
                P6_ROUND(1, acc1, (jj < 15 ? 8 * jj + 8 : 120)); P6_SB();
            }
        } else {
#pragma unroll 1
            for (int jj = 0; jj < 16; ++jj) { P6_SB(); P6_FETCH(8 * jj); P6_SB(); P6_MATH(0, acc0); }
        }
        asm volatile("" ::: "memory"); __builtin_amdgcn_sched_barrier(0);
        peer_finish_token6(acc0, X1B, g2, b2, Y, tok0, lane);
        asm volatile("" ::: "memory"); __builtin_amdgcn_sched_barrier(0);
        if (T > 1) peer_finish_token6(acc1, X1B, g2, b2, Y, tok0 + 1, lane);
        LDS_WAIT();
    }
    {
        asm volatile("" : "+v"(lane));
        const int lp = lane & 31, hf = lane >> 5; const int voff24 = lp * 24;
        float gA, suA, svA; v4u ub[4], vb[4]; v2u ub2[4], vb2[4];
#pragma unroll 1
        for (int tr = full * TT * NGW + (int)blockIdx.x; tr < NTOK; tr += nblk) {
            __syncthreads();
            {
                const size_t o = (size_t)tr * 128 + 16 * wave + (lane & 15);
                if (lane < 16) { v2u ent; ent.x = (unsigned)IDX[o]; ent.y = __float_as_uint(GATE[o]); Q[lane] = ent; }
                const v4u* xp = (const v4u*)(X1B + (size_t)tr * DM) + 2 * lane; const v4u a = xp[0], b = xp[1];
                P6_XSTORE(xl, a, b);
            }
            LDS_WAIT();
            f32x2_t acc0[16];
#pragma unroll
            for (int i = 0; i < 16; ++i) acc0[i] = (f32x2_t){0.f, 0.f};
            P6_SB(); P6_FETCH(0); P6_SB(); P6_MATH(0, acc0);
            P6_SB(); P6_FETCH(8); P6_SB(); P6_MATH(0, acc0);
#pragma unroll
            for (int i = 0; i < 32; ++i) ((LAS float*)(wl + 4096))[i * 64 + lane] = (i & 1) ? acc0[i >> 1].y : acc0[i >> 1].x;
            __syncthreads();
            if (wave == 0) {
#pragma unroll 1
                for (int w = 1; w < 8; ++w) {
                    const LAS float* rp = (const LAS float*)(lds0 + w * 12288 + 4096) + lane;
#pragma unroll
                    for (int i = 0; i < 16; ++i) { acc0[i].x += rp[(2 * i) * 64]; acc0[i].y += rp[(2 * i + 1) * 64]; }
                }
                peer_finish_token6(acc0, X1B, g2, b2, Y, tr, lane);
            }
        }
    }
#undef P6_FETCH
#undef P6_XSTORE
#undef P6_CVT
#undef P6_MATH
#undef P6_ROUND
#undef P6_SB
}

template <int NB>
__device__ __forceinline__ void block_gemm32(const bf16* A, const bf16* Bt, int row0, int n0, int n1, LAS float* part, float (&v0)[2], float (&v1)[2], int tid) {
    const int lane = tid & 63, w = tid >> 6, q = lane & 31, hi = lane >> 5;
    const bf16* ap = A + (size_t)(row0 + q) * DM + 128 * w + 8 * hi;
    const bf16* b0p = Bt + (size_t)(n0 + q) * DM + 128 * w + 8 * hi;
    const bf16* b1p = Bt + (size_t)(n1 + q) * DM + 128 * w + 8 * hi;
    bf16x8_t af[8], bf0[8], bf1[8];
#pragma unroll
    for (int ks = 0; ks < 8; ++ks) { af[ks] = *(const bf16x8_t*)(ap + 16 * ks); bf0[ks] = *(const bf16x8_t*)(b0p + 16 * ks); if constexpr (NB == 2) bf1[ks] = *(const bf16x8_t*)(b1p + 16 * ks); }
    f32x16_t acc0 = {0.f, 0.f, 0.f, 0.f, 0.f, 0.f, 0.f, 0.f, 0.f, 0.f, 0.f, 0.f, 0.f, 0.f, 0.f, 0.f}, acc1 = acc0;
#pragma unroll
    for (int ks = 0; ks < 8; ++ks) {
        acc0 = __builtin_amdgcn_mfma_f32_32x32x16_bf16(af[ks], bf0[ks], acc0, 0, 0, 0);
        if constexpr (NB == 2) acc1 = __builtin_amdgcn_mfma_f32_32x32x16_bf16(af[ks], bf1[ks], acc1, 0, 0, 0);
    }
    __syncthreads();
#pragma unroll
    for (int r = 0; r < 16; ++r) { part[(w * 16 + r) * 64 + lane] = acc0[r]; if constexpr (NB == 2) part[8192 + (w * 16 + r) * 64 + lane] = acc1[r]; }
    __syncthreads();
#pragma unroll
    for (int e = 0; e < 2; ++e) {
        float s0 = 0.f, s1 = 0.f;
#pragma unroll
        for (int ww = 0; ww < 8; ++ww) { s0 += part[ww * 1024 + tid + 512 * e]; if constexpr (NB == 2) s1 += part[8192 + ww * 1024 + tid + 512 * e]; }
        v0[e] = s0; v1[e] = s1;
    }
}
__device__ __forceinline__ void tile_ij(int tid, int e, int& i, int& j) { const int idx = tid + 512 * e, r = idx >> 6, ln = idx & 63; i = crow(r, ln >> 5); j = ln & 31; }
__device__ __forceinline__ void sample_inproj_task(const bf16* XB, const bf16* WT1, bf16* QB, bf16* GB, float* out, int task, LAS float* part, int tid) {
    const int rt = task >> 6, ct = task & 63;
    float v0[2], v1[2];
    if (ct < 48) {
        block_gemm32<1>(XB, WT1, NP + 32 * rt, 32 * ct, 0, part, v0, v1, tid);
        const int which = ct >> 4;
#pragma unroll
        for (int e = 0; e < 2; ++e) {
            int i, j; tile_ij(tid, e, i, j);
            const int s_ = 32 * rt + i, col = (ct & 15) * 32 + j;
            QB[(size_t)which * ((size_t)NTOK * 512) + (size_t)(NP + s_) * 512 + col] = (bf16)(cvtpk(v0[e], 0.f) & 0xffffu);
            if (which != 0) out[(which == 1 ? O_KS : O_VS) + ((size_t)(s_ >> 3) * 2048 + 2040 + (s_ & 7)) * 512 + col] = v0[e];
        }
    } else {
        const int cb = ct - 48; const int na = 1536 + 256 * (cb >> 2) + (cb & 3) * 32;
        block_gemm32<2>(XB, WT1, NP + 32 * rt, na, na + 128, part, v0, v1, tid);
#pragma unroll
        for (int e = 0; e < 2; ++e) {
            int i, j; tile_ij(tid, e, i, j);
            const int s_ = 32 * rt + i, ch = cb * 32 + j;
            const float g = v0[e] / (1.f + __expf(-v1[e]));
            GB[(size_t)(NP + s_) * 512 + ch] = (bf16)(cvtpk(g, 0.f) & 0xffffu);
            out[O_CS + ((size_t)(s_ >> 3) * 30 + 22 + (s_ & 7)) * 512 + ch] = g;
        }
    }
}
__device__ __forceinline__ void sample_outproj_task(const bf16* MIX, const bf16* WT2, const float* xs, bf16* H, int task, LAS float* part, int tid) {
    const int rt = task >> 5, ct = task & 31;
    float v0[2], v1[2];
    block_gemm32<1>(MIX, WT2, NP + 32 * rt, 32 * ct, 0, part, v0, v1, tid);
#pragma unroll
    for (int e = 0; e < 2; ++e) { int i, j; tile_ij(tid, e, i, j); const int s_ = 32 * rt + i; H[(size_t)(NP + s_) * DM + 32 * ct + j] = (bf16)(cvtpk(ALPHA * xs[(size_t)s_ * DM + 32 * ct + j] + v0[e], 0.f) & 0xffffu); }
}
__device__ __forceinline__ void sample_query_task(const bf16* X1B, const bf16* WT3, bf16* PQ, int task, LAS float* part, int tid) {
    const int rt = task >> 6, ct = task & 63;
    float v0[2], v1[2];
    block_gemm32<1>(X1B, WT3, NP + 32 * rt, 32 * ct, 0, part, v0, v1, tid);
#pragma unroll
    for (int e = 0; e < 2; ++e) { int i, j; tile_ij(tid, e, i, j); const int s_ = 32 * rt + i; PQ[(size_t)(NP + s_) * PQD + 32 * ct + j] = (bf16)(cvtpk(v0[e], 0.f) & 0xffffu); }
}

#define XB_TMO      128
#define XB_XCNT(j)  (256  + 64 * (j))
#define XB_XSUB(j)  (1280 + 64 * (j))
#define XB_XGEN(j)  (2304 + 64 * (j))
#define XB_TOP      3328
#define XB_TOPGEN   3392
#define XCD_BAR_WORDS 3456
#define XB_SPIN_CAP (1u << 18)
__device__ __forceinline__ unsigned xb_ld(unsigned* p)              { return __hip_atomic_load(p, __ATOMIC_RELAXED, __HIP_MEMORY_SCOPE_AGENT); }
__device__ __forceinline__ unsigned xb_add(unsigned* p, unsigned v) { return __hip_atomic_fetch_add(p, v, __ATOMIC_RELAXED, __HIP_MEMORY_SCOPE_AGENT); }
__device__ __forceinline__ unsigned xb_xcc_id() { return (unsigned)__builtin_amdgcn_s_getreg((3 << 11) | 20) & 0xFu; }
#define XB_SPIN(cond, bar) do { unsigned _sp = 0; while (cond) { __builtin_amdgcn_s_sleep(1); \
    if ((++_sp & 255u) == 0u) { if (xb_ld(&(bar)[XB_TMO])) break; if (_sp > XB_SPIN_CAP) { atomicAdd(&(bar)[XB_TMO], 1u); break; } } } } while (0)
struct XcdBarrier { unsigned* bar; unsigned x; volatile LAS unsigned* st; };
__device__ __forceinline__ XcdBarrier xcd_barrier_post(unsigned* bar, volatile LAS unsigned* st) {
    XcdBarrier b; b.bar = bar; b.x = xb_xcc_id(); b.st = st;
    if (threadIdx.x == 0) (void)xb_add(&bar[XB_XCNT(b.x)], 1u);
    return b;
}
__device__ __forceinline__ void xcd_barrier_complete(unsigned* bar, unsigned x, unsigned& nloc, unsigned& nx) {
    const unsigned G = gridDim.x * gridDim.y * gridDim.z;
    unsigned sum, cnt, mine, sp = 0u;
    for (;;) {
        sum = 0u; cnt = 0u; mine = 0u;
#pragma unroll
        for (unsigned j = 0; j < 16; ++j) { const unsigned c = xb_ld(&bar[XB_XCNT(j)]); sum += c; cnt += (c > 0u) ? 1u : 0u; mine = (j == x) ? c : mine; }
        if (sum == G) break;
        __builtin_amdgcn_s_sleep(1);
        if ((++sp & 255u) == 0u) { if (xb_ld(&bar[XB_TMO])) break; if (sp > XB_SPIN_CAP) { atomicAdd(&bar[XB_TMO], 1u); break; } }
    }
    nloc = mine > 0u ? mine : 1u; nx = cnt > 0u ? cnt : 1u;
}
__device__ __forceinline__ void xcd_barrier(const XcdBarrier& b) {
    asm volatile("s_waitcnt vmcnt(0)" ::: "memory");
    __syncthreads();
    if (threadIdx.x == 0) {
        unsigned* bar = b.bar;
        __builtin_amdgcn_s_waitcnt(0);
        unsigned nloc = b.st[0], nx = b.st[1];
        if (nloc == 0u) { xcd_barrier_complete(bar, b.x, nloc, nx); b.st[0] = nloc; b.st[1] = nx; }
        const unsigned old = xb_add(&bar[XB_XSUB(b.x)], 1u);
        const unsigned gen = old / nloc;
        if (old + 1u == (gen + 1u) * nloc) {
            __builtin_amdgcn_fence(__ATOMIC_RELEASE, "agent");
            asm volatile("s_waitcnt vmcnt(0)" ::: "memory");
            const unsigned og = xb_add(&bar[XB_TOP], 1u);
            const unsigned tg = og / nx;
            if (og + 1u == (tg + 1u) * nx) xb_add(&bar[XB_TOPGEN], 1u);
            else XB_SPIN(xb_ld(&bar[XB_TOPGEN]) == tg, bar);
            __builtin_amdgcn_fence(__ATOMIC_ACQUIRE, "agent");
            xb_add(&bar[XB_XGEN(b.x)], 1u);
            asm volatile("s_waitcnt vmcnt(0)" ::: "memory");
        } else {
            XB_SPIN(xb_ld(&bar[XB_XGEN(b.x)]) == gen, bar);
            __builtin_amdgcn_fence(__ATOMIC_ACQUIRE, "agent");
            asm volatile("s_waitcnt vmcnt(0)" ::: "memory");
        }
    }
    __syncthreads();
}

__global__ void __launch_bounds__(NTHREADS, 2) fwd_megakernel(Params p) {
    extern __shared__ __attribute__((aligned(16))) unsigned char lds_raw[];
    LAS unsigned char* lds = (LAS unsigned char*)lds_raw;
    cg::grid_group grid = cg::this_grid();
    int tid = threadIdx.x, lane = tid & 63; const int wave = __builtin_amdgcn_readfirstlane(tid >> 6);
    const int G = gridDim.x, gw = blockIdx.x * NWAVES + wave, NGW = G * NWAVES;
    const long gt = (long)blockIdx.x * NTHREADS + tid, NGT = (long)G * NTHREADS;
    unsigned char* ws = p.ws;
    float* out = p.out;
    volatile LAS unsigned* bst = (volatile LAS unsigned*)(lds + LDS_BYTES - 64);
    if (tid < 16) bst[tid] = 0u;
    __syncthreads();
    const XcdBarrier xbar = xcd_barrier_post((unsigned*)(ws + WS_CTL), bst);
    bf16* WT1 = (bf16*)(ws + WS_WT1); bf16* WT2 = (bf16*)(ws + WS_WT2); bf16* WT3 = (bf16*)(ws + WS_WT3); bf16* SKB = (bf16*)(ws + WS_SK);
    unsigned char* EU8 = ws + WS_EU; unsigned char* EV8 = ws + WS_EV;
    float* SU = (float*)(ws + WS_EU + 16 * MiB); float* SV = (float*)(ws + WS_EV + 16 * MiB);
    bf16* XB = (bf16*)(ws + WS_XB);
    bf16* CSB = (bf16*)(ws + WS_EU + 20 * MiB);
    bf16* QB = (bf16*)(ws + WS_QKVG); bf16* KB = (bf16*)(ws + WS_QKVG + QSZ); bf16* VB = (bf16*)(ws + WS_QKVG + 2 * QSZ); bf16* GB = (bf16*)(ws + WS_QKVG + 3 * QSZ);
    bf16* MIX = (bf16*)(ws + WS_MIX); bf16* HBB = (bf16*)(ws + WS_H);

    {
        LAS float* scr = (LAS float*)(lds + wave * 16384);
        constexpr int I1 = 16 * (INC / 32), I2 = 16 * (DM / 32), I3 = 16 * (PQD / 32);
        for (int it = gw; it < I1 + I2 + I3; it += NGW) {
            int r = it;
            if (r < I1) { const int kb = r / (INC / 32), nb = r % (INC / 32); p0_transpose_item(p.in[5], INC, DM, w1_src_col(32 * nb), WT1, 32 * nb, 64 * kb, scr, lane); continue; } r -= I1;
            if (r < I2) { const int kb = r / (DM / 32), nb = r % (DM / 32); p0_transpose_item(p.in[6], DM, DM, 32 * nb, WT2, 32 * nb, 64 * kb, scr, lane); continue; } r -= I2;
            { const int kb = r / (PQD / 32), nb = r % (PQD / 32); p0_transpose_item(p.in[13], PQD, DM, 32 * nb, WT3, 32 * nb, 64 * kb, scr, lane); }
        }
        constexpr int I_XP = NP / 4, I_XS = NS / 4, I_SK = 64, I_EU = 8192, I_EV = 8192, I_CS = NSB * 30 * 512 / 4096;
        {
            constexpr int N4 = I_XP + I_XS + I_SK + I_CS;
            auto src4 = [&](int r) -> const float* { if (r < I_XP) return p.in[0] + (size_t)r * 4096; r -= I_XP; if (r < I_XS) return p.in[1] + (size_t)r * 4096; r -= I_XS; if (r < I_SK) return p.in[14] + (size_t)r * 4096; r -= I_SK; return p.in[4] + (size_t)r * 4096; };
            auto dst4 = [&](int r) -> bf16* { if (r < I_XP) return XB + (size_t)r * 4096; r -= I_XP; if (r < I_XS) return XB + (size_t)NP * DM + (size_t)r * 4096; r -= I_XS; if (r < I_SK) return SKB + (size_t)r * 4096; r -= I_SK; return CSB + (size_t)r * 4096; };
            f32x4 cur[16], nxt[16];
            int it = gw;
            if (it < N4) rows4_load(src4(it), cur, lane);
#pragma unroll 1
            for (; it < N4; it += NGW) {
                const bool more = it + NGW < N4;
                if (more) rows4_load(src4(it + NGW), nxt, lane);
                rows4_store_bf16(cur, dst4(it), lane);
                if (more) {
#pragma unroll
                    for (int j = 0; j < 16; ++j) cur[j] = nxt[j];
                }
            }
        }
        {
            constexpr int N6 = I_EU + I_EV;
            f32x4 cur[8], nxt[8];
            int it = gw;
            if (it < N6) rows2_load((it < I_EU ? p.in[15] + (size_t)it * 2048 : p.in[16] + (size_t)(it - I_EU) * 2048), cur, lane);
#pragma unroll 1
            for (; it < N6; it += NGW) {
                const int in_ = it + NGW; const bool more = in_ < N6;
                if (more) rows2_load((in_ < I_EU ? p.in[15] + (size_t)in_ * 2048 : p.in[16] + (size_t)(in_ - I_EU) * 2048), nxt, lane);
                if (it < I_EU) rows2_encode_fp6(cur, EU8 + (size_t)it * 1536, SU + 2 * it, lane);
                else rows2_encode_fp6(cur, EV8 + (size_t)(it - I_EU) * 1536, SV + 2 * (it - I_EU), lane);
                if (more) {
#pragma unroll
                    for (int j = 0; j < 8; ++j) cur[j] = nxt[j];
                }
            }
        }
        {
            constexpr long PER_BC = 22L * 128, TOTC = NSB * PER_BC;
            const f32x4* sc = (const f32x4*)p.in[4]; f32x4* oc = (f32x4*)(out + O_CS);
            for (long i = gt; i < TOTC; i += NGT) { const long b = i / PER_BC, rem = i - b * PER_BC; oc[b * 30 * 128 + rem] = sc[b * 30 * 128 + 8 * 128 + rem]; }
        }
    }
    xcd_barrier(xbar); asm volatile("" : "+v"(tid), "+v"(lane));

    {
        pg8::Gemm g{XB, WT1, NP, INC, DM}; pg8::StaticOrder S; S.init(NP, INC, G, (int)blockIdx.x);
        EpiInProj E{QB, GB, out};
        pg8::gemm_phase<EpiInProj, pg8::StaticOrder, true, true>(lds, g, S, E);
        for (int task = blockIdx.x; task < 8 * 64; task += G) sample_inproj_task(XB, WT1, QB, GB, out, task, (LAS float*)lds, tid);
    }
    xcd_barrier(xbar); asm volatile("" : "+v"(tid), "+v"(lane));

    bf16* OP = (bf16*)(ws + WS_H); float* LSE = (float*)(ws + WS_H + (size_t)3 * NTOK * 512 * 2);
    {
        LAS float* wl = (LAS float*)(lds + 65536);
        for (int i = tid; i < (CK + 1) * CC / 4; i += NTHREADS) ((LAS f32x4*)wl)[i] = i < CK * CC / 4 ? ((const f32x4*)p.in[7])[i] : (f32x4){0.f, 0.f, 0.f, 0.f};
        __syncthreads();
        LAS unsigned char* vbuf = lds + wave * 8192;
        const AttnArgs AA{QB, KB, VB, p.in[2], p.in[3], out, OP, LSE};
        constexpr int T_CONV = 4096 + NSB, T_SA = NSB * NH * 13;
        const __amdgpu_buffer_rsrc_t rsw = __builtin_amdgcn_make_buffer_rsrc((void*)ws, 0, 0x40000000, 0x00020000);
        for (int task = gw; task < T_CONV + T_SA; task += NGW) {
            asm volatile("" : "+v"(lane));
            int k = task;
            if (k < T_SA) { attn_mfma_task<true, false>(AA, k, vbuf, lane); continue; }
            k -= T_SA;
            conv_task(rsw, (unsigned)((const unsigned char*)GB - ws), (unsigned)((const unsigned char*)CSB - ws), wl, p.in[8], p.in[9], p.in[10], MIX, k, lane);
        }
        attn_block_phase(AA, lds, G, tid, wave, lane);
    }
    xcd_barrier(xbar); asm volatile("" : "+v"(tid), "+v"(lane));
    for (int r = gw; r < NTOK; r += NGW) attn_merge_row(OP, LSE, MIX, r, lane);
    xcd_barrier(xbar); asm volatile("" : "+v"(tid), "+v"(lane));

    {
        pg8::Gemm g{MIX, WT2, NP, DM, DM}; pg8::StaticOrder S; S.init(NP, DM, G, (int)blockIdx.x);
        EpiResid E{XB, HBB};
        pg8::gemm_phase<EpiResid, pg8::StaticOrder, true, true>(lds, g, S, E);
        for (int task = blockIdx.x; task < 8 * 32; task += G) sample_outproj_task(MIX, WT2, p.in[1], HBB, task, (LAS float*)lds, tid);
    }
    xcd_barrier(xbar); asm volatile("" : "+v"(tid), "+v"(lane));

    bf16* X1B = XB;
    for (int r = 4 * gw; r < NTOK; r += 4 * NGW) ln1_rows4(HBB, X1B, p.in[11], p.in[12], r, lane);
    xcd_barrier(xbar); asm volatile("" : "+v"(tid), "+v"(lane));

    bf16* PQ = (bf16*)(ws + WS_QKVG);
    {
        pg8::Gemm g{X1B, WT3, NP, PQD, DM}; pg8::StaticOrder S; S.init(NP, PQD, G, (int)blockIdx.x);
        EpiPlainBf16 E{PQ, PQD};
        pg8::gemm_phase<EpiPlainBf16, pg8::StaticOrder, true, true>(lds, g, S, E);
        for (int task = blockIdx.x; task < 8 * 64; task += G) sample_query_task(X1B, WT3, PQ, task, (LAS float*)lds, tid);
    }
    xcd_barrier(xbar); asm volatile("" : "+v"(tid), "+v"(lane));

    int* IDX = (int*)(ws + WS_MIX); float* GATE = (float*)(ws + WS_MIX + (size_t)NTOK * 128 * 4);
    {
        constexpr int NTILE = NTOK / 32;
        const CacheCopy CC{(const f32x4*)p.in[2], (const f32x4*)p.in[3], (f32x4*)(out + O_KS), (f32x4*)(out + O_VS)};
        const int ntb = ((int)blockIdx.x < NTILE) ? (NTILE - 1 - (int)blockIdx.x) / G + 1 : 0;
        for (int hp = 0; hp < 4; ++hp) {
            __syncthreads();
            const v4u* src = (const v4u*)(SKB + (size_t)hp * 2 * 2 * 128 * 128);
#pragma unroll 4
            for (int i = 0; i < 16; ++i) { const int gch = tid + NTHREADS * i, row = gch >> 4, ch = gch & 15; *(LAS v4u*)(lds + row * 256 + ((ch ^ (row & 15)) << 4)) = src[gch]; }
            __syncthreads();
            if (G == 256) {
                topk_mfma_task(PQ, lds + (wave & 1) * 65536, IDX, GATE, (int)blockIdx.x * 4 + (wave >> 1), 2 * hp + (wave & 1), lane, CC);
                const int x = (int)blockIdx.x - 8;
                if (x >= 0 && x < 64 && ((x >> 4) == hp) && wave == 0) topk_mfma_task(PQ, lds + ((x >> 3) & 1) * 65536, IDX, GATE, 1024 + (x & 7), x >> 3, lane, CC);
            } else {
                for (int k0 = 0; k0 < ntb; k0 += 4) {
                    const int k = k0 + (wave >> 1);
                    if (k < ntb) topk_mfma_task(PQ, lds + (wave & 1) * 65536, IDX, GATE, (int)blockIdx.x + G * k, 2 * hp + (wave & 1), lane, CC);
                }
            }
        }
    }
    xcd_barrier(xbar); asm volatile("" : "+v"(tid), "+v"(lane));

#ifdef PEER_TOKEN_MAJOR
    peer_phase(X1B, HB, IDX, GATE, EU8, EV8, SU, SV, p.in[17], p.in[18], out + O_Y, gw, NGW, lane);
#else
    peer_phase6(X1B, IDX, GATE, EU8, EV8, SU, SV, p.in[17], p.in[18], out + O_Y, gw, NGW, lane, lds + wave * 12288, lds, wave, G);
    grid.sync();
#endif
}

extern "C" void kernel_launch(void* const* d_in, const int* in_sizes, int n_in, void* d_out, int out_size, void* d_ws, size_t ws_size, hipStream_t stream) {
    static int grid_blocks = 0;
    if (grid_blocks == 0) {
        if (n_in != 19 || (size_t)out_size != O_END || ws_size < WS_END) { fprintf(stderr, "kernel_launch: unexpected shapes n_in %d out %d ws %zu\n", n_in, out_size, ws_size); grid_blocks = -1; return; }
        int dev = 0, cus = 0, per_cu = 0;
        (void)hipGetDevice(&dev);
        (void)hipDeviceGetAttribute(&cus, hipDeviceAttributeMultiprocessorCount, dev);
        (void)hipFuncSetAttribute((const void*)fwd_megakernel, hipFuncAttributeMaxDynamicSharedMemorySize, LDS_BYTES);
        (void)hipOccupancyMaxActiveBlocksPerMultiprocessor(&per_cu, (const void*)fwd_megakernel, NTHREADS, LDS_BYTES);
        if (per_cu < 1) { fprintf(stderr, "kernel_launch: occupancy query says %d blocks per CU\n", per_cu); per_cu = 1; }
        if (per_cu > 1) per_cu = 1;
        grid_blocks = cus * per_cu;
        (void)hipGetLastError();
    }
    if (grid_blocks < 0) return;
    (void)hipMemsetAsync((char*)d_ws + WS_CTL, 0, 16384, stream);
    Params p{};
    for (int i = 0; i < 19; ++i) p.in[i] = (const float*)d_in[i];
    p.out = (float*)d_out; p.ws = (unsigned char*)d_ws;
    void* args[] = {&p};
    hipError_t e = hipLaunchCooperativeKernel((const void*)fwd_megakernel, dim3(grid_blocks), dim3(NTHREADS), args, LDS_BYTES, stream);
    if (e != hipSuccess) fprintf(stderr, "cooperative launch failed: %s (grid %d)\n", hipGetErrorString(e), grid_blocks);
}
```

```cpp
#include <hip/hip_runtime.h>
#include <hip/hip_cooperative_groups.h>
#include <cstdio>
#include <cstdint>
namespace cg = cooperative_groups;

namespace pg8 {
#define PG8_LAS __attribute__((address_space(3)))
typedef unsigned short bf16_t;
typedef short bf16x8 __attribute__((ext_vector_type(8)));
typedef float f32x4 __attribute__((ext_vector_type(4)));
typedef unsigned u32x4 __attribute__((ext_vector_type(4)));
typedef unsigned u32x2 __attribute__((ext_vector_type(2)));
constexpr int BM = 256, BK = 64, HALF = 128, HTB = HALF * BK * 2, STAGE_BYTES = 8 * HTB, NXCD = 8, WGM = 4;

__host__ __device__ __forceinline__ int lds_byte(int r, int c) { const int st = (r >> 4) * 2 + (c >> 5), rr = r & 15, cc = c & 31, ob = rr * 64 + cc * 2; return st * 1024 + (ob ^ (((ob >> 9) & 1) << 5)); }
__host__ __device__ __forceinline__ void stage_rc(int b, int& R, int& C) { const int st = b / 1024, sb = b % 1024, swz = sb ^ (((sb >> 9) & 1) << 5); R = (st >> 1) * 16 + swz / 64; C = (st & 1) * 32 + (swz % 64) / 2; }
__host__ __device__ __forceinline__ int perm32(int rho) { const int n = rho >> 4, i = rho & 15; return 8 * (i >> 2) + 4 * n + (i & 3); }

struct Unit { int pm, pn; };
struct Gemm { const bf16_t* A; const bf16_t* Bt; int M, N, K; };

struct StaticOrder {
    int nM, nN, nwg, G, c;
    __host__ __device__ void init(int M, int N, int G_, int c_) { nM = M / BM; nN = N / BM; nwg = nM * nN; G = G_; c = c_; }
    __host__ __device__ bool next(int i, Unit& u) const {
        const long L = (long)i * G + c; if (L >= nwg) return false;
        int wgid = (int)L; { const int q = nwg / NXCD, r = nwg % NXCD, xcd = wgid % NXCD, off = wgid / NXCD; wgid = (xcd < r ? xcd * (q + 1) : r * (q + 1) + (xcd - r) * q) + off; }
        const int nig = WGM * nN, gid = wgid / nig, fm = gid * WGM, gsz = (nM - fm) < WGM ? (nM - fm) : WGM;
        u.pm = fm + ((wgid % nig) % gsz); u.pn = (wgid % nig) / gsz; return true;
    }
    __device__ __forceinline__ void a_ready(const Unit&) const {}
    __device__ __forceinline__ void done(const Unit&) const {}
};

template <class Epi, class Sched, bool ALIGN_EPI = false, bool SP2 = false>
__device__ __forceinline__ void gemm_phase(PG8_LAS unsigned char* lds, const Gemm g, const Sched& S, const Epi& E) {
    int tid = threadIdx.x; asm volatile("" : "+v"(tid));
    const int wid = __builtin_amdgcn_readfirstlane(tid >> 6), lane = tid & 63, wr = wid >> 2, wc = wid & 3, fr = lane & 15, fq = lane >> 4;
    const int K = g.K, nt = K / BK;
    unsigned voffA[2], voffB[2];
#pragma unroll
    for (int i = 0; i < 2; ++i) { int R, C; stage_rc(tid * 16 + i * 8192, R, C); const int Rb = Epi::PERM ? ((R & ~31) + perm32(R & 31)) : R;
        voffA[i] = (unsigned)(R * K + C) * 2u; voffB[i] = (unsigned)(Rb * K + C) * 2u; }
    const size_t kstep = (size_t)(BK * 2);
    const size_t hstep = (size_t)HALF * K * 2;
    const size_t tstep = 2 * hstep;
    const unsigned ldsw = (unsigned)wid * 1024u;
    const int aoff = lds_byte(wr * 64 + fr, fq * 8), boff = lds_byte(wc * 32 + fr, fq * 8);
#define PG8_SA(b, h) (((b) * 2 + (h)) * HTB)
#define PG8_SB(b, h) ((4 + (b) * 2 + (h)) * HTB)
#define PG8_STAGE(bufoff, gbase, voff) do { _Pragma("unroll") for (int _i = 0; _i < 2; ++_i) \
        __builtin_amdgcn_global_load_lds((const unsigned*)((const char*)(gbase) + (voff)[_i]), (PG8_LAS unsigned*)(lds + (bufoff) + ldsw + _i * 8192), 16, 0, 0); } while (0)
#define PG8_LDA(dst, b, h) do { _Pragma("unroll") for (int m = 0; m < 4; ++m) _Pragma("unroll") for (int k = 0; k < 2; ++k) dst[m][k] = *(const PG8_LAS bf16x8*)(lds + PG8_SA(b, h) + aoff + m * 2048 + k * 1024); } while (0)
#define PG8_LDB(dst, b, h) do { _Pragma("unroll") for (int n = 0; n < 2; ++n) _Pragma("unroll") for (int k = 0; k < 2; ++k) dst[n][k] = *(const PG8_LAS bf16x8*)(lds + PG8_SB(b, h) + boff + n * 2048 + k * 1024); } while (0)
#define PG8_MMA(ai, bj, At, Bt) do { __builtin_amdgcn_s_setprio(1); _Pragma("unroll") for (int m = 0; m < 4; ++m) _Pragma("unroll") for (int n = 0; n < 2; ++n) _Pragma("unroll") for (int k = 0; k < 2; ++k) \
        acc[ai][bj][m][n] = __builtin_amdgcn_mfma_f32_16x16x32_bf16(Bt[n][k], At[m][k], acc[ai][bj][m][n], 0, 0, 0); __builtin_amdgcn_s_setprio(0); } while (0)
#define PG8_WAIT_V(n) asm volatile("s_waitcnt vmcnt(" #n ")" ::: "memory")
#define PG8_WAIT_L(n) asm volatile("s_waitcnt lgkmcnt(" #n ")" ::: "memory")
#define PG8_BAR __builtin_amdgcn_s_barrier()
#define PG8_SCHED __builtin_amdgcn_sched_barrier(0)
    Unit cur, nxt; int ui = 0;
    if (!S.next(0, cur)) return;
    f32x4 acc[2][2][4][2];
#pragma unroll
    for (int a = 0; a < 2; ++a)
#pragma unroll
        for (int b = 0; b < 2; ++b)
#pragma unroll
            for (int m = 0; m < 4; ++m)
#pragma unroll
                for (int n = 0; n < 2; ++n) acc[a][b][m][n] = (f32x4){0.f, 0.f, 0.f, 0.f};
    bf16x8 At[4][2], B0[2][2], B1[2][2];
    const char* cA = (const char*)g.A + (size_t)cur.pm * tstep; const char* cB = (const char*)g.Bt + (size_t)cur.pn * tstep;
    S.a_ready(cur);
    if constexpr (SP2) {
        PG8_STAGE(PG8_SB(0, 0), cB, voffB); PG8_STAGE(PG8_SB(0, 1), cB + hstep, voffB); PG8_STAGE(PG8_SA(0, 0), cA, voffA); PG8_STAGE(PG8_SA(0, 1), cA + hstep, voffA);
        if (wr == 1) PG8_BAR;
        PG8_WAIT_V(2); PG8_BAR;
        PG8_STAGE(PG8_SB(1, 0), cB + kstep, voffB); PG8_STAGE(PG8_SA(1, 0), cA + kstep, voffA); PG8_STAGE(PG8_SB(1, 1), cB + hstep + kstep, voffB);
        PG8_WAIT_V(6); PG8_BAR;
    } else {
        PG8_STAGE(PG8_SB(0, 0), cB, voffB); PG8_STAGE(PG8_SA(0, 0), cA, voffA); PG8_STAGE(PG8_SB(0, 1), cB + hstep, voffB); PG8_STAGE(PG8_SA(0, 1), cA + hstep, voffA);
        if (wr == 1) PG8_BAR;
        PG8_WAIT_V(4); PG8_BAR;
        PG8_STAGE(PG8_SB(1, 0), cB + kstep, voffB); PG8_STAGE(PG8_SA(1, 0), cA + kstep, voffA); PG8_STAGE(PG8_SB(1, 1), cB + hstep + kstep, voffB);
        PG8_WAIT_V(6); PG8_BAR;
    }
    for (;;) {
        const bool has_next = S.next(ui + 1, nxt);
        const char* nA = has_next ? (const char*)g.A + (size_t)nxt.pm * tstep : cA; const char* nB = has_next ? (const char*)g.Bt + (size_t)nxt.pn * tstep : cB;
        for (int t = 0; t < nt; t += 2) {
            const bool last = (t == nt - 2);
            const char* a1 = cA + (size_t)(t + 1) * kstep;
            const char* a2 = last ? nA : cA + (size_t)(t + 2) * kstep; const char* b2 = last ? nB : cB + (size_t)(t + 2) * kstep;
            const char* a3 = a2 + kstep; const char* b3 = b2 + kstep;
            if (last && has_next) S.a_ready(nxt);
            if constexpr (SP2) {
            PG8_LDB(B0, 0, 0); PG8_LDB(B1, 0, 1); PG8_SCHED; PG8_LDA(At, 0, 0); PG8_STAGE(PG8_SA(1, 1), a1 + hstep, voffA);
            PG8_WAIT_V(8); PG8_WAIT_L(0); PG8_BAR; PG8_MMA(0, 0, At, B0); PG8_MMA(0, 1, At, B1); PG8_BAR; PG8_SCHED;
            PG8_LDA(At, 0, 1); PG8_STAGE(PG8_SB(0, 0), b2, voffB); PG8_STAGE(PG8_SB(0, 1), b2 + hstep, voffB); PG8_STAGE(PG8_SA(0, 0), a2, voffA);
            PG8_WAIT_V(8); PG8_WAIT_L(0); PG8_BAR; PG8_MMA(1, 0, At, B0); PG8_MMA(1, 1, At, B1); PG8_BAR; PG8_SCHED;
            PG8_LDB(B0, 1, 0); PG8_LDB(B1, 1, 1); PG8_SCHED; PG8_LDA(At, 1, 0); PG8_STAGE(PG8_SA(0, 1), a2 + hstep, voffA);
            PG8_WAIT_V(8); PG8_WAIT_L(0); PG8_BAR; PG8_MMA(0, 0, At, B0); PG8_MMA(0, 1, At, B1); PG8_BAR; PG8_SCHED;
            PG8_LDA(At, 1, 1); PG8_STAGE(PG8_SB(1, 0), b3, voffB); PG8_STAGE(PG8_SB(1, 1), b3 + hstep, voffB); PG8_STAGE(PG8_SA(1, 0), a3, voffA);
            PG8_WAIT_V(8); PG8_WAIT_L(0); PG8_BAR; PG8_MMA(1, 0, At, B0); PG8_MMA(1, 1, At, B1); PG8_BAR; PG8_SCHED;
            } else {
            PG8_LDB(B0, 0, 0); PG8_SCHED; PG8_LDA(At, 0, 0); PG8_STAGE(PG8_SA(1, 1), a1 + hstep, voffA);
            PG8_WAIT_L(8); PG8_BAR; PG8_WAIT_L(0); PG8_MMA(0, 0, At, B0); PG8_BAR; PG8_SCHED;
            PG8_LDB(B1, 0, 1); PG8_STAGE(PG8_SB(0, 0), b2, voffB);
            PG8_BAR; PG8_WAIT_L(0); PG8_MMA(0, 1, At, B1); PG8_BAR;
            PG8_LDA(At, 0, 1); PG8_STAGE(PG8_SA(0, 0), a2, voffA);
            PG8_BAR; PG8_WAIT_L(0); PG8_MMA(1, 0, At, B0); PG8_BAR; PG8_SCHED;
            PG8_STAGE(PG8_SB(0, 1), b2 + hstep, voffB);
            PG8_WAIT_V(6); PG8_BAR; PG8_MMA(1, 1, At, B1); PG8_BAR;
            PG8_LDB(B0, 1, 0); PG8_SCHED; PG8_LDA(At, 1, 0); PG8_STAGE(PG8_SA(0, 1), a2 + hstep, voffA);
            PG8_WAIT_L(8); PG8_BAR; PG8_WAIT_L(0); PG8_MMA(0, 0, At, B0); PG8_BAR; PG8_SCHED;
            PG8_LDB(B1, 1, 1); PG8_STAGE(PG8_SB(1, 0), b3, voffB);
            PG8_BAR; PG8_WAIT_L(0); PG8_MMA(0, 1, At, B1); PG8_BAR;
            PG8_LDA(At, 1, 1); PG8_STAGE(PG8_SA(1, 0), a3, voffA);
            PG8_BAR; PG8_WAIT_L(0); PG8_MMA(1, 0, At, B0); PG8_BAR; PG8_SCHED;
            PG8_STAGE(PG8_SB(1, 1), b3 + hstep, voffB);
            PG8_WAIT_V(6); PG8_BAR; PG8_MMA(1, 1, At, B1); PG8_BAR;
            }
        }
        if constexpr (ALIGN_EPI) { if (wr == 0) PG8_BAR; }
        if constexpr (!Epi::AFTER_DRAIN) { E(acc, cur, wr, wc, fr, fq); S.done(cur); }
        if (!has_next) break;
#pragma unroll
        for (int a = 0; a < 2; ++a)
#pragma unroll
            for (int b = 0; b < 2; ++b)
#pragma unroll
                for (int m = 0; m < 4; ++m)
#pragma unroll
                    for (int n = 0; n < 2; ++n) acc[a][b][m][n] = (f32x4){0.f, 0.f, 0.f, 0.f};
        cur = nxt; cA = nA; cB = nB; ++ui;
        if constexpr (ALIGN_EPI) { if (wr == 1) PG8_BAR; }
    }
    PG8_WAIT_V(0);
    if constexpr (!ALIGN_EPI) { if (wr == 0) PG8_BAR; }
    PG8_BAR;
    if constexpr (Epi::AFTER_DRAIN) { E.fused(acc, cur, wr, wc, fr, fq, lds, wid, lane); S.done(cur); }
#undef PG8_SA
#undef PG8_SB
#undef PG8_STAGE
#undef PG8_LDA
#undef PG8_LDB
#undef PG8_MMA
#undef PG8_WAIT_V
#undef PG8_WAIT_L
#undef PG8_BAR
#undef PG8_SCHED
}
}

#define GAS __attribute__((address_space(1)))
#define LAS __attribute__((address_space(3)))
typedef unsigned short bf16;
typedef unsigned v4u __attribute__((ext_vector_type(4)));
typedef unsigned v2u __attribute__((ext_vector_type(2)));
typedef float f32x4 __attribute__((ext_vector_type(4)));
typedef float f32x2_t __attribute__((ext_vector_type(2)));
typedef __bf16 bf16x2_t __attribute__((ext_vector_type(2)));

constexpr int DM = 1024, NPB = 8, SEQ = 4096, NSB = 32, DSEQ = 8, LB = 2048;
constexpr int NP = NPB * SEQ, NS = NSB * DSEQ, NTOK = NP + NS;
constexpr int AW = 512, CC = 512, NH = 8, HD = 64, INC = 2560, CK = 31;
constexpr int NKEYS = 128, PH = 8, PQD = 2048;
constexpr float ALPHA = 1.18920711500272f, LN_EPS = 1e-5f;
constexpr size_t O_Y = 0, O_KP = (size_t)NTOK * DM, O_VP = O_KP + (size_t)NPB * 2048 * 512, O_CP = O_VP + (size_t)NPB * 2048 * 512,
                 O_KS = O_CP + (size_t)NPB * 30 * 512, O_VS = O_KS + (size_t)NSB * 2048 * 512, O_CS = O_VS + (size_t)NSB * 2048 * 512, O_END = O_CS + (size_t)NSB * 30 * 512;
static_assert(O_END == 118317056ull, "output map");
constexpr size_t MiB = 1u << 20;
constexpr size_t WS_CTL = 0, WS_WT1 = 1 * MiB, WS_WT2 = 6 * MiB, WS_WT3 = 8 * MiB, WS_SK = 12 * MiB, WS_EU = 13 * MiB, WS_EV = 45 * MiB,
                 WS_XB = 77 * MiB, WS_QKVG = 142 * MiB, WS_MIX = 271 * MiB, WS_H = 336 * MiB, WS_END = 465 * MiB;
constexpr size_t QSZ = (size_t)NTOK * 512 * 2;
static_assert(WS_XB + (size_t)NTOK * DM * 2 <= WS_QKVG && WS_QKVG + 4 * QSZ <= WS_MIX && WS_QKVG + (size_t)NTOK * PQD * 2 <= WS_MIX && WS_MIX + (size_t)NTOK * DM * 2 <= WS_H && WS_H + (size_t)NTOK * DM * 4 <= WS_END, "ws map");
static_assert(WS_MIX + (size_t)NTOK * 128 * 8 <= WS_H, "idx+gate overlay");

constexpr int NWAVES = 8, NTHREADS = 512;
constexpr int LDS_BYTES = 147456;

struct Params { const float* in[19]; float* out; unsigned char* ws; };

__device__ __forceinline__ unsigned cvtpk(float lo, float hi) { f32x2_t v = {lo, hi}; bf16x2_t b = __builtin_convertvector(v, bf16x2_t); return __builtin_bit_cast(unsigned, b); }
__device__ __forceinline__ float bflo(unsigned u) { return __uint_as_float(u << 16); }
__device__ __forceinline__ float bfhi(unsigned u) { return __uint_as_float(u & 0xffff0000u); }
__device__ __forceinline__ float dot2(unsigned a, unsigned b, float c) { return __builtin_amdgcn_fdot2_f32_bf16(__builtin_bit_cast(bf16x2_t, a), __builtin_bit_cast(bf16x2_t, b), c, false); }
__device__ __forceinline__ float wave_sum(float v) {
#pragma unroll
    for (int o = 1; o < 64; o <<= 1) v += __shfl_xor(v, o);
    return v;
}
__device__ __forceinline__ float wave_max(float v) {
#pragma unroll
    for (int o = 1; o < 64; o <<= 1) v = fmaxf(v, __shfl_xor(v, o));
    return v;
}
__device__ __forceinline__ unsigned wave_maxu(unsigned v) {
#pragma unroll
    for (int o = 1; o < 64; o <<= 1) { const unsigned w = (unsigned)__shfl_xor((int)v, o); v = v > w ? v : w; }
    return v;
}
#define LDS_WAIT() asm volatile("s_waitcnt lgkmcnt(0)" ::: "memory")

__device__ __forceinline__ void p0_transpose_item(const float* W, int N, int K, int srcn0, bf16* WT, int dstn0, int k0, LAS float* scr, int lane) {
#pragma unroll 8
    for (int i = 0; i < 32; ++i) { const int kk = 2 * i + (lane >> 5); scr[kk * 33 + (lane & 31)] = W[(size_t)(k0 + kk) * N + srcn0 + (lane & 31)]; }
    LDS_WAIT(); asm volatile("" ::: "memory");
    const int c = lane & 7;
#pragma unroll
    for (int j = 0; j < 4; ++j) { const int n = (lane >> 3) + 8 * j; const LAS float* s = scr + (8 * c) * 33 + n;
        v4u o; o.x = cvtpk(s[0 * 33], s[1 * 33]); o.y = cvtpk(s[2 * 33], s[3 * 33]); o.z = cvtpk(s[4 * 33], s[5 * 33]); o.w = cvtpk(s[6 * 33], s[7 * 33]);
        *(v4u*)(WT + (size_t)(dstn0 + n) * K + k0 + 8 * c) = o; }
    LDS_WAIT(); asm volatile("" ::: "memory");
}
__device__ __forceinline__ int w1_src_col(int n0) {
    if (n0 < 1536) return n0;
    const int t = n0 - 1536, j = t >> 8, c = t & 255;
    return c < 128 ? 1536 + 128 * j + c : 2048 + 128 * j + (c - 128);
}
__device__ __forceinline__ void rows4_to_bf16(const float* src, bf16* dst, int lane) {
    const f32x4* s = (const f32x4*)src + lane; v2u* d = (v2u*)dst + lane;
    f32x4 v[16];
#pragma unroll
    for (int j = 0; j < 16; ++j) v[j] = s[64 * j];
#pragma unroll
    for (int j = 0; j < 16; ++j) { v2u o; o.x = cvtpk(v[j].x, v[j].y); o.y = cvtpk(v[j].z, v[j].w); d[64 * j] = o; }
}

typedef int v6i_t __attribute__((ext_vector_type(6)));
typedef float v32f_t __attribute__((ext_vector_type(32)));
typedef float v16f_t __attribute__((ext_vector_type(16)));
typedef unsigned v3u __attribute__((ext_vector_type(3)));
__device__ __forceinline__ void rows2_to_fp6(const float* src, unsigned char* dst, float* scale_out, int lane) {
    const int lp = lane & 31, hf = lane >> 5;
    const f32x4* s = (const f32x4*)(src + (size_t)hf * DM + 32 * lp);
    f32x4 v[8]; float m = 0.f;
#pragma unroll
    for (int j = 0; j < 8; ++j) { v[j] = s[j]; m = fmaxf(m, fmaxf(fmaxf(fabsf(v[j].x), fabsf(v[j].y)), fmaxf(fabsf(v[j].z), fabsf(v[j].w)))); }
#pragma unroll
    for (int o = 1; o < 32; o <<= 1) m = fmaxf(m, __shfl_xor(m, o));
    const float sc = m > 0.f ? m * (1.f / 7.5f) : 1.f, inv = 1.f / sc;
    unsigned long long acc64 = 0ull; int nb = 0; unsigned pkw[6]; int wi = 0;
#pragma unroll
    for (int j = 0; j < 8; ++j) {
        const float f4[4] = {v[j].x * inv, v[j].y * inv, v[j].z * inv, v[j].w * inv};
#pragma unroll
        for (int c = 0; c < 4; ++c) {
            const float a_ = fminf(fabsf(f4[c]), 7.5f);
            const float cf = a_ < 1.f ? a_ * 8.f : (a_ < 2.f ? 8.f + (a_ - 1.f) * 8.f : (a_ < 4.f ? 16.f + (a_ - 2.f) * 4.f : 24.f + (a_ - 4.f) * 2.f));
            unsigned code = (unsigned)__builtin_rintf(cf); if (code > 31u) code = 31u;
            if (f4[c] < 0.f) code |= 32u;
            acc64 |= (unsigned long long)code << nb; nb += 6;
            if (nb >= 32) { pkw[wi++] = (unsigned)acc64; acc64 >>= 32; nb -= 32; }
        }
    }
    v6i_t pk; pk[0] = (int)pkw[0]; pk[1] = (int)pkw[1]; pk[2] = (int)pkw[2]; pk[3] = (int)pkw[3]; pk[4] = (int)pkw[4]; pk[5] = (int)pkw[5];
    v2u* d = (v2u*)(dst + (size_t)hf * 768 + 24 * lp);
    v2u w; w.x = (unsigned)pk[0]; w.y = (unsigned)pk[1]; d[0] = w; w.x = (unsigned)pk[2]; w.y = (unsigned)pk[3]; d[1] = w; w.x = (unsigned)pk[4]; w.y = (unsigned)pk[5]; d[2] = w;
    if (lp == 0) scale_out[hf] = sc;
}

struct EpiInProj {
    static constexpr bool PERM = true, AFTER_DRAIN = false;
    bf16 *qb, *gb; float* out;
    __device__ __forceinline__ void operator()(const f32x4 (&acc)[2][2][4][2], const pg8::Unit& u, int wr, int wc, int fr, int fq) const {
        const int pn = u.pn;
#pragma unroll
        for (int ai = 0; ai < 2; ++ai)
#pragma unroll
            for (int m = 0; m < 4; ++m) {
                const int row = u.pm * 256 + ai * 128 + wr * 64 + m * 16 + fr;
                long kvrow = -1, cvrow = -1;
                bool samp = row >= NP;
                if (!samp) { const int b = row >> 12, t = row & 4095; if (t >= 2048) kvrow = (long)b * 2048 + (t - 2048); if (t >= SEQ - 30) cvrow = (long)b * 30 + (t - (SEQ - 30)); }
                else { const int s = row - NP, b = s >> 3, tt = s & 7; kvrow = (long)b * 2048 + 2040 + tt; cvrow = (long)b * 30 + 22 + tt; }
                if (pn < 6) {
                    const int which = pn >> 1;
                    bf16* dst = qb + (size_t)which * ((size_t)NTOK * 512) + (size_t)row * 512;
                    const size_t fbase = samp ? O_KS : O_KP, fstride = samp ? (O_VS - O_KS) : (O_VP - O_KP);
                    const bool dof = (which != 0) && (kvrow >= 0);
                    float* fo = out + fbase + (size_t)(which == 2 ? 1 : 0) * fstride + (size_t)(kvrow < 0 ? 0 : kvrow) * 512;
#pragma unroll
                    for (int bj = 0; bj < 2; ++bj) {
                        const int col = (pn & 1) * 256 + bj * 128 + wc * 32 + fq * 8;
                        const f32x4 v0 = acc[ai][bj][m][0], v1 = acc[ai][bj][m][1];
                        v4u o; o.x = cvtpk(v0.x, v0.y); o.y = cvtpk(v0.z, v0.w); o.z = cvtpk(v1.x, v1.y); o.w = cvtpk(v1.z, v1.w);
                        *(v4u*)(dst + col) = o;
                        if (dof) { *(f32x4*)(fo + col) = v0; *(f32x4*)(fo + col + 4) = v1; }
                    }
                } else {
                    const int j = pn - 6;
                    const bool dof = cvrow >= 0;
                    float* fo = out + (samp ? O_CS : O_CP) + (size_t)(cvrow < 0 ? 0 : cvrow) * 512;
                    const int ch = j * 128 + wc * 32 + fq * 8;
                    f32x4 r[2];
#pragma unroll
                    for (int n = 0; n < 2; ++n) {
                        const f32x4 a = acc[ai][0][m][n], g = acc[ai][1][m][n];
                        r[n].x = a.x / (1.f + __expf(-g.x)); r[n].y = a.y / (1.f + __expf(-g.y)); r[n].z = a.z / (1.f + __expf(-g.z)); r[n].w = a.w / (1.f + __expf(-g.w));
                    }
                    v4u o; o.x = cvtpk(r[0].x, r[0].y); o.y = cvtpk(r[0].z, r[0].w); o.z = cvtpk(r[1].x, r[1].y); o.w = cvtpk(r[1].z, r[1].w);
                    *(v4u*)(gb + (size_t)row * 512 + ch) = o;
                    if (dof) { *(f32x4*)(fo + ch) = r[0]; *(f32x4*)(fo + ch + 4) = r[1]; }
                }
            }
    }
};
struct EpiResid {
    static constexpr bool PERM = true, AFTER_DRAIN = false;
    const bf16* XBp; bf16* H;
    __device__ __forceinline__ void operator()(const f32x4 (&acc)[2][2][4][2], const pg8::Unit& u, int wr, int wc, int fr, int fq) const {
#pragma unroll
        for (int ai = 0; ai < 2; ++ai)
#pragma unroll
            for (int m = 0; m < 4; ++m) {
                const int row = u.pm * 256 + ai * 128 + wr * 64 + m * 16 + fr;
#pragma unroll
                for (int bj = 0; bj < 2; ++bj) {
                    const int col = u.pn * 256 + bj * 128 + wc * 32 + fq * 8;
                    const v4u xv = *(const v4u*)(XBp + (size_t)row * DM + col);
                    const f32x4 a0 = acc[ai][bj][m][0], a1 = acc[ai][bj][m][1];
                    v4u o;
                    o.x = cvtpk(ALPHA * bflo(xv.x) + a0.x, ALPHA * bfhi(xv.x) + a0.y); o.y = cvtpk(ALPHA * bflo(xv.y) + a0.z, ALPHA * bfhi(xv.y) + a0.w);
                    o.z = cvtpk(ALPHA * bflo(xv.z) + a1.x, ALPHA * bfhi(xv.z) + a1.y); o.w = cvtpk(ALPHA * bflo(xv.w) + a1.z, ALPHA * bfhi(xv.w) + a1.w);
                    *(v4u*)(H + (size_t)row * DM + col) = o;
                }
            }
    }
};
struct EpiPlainBf16 {
    static constexpr bool PERM = true, AFTER_DRAIN = false;
    bf16* O; int ldc;
    __device__ __forceinline__ void operator()(const f32x4 (&acc)[2][2][4][2], const pg8::Unit& u, int wr, int wc, int fr, int fq) const {
#pragma unroll
        for (int ai = 0; ai < 2; ++ai)
#pragma unroll
            for (int m = 0; m < 4; ++m) {
                const int row = u.pm * 256 + ai * 128 + wr * 64 + m * 16 + fr;
#pragma unroll
                for (int bj = 0; bj < 2; ++bj) {
                    const int col = u.pn * 256 + bj * 128 + wc * 32 + fq * 8;
                    const f32x4 v0 = acc[ai][bj][m][0], v1 = acc[ai][bj][m][1];
                    v4u o; o.x = cvtpk(v0.x, v0.y); o.y = cvtpk(v0.z, v0.w); o.z = cvtpk(v1.x, v1.y); o.w = cvtpk(v1.z, v1.w);
                    *(v4u*)(O + (size_t)row * ldc + col) = o;
                }
            }
    }
};


__device__ __forceinline__ void conv_task(const __amdgpu_buffer_rsrc_t rs, unsigned gb_off, unsigned csb_off, const LAS float* wl, const float* cb, const float* lg, const float* lb, bf16* MIX, int task, int lane) {
    const bool samp = task >= 4096;
    const int b = samp ? task - 4096 : task >> 9, t0 = samp ? 0 : (task & 511) * 8;
    const size_t rowbase = samp ? (size_t)NP + (size_t)b * 8 : (size_t)b * 4096;
    f32x2_t acc2[8][4];
    f32x4 wA[8], wB[8];
#pragma unroll
    for (int tt = 0; tt < 8; ++tt) {
        wA[tt] = (f32x4){0.f, 0.f, 0.f, 0.f}; wB[tt] = (f32x4){0.f, 0.f, 0.f, 0.f};
#pragma unroll
        for (int c = 0; c < 4; ++c) acc2[tt][c] = (f32x2_t){0.f, 0.f};
    }
    v4u cur[16];
    const unsigned baseB = gb_off + (unsigned)((int)rowbase + t0 - 30) * 1024u;
    const unsigned baseA = samp ? csb_off + (unsigned)(b * 30) * 1024u : baseB;
    const int rmin = samp ? 0 : (30 - t0 > 0 ? 30 - t0 : 0);
#define CONV_LOADROW(RR, DST) do { const int rr_ = (RR); \
            const unsigned bs_ = rr_ < 30 ? baseA : baseB; const bool ok_ = (rr_ >= rmin) & (rr_ < 38); \
            const unsigned ro_ = ok_ ? bs_ + (unsigned)rr_ * 1024u : 0x80000000u; \
            DST = __builtin_amdgcn_raw_buffer_load_b128(rs, (int)(ro_ + lane16), 0, 0); } while (0)
    const unsigned lane16 = 16u * (unsigned)lane;
#pragma unroll
    for (int i = 0; i < 16; ++i) CONV_LOADROW(i, cur[i]);
    { const LAS f32x4* wp = (const LAS f32x4*)(wl + 8 * lane); wA[0] = wp[0]; wB[0] = wp[1]; }
#define CONV_FMA(I, TT) do { const int sl_ = ((I) - (TT)) & 7; \
                acc2[TT][0] = __builtin_elementwise_fma((f32x2_t){wA[sl_].x, wA[sl_].y}, x01, acc2[TT][0]); \
                acc2[TT][1] = __builtin_elementwise_fma((f32x2_t){wA[sl_].z, wA[sl_].w}, x23, acc2[TT][1]); \
                acc2[TT][2] = __builtin_elementwise_fma((f32x2_t){wB[sl_].x, wB[sl_].y}, x45, acc2[TT][2]); \
                acc2[TT][3] = __builtin_elementwise_fma((f32x2_t){wB[sl_].z, wB[sl_].w}, x67, acc2[TT][3]); } while (0)
#define CONV_ROW(I, RR, REFILL) do { const int rr = (RR); \
            const v4u u = cur[I]; \
            const f32x2_t x01 = {bflo(u.x), bfhi(u.x)}, x23 = {bflo(u.y), bfhi(u.y)}, x45 = {bflo(u.z), bfhi(u.z)}, x67 = {bflo(u.w), bfhi(u.w)}; \
            if (REFILL) CONV_LOADROW(rr + 16, cur[I]); \
            CONV_FMA(I, 7); \
            __builtin_amdgcn_sched_barrier(0); \
            { const int kk = rr + 1 > 31 ? 31 : rr + 1; const LAS f32x4* wp = (const LAS f32x4*)(wl + kk * 512 + 8 * lane); wA[((I) + 1) & 7] = wp[0]; wB[((I) + 1) & 7] = wp[1]; }     \
            __builtin_amdgcn_sched_barrier(0); \
            CONV_FMA(I, 0); CONV_FMA(I, 1); CONV_FMA(I, 2); CONV_FMA(I, 3); CONV_FMA(I, 4); CONV_FMA(I, 5); CONV_FMA(I, 6); \
            __builtin_amdgcn_sched_barrier(0); } while (0)
#pragma unroll 1
    for (int c0 = 0; c0 < 32; c0 += 16) {
#pragma unroll
        for (int i = 0; i < 16; ++i) CONV_ROW(i, c0 + i, true);
    }
#pragma unroll
    for (int i = 0; i < 8; ++i) CONV_ROW(i, 32 + i, false);
#undef CONV_ROW
#undef CONV_FMA
#undef CONV_LOADROW
    float acc[8][8];
#pragma unroll
    for (int tt = 0; tt < 8; ++tt)
#pragma unroll
        for (int c = 0; c < 4; ++c) { acc[tt][2 * c] = acc2[tt][c].x; acc[tt][2 * c + 1] = acc2[tt][c].y; }
    const f32x4 cb0 = *(const f32x4*)(cb + 8 * lane), cb1 = *(const f32x4*)(cb + 8 * lane + 4);
    const f32x4 lg0 = *(const f32x4*)(lg + 8 * lane), lg1 = *(const f32x4*)(lg + 8 * lane + 4);
    const f32x4 lb0 = *(const f32x4*)(lb + 8 * lane), lb1 = *(const f32x4*)(lb + 8 * lane + 4);
    const float cbv[8] = {cb0.x, cb0.y, cb0.z, cb0.w, cb1.x, cb1.y, cb1.z, cb1.w};
    const float lgv[8] = {lg0.x, lg0.y, lg0.z, lg0.w, lg1.x, lg1.y, lg1.z, lg1.w};
    const float lbv[8] = {lb0.x, lb0.y, lb0.z, lb0.w, lb1.x, lb1.y, lb1.z, lb1.w};
#pragma unroll
    for (int tt = 0; tt < 8; ++tt) {
        float y[8]; float s1 = 0.f;
#pragma unroll
        for (int c = 0; c < 8; ++c) { y[c] = acc[tt][c] + cbv[c]; s1 += y[c]; }
        const float mean = wave_sum(s1) * (1.f / 512.f);
        float s2 = 0.f;
#pragma unroll
        for (int c = 0; c < 8; ++c) { y[c] -= mean; s2 += y[c] * y[c]; }
        const float rstd = rsqrtf(wave_sum(s2) * (1.f / 512.f) + LN_EPS);
        float z[8];
#pragma unroll
        for (int c = 0; c < 8; ++c) { const float v = y[c] * rstd * lgv[c] + lbv[c]; z[c] = v / (1.f + __expf(-v)); }
        v4u o; o.x = cvtpk(z[0], z[1]); o.y = cvtpk(z[2], z[3]); o.z = cvtpk(z[4], z[5]); o.w = cvtpk(z[6], z[7]);
        *(v4u*)(MIX + (rowbase + t0 + tt) * 1024 + 512 + 8 * lane) = o;
    }
}

__device__ __forceinline__ void ln1_rows4(const bf16* H, bf16* X1B, const float* g, const float* bt, int r, int lane) {
    const v4u* hr = (const v4u*)(H + (size_t)r * DM) + 2 * lane;
    v4u hv[4][2];
#pragma unroll
    for (int u = 0; u < 4; ++u) { hv[u][0] = hr[u * 128]; hv[u][1] = hr[u * 128 + 1]; }
    const f32x4* gp = (const f32x4*)g + 4 * lane; const f32x4* bp = (const f32x4*)bt + 4 * lane;
    float gv[16], bv[16];
#pragma unroll
    for (int q = 0; q < 4; ++q) { const f32x4 a = gp[q], b = bp[q]; gv[4 * q] = a.x; gv[4 * q + 1] = a.y; gv[4 * q + 2] = a.z; gv[4 * q + 3] = a.w; bv[4 * q] = b.x; bv[4 * q + 1] = b.y; bv[4 * q + 2] = b.z; bv[4 * q + 3] = b.w; }
#pragma unroll
    for (int u = 0; u < 4; ++u) {
        float v[16];
#pragma unroll
        for (int k = 0; k < 2; ++k) { const v4u a = hv[u][k];
            v[8 * k] = bflo(a.x); v[8 * k + 1] = bfhi(a.x); v[8 * k + 2] = bflo(a.y); v[8 * k + 3] = bfhi(a.y); v[8 * k + 4] = bflo(a.z); v[8 * k + 5] = bfhi(a.z); v[8 * k + 6] = bflo(a.w); v[8 * k + 7] = bfhi(a.w); }
        float s = 0.f;
#pragma unroll
        for (int i = 0; i < 16; ++i) s += v[i];
        const float mean = wave_sum(s) * (1.f / DM); float s2 = 0.f;
#pragma unroll
        for (int i = 0; i < 16; ++i) { v[i] -= mean; s2 += v[i] * v[i]; }
        const float rstd = rsqrtf(wave_sum(s2) * (1.f / DM) + LN_EPS);
        float o[16];
#pragma unroll
        for (int i = 0; i < 16; ++i) o[i] = v[i] * rstd * gv[i] + bv[i];
        v4u w0, w1;
        w0.x = cvtpk(o[0], o[1]); w0.y = cvtpk(o[2], o[3]); w0.z = cvtpk(o[4], o[5]); w0.w = cvtpk(o[6], o[7]);
        w1.x = cvtpk(o[8], o[9]); w1.y = cvtpk(o[10], o[11]); w1.z = cvtpk(o[12], o[13]); w1.w = cvtpk(o[14], o[15]);
        v4u* od = (v4u*)(X1B + (size_t)(r + u) * DM) + 2 * lane; od[0] = w0; od[1] = w1;
    }
}

__device__ __forceinline__ unsigned f2key(float f) { const unsigned u = __float_as_uint(f); return (u & 0x80000000u) ? ~u : (u | 0x80000000u); }
__device__ __forceinline__ float key2f(unsigned k) { const unsigned u = (k & 0x80000000u) ? (k & 0x7fffffffu) : ~k; return __uint_as_float(u); }
__device__ __forceinline__ unsigned umax2(unsigned a, unsigned b) { return a > b ? a : b; }
__device__ __forceinline__ unsigned umin2(unsigned a, unsigned b) { return a < b ? a : b; }

typedef short bf16x8_t __attribute__((ext_vector_type(8)));
typedef float f32x16_t __attribute__((ext_vector_type(16)));
typedef short s16x4_t __attribute__((ext_vector_type(4)));
__device__ __forceinline__ int crow(int r, int hi) { return (r & 3) + 8 * (r >> 2) + 4 * hi; }
__device__ __forceinline__ s16x4_t vtr(const LAS unsigned char* p) { return __builtin_bit_cast(s16x4_t, __builtin_amdgcn_ds_read_tr16_b64_v4i16((LAS s16x4_t*)p)); }
struct AttnArgs { const bf16* QB; const bf16* KB; const bf16* VB; const float* ck; const float* cv; const float* out; bf16* OP; float* LSE; };
__device__ __forceinline__ bf16x8_t cvt8(const f32x4 a, const f32x4 b) { const v4u u = {cvtpk(a.x, a.y), cvtpk(a.z, a.w), cvtpk(b.x, b.y), cvtpk(b.z, b.w)}; return __builtin_bit_cast(bf16x8_t, u); }
template <bool SAMP, bool FULL>
__device__ __forceinline__ void attn_mfma_task(const AttnArgs& A, int task, LAS unsigned char* vbuf, int lane) {
    int b, h, br, res, i0, nq;
    if constexpr (!SAMP) {
        const int ti = task & 127; int rest = task >> 7; br = rest % 3; rest /= 3; h = rest & 7; b = rest >> 3;
        const int sh_ = 2 * br; res = ti >> (7 - sh_); i0 = (ti & ((128 >> sh_) - 1)) * 32; nq = 32;
    } else {
        const int sub = task % 13; int rest = task / 13; h = rest & 7; b = rest >> 3;
        if (sub == 0) { br = 0; res = 0; i0 = 2048; nq = 8; } else if (sub < 5) { br = 1; res = sub - 1; i0 = 512; nq = 2; } else { br = 2; res = sub - 5; i0 = 128; nq = 1; }
    }
    const int sh = 2 * br;
    const int q = lane & 31, hi = lane >> 5;
    const size_t rowb = (size_t)b * 4096;
    auto srow = [&](const float* cache, size_t onew, int pp) -> const float* {
        const int pc = pp > 2055 ? 2055 : pp;
        return pc < LB ? cache + ((size_t)b * 2048 + pc) * 512 + h * 64 : A.out + onew + ((size_t)b * 2048 + pc - 8) * 512 + h * 64;
    };
    const int iq = i0 + (q < nq ? q : nq - 1);
    const int posq = res + (iq << sh);
    const size_t qrow = SAMP ? (size_t)NP + (size_t)b * 8 + (posq - LB) : rowb + posq;
    bf16x8_t qf[4];
    { const bf16* qp = A.QB + qrow * 512 + h * 64 + 8 * hi;
#pragma unroll
      for (int ks = 0; ks < 4; ++ks) qf[ks] = *(const bf16x8_t*)(qp + 16 * ks); }
    const int tstart = FULL ? 0 : (i0 >= 128 ? 0 : ((128 - i0) >> 5));
    const int vc = lane & 7, vr = lane >> 3;
    const int vdst = (vc >> 2) * 2048 + vr * 64 + (vc & 3) * 16;
    v4u vreg[4];
    auto loadv = [&](int t) {
#pragma unroll
        for (int i_ = 0; i_ < 4; ++i_) {
            const int j_ = i0 - 128 + 32 * t + vr + 8 * i_;
            if constexpr (!SAMP) { vreg[i_] = *(const v4u*)(A.VB + (rowb + res + ((size_t)j_ << sh)) * 512 + h * 64 + 8 * vc); }
            else { const f32x4* vp_ = (const f32x4*)(srow(A.cv, O_VS, res + (j_ << sh)) + 8 * vc); vreg[i_] = __builtin_bit_cast(v4u, cvt8(vp_[0], vp_[1])); }
        }
    };
    if (tstart == 0) loadv(0); else if (tstart == 1) loadv(1); else if (tstart == 2) loadv(2); else if (tstart == 3) loadv(3); else loadv(4);
    f32x16_t sc[5];
    float mx = -INFINITY;
    bf16x8_t kall[FULL ? 5 : 1][4];
    if constexpr (FULL) {
#pragma unroll
        for (int t = 0; t < 5; ++t) {
            const int j = i0 - 128 + 32 * t + q;
            if constexpr (!SAMP) {
                const bf16* kp = A.KB + (rowb + res + ((size_t)j << sh)) * 512 + h * 64 + 8 * hi;
#pragma unroll
                for (int ks = 0; ks < 4; ++ks) kall[t][ks] = *(const bf16x8_t*)(kp + 16 * ks);
            } else {
                const f32x4* kp = (const f32x4*)(srow(A.ck, O_KS, res + (j << sh)) + 8 * hi);
#pragma unroll
                for (int ks = 0; ks < 4; ++ks) kall[t][ks] = cvt8(kp[4 * ks], kp[4 * ks + 1]);
            }
        }
        __builtin_amdgcn_sched_barrier(0);
    }
#pragma unroll
    for (int t = 0; t < 5; ++t) {
        if (t >= tstart) {
            const int j = i0 - 128 + 32 * t + q;
            bf16x8_t kf[4];
            if constexpr (FULL) {
#pragma unroll
                for (int ks = 0; ks < 4; ++ks) kf[ks] = kall[t][ks];
            } else if constexpr (!SAMP) {
                const bf16* kp = A.KB + (rowb + res + ((size_t)j << sh)) * 512 + h * 64 + 8 * hi;
#pragma unroll
                for (int ks = 0; ks < 4; ++ks) kf[ks] = *(const bf16x8_t*)(kp + 16 * ks);
            } else {
                const f32x4* kp = (const f32x4*)(srow(A.ck, O_KS, res + (j << sh)) + 8 * hi);
#pragma unroll
                for (int ks = 0; ks < 4; ++ks) kf[ks] = cvt8(kp[4 * ks], kp[4 * ks + 1]);
            }
            f32x16_t a = {0.f, 0.f, 0.f, 0.f, 0.f, 0.f, 0.f, 0.f, 0.f, 0.f, 0.f, 0.f, 0.f, 0.f, 0.f, 0.f};
#pragma unroll
            for (int ks = 0; ks < 4; ++ks) a = __builtin_amdgcn_mfma_f32_32x32x16_bf16(kf[ks], qf[ks], a, 0, 0, 0);
#pragma unroll
            for (int r = 0; r < 16; ++r) {
                float v = a[r] * 0.125f;
                if (t == 0) { if (crow(r, hi) < q) v = -INFINITY; }
                if (t == 4) { if (crow(r, hi) > q) v = -INFINITY; }
                a[r] = v; mx = fmaxf(mx, v);
            }
            sc[t] = a;
        } else {
#pragma unroll
            for (int r = 0; r < 16; ++r) sc[t][r] = -INFINITY;
        }
    }
    mx = fmaxf(mx, __shfl_xor(mx, 32));
    float l = 0.f;
#pragma unroll
    for (int t = 0; t < 5; ++t)
#pragma unroll
        for (int r = 0; r < 16; ++r) { const float pv = __expf(sc[t][r] - mx); sc[t][r] = pv; l += pv; }
    l += __shfl_xor(l, 32);
    f32x16_t o0 = {0.f, 0.f, 0.f, 0.f, 0.f, 0.f, 0.f, 0.f, 0.f, 0.f, 0.f, 0.f, 0.f, 0.f, 0.f, 0.f}, o1 = o0;
    const int vb = ((lane >> 4) & 1) * 32 + (lane & 3) * 8 + (4 * hi + ((lane & 15) >> 2)) * 64;
#pragma unroll
    for (int t = 0; t < 5; ++t) {
        if (t >= tstart) {
            LAS unsigned char* buf = vbuf + (t & 1) * 4096;
#pragma unroll
            for (int i = 0; i < 4; ++i) *(LAS v4u*)(buf + vdst + i * 512) = vreg[i];
            if (t < 4) loadv(t + 1);
            LDS_WAIT();
            unsigned pw_[8];
#pragma unroll
            for (int k = 0; k < 8; ++k) pw_[k] = cvtpk(sc[t][2 * k], sc[t][2 * k + 1]);
            const v4u pa0u = {pw_[0], pw_[1], pw_[2], pw_[3]}, pa1u = {pw_[4], pw_[5], pw_[6], pw_[7]};
            const bf16x8_t pa0 = __builtin_bit_cast(bf16x8_t, pa0u), pa1 = __builtin_bit_cast(bf16x8_t, pa1u);
            const LAS unsigned char* vp = buf + vb;
            s16x4_t lo, hh;
#define ATT_VFR() (bf16x8_t){lo[0], lo[1], lo[2], lo[3], hh[0], hh[1], hh[2], hh[3]}
            lo = vtr(vp);               hh = vtr(vp + 512);         o0 = __builtin_amdgcn_mfma_f32_32x32x16_bf16(pa0, ATT_VFR(), o0, 0, 0, 0);
            lo = vtr(vp + 1024);        hh = vtr(vp + 1024 + 512);  o0 = __builtin_amdgcn_mfma_f32_32x32x16_bf16(pa1, ATT_VFR(), o0, 0, 0, 0);
            lo = vtr(vp + 2048);        hh = vtr(vp + 2048 + 512);  o1 = __builtin_amdgcn_mfma_f32_32x32x16_bf16(pa0, ATT_VFR(), o1, 0, 0, 0);
            lo = vtr(vp + 3072);        hh = vtr(vp + 3072 + 512);  o1 = __builtin_amdgcn_mfma_f32_32x32x16_bf16(pa1, ATT_VFR(), o1, 0, 0, 0);
#undef ATT_VFR
            LDS_WAIT();
        }
    }
    const float rl = 1.f / l;
#pragma unroll
    for (int r = 0; r < 16; ++r) {
        const int qq = crow(r, hi);
        const float ri = __shfl(rl, qq);
        const int pp = res + ((i0 + qq) << sh);
        const size_t orow_ = SAMP ? (size_t)NP + (size_t)b * 8 + (pp - LB) : rowb + pp;
        if (qq < nq) {
            bf16* orow = A.OP + ((size_t)br * NTOK + orow_) * 512 + h * 64 + q;
            orow[0] = (bf16)(cvtpk(o0[r] * ri, 0.f) & 0xffffu);
            orow[32] = (bf16)(cvtpk(o1[r] * ri, 0.f) & 0xffffu);
        }
    }
    if (hi == 0 && q < nq) A.LSE[((size_t)br * NTOK + qrow) * 8 + h] = mx + __logf(l);
}
constexpr int ATT_KIMG = 0, ATT_VIMG = 49152, ATT_VPLANE = 24576, ATT_OTILE = 98304;
__device__ __forceinline__ void attn_block_phase(const AttnArgs& A, LAS unsigned char* lds, int G, int tid, int wave, int lane) {
    constexpr int NUNIT = NPB * NH * 3 * 16;
    asm volatile("" : "+v"(lane));
    const int q = lane & 31, hi = lane >> 5;
    const int srow0 = wave * 8 + (lane >> 3), sch = lane & 7;
    v4u pk_[6], pv_[6];
    auto decode = [&](int unit, int& b, int& h, int& br, int& res, int& i0u) {
        const int uu = unit & 15; int rest = unit >> 4; br = rest % 3; rest /= 3; h = rest & 7; b = rest >> 3;
        const int sh_ = 2 * br, upr = 16 >> sh_; res = uu / upr; i0u = (uu % upr) * 256;
    };
    auto request = [&](int unit) {
        int b, h, br, res, i0u; decode(unit, b, h, br, res, i0u); const int sh = 2 * br; const size_t rowb = (size_t)b * 4096;
#pragma unroll
        for (int p_ = 0; p_ < 6; ++p_) {
            const int row = srow0 + 64 * p_, j = i0u - 128 + row;
            if (j >= 0) { const size_t o = (rowb + res + ((size_t)j << sh)) * 512 + h * 64 + 8 * sch; pk_[p_] = *(const v4u*)(A.KB + o); pv_[p_] = *(const v4u*)(A.VB + o); }
        }
    };
    auto commit = [&](int unit) {
        int b, h, br, res, i0u; decode(unit, b, h, br, res, i0u);
#pragma unroll
        for (int p_ = 0; p_ < 6; ++p_) {
            const int row = srow0 + 64 * p_, j = i0u - 128 + row;
            if (j >= 0) {
                *(LAS v4u*)(lds + ATT_KIMG + row * 128 + ((sch ^ (row & 7)) << 4)) = pk_[p_];
                *(LAS v4u*)(lds + ATT_VIMG + (sch >> 2) * ATT_VPLANE + row * 64 + (sch & 3) * 16) = pv_[p_];
            }
        }
    };
    int unit = (int)blockIdx.x;
    if (unit < NUNIT) request(unit);
    bf16x8_t qf[4];
    auto request_q = [&](int u_) {
        int b, h, br, res, i0u; decode(u_, b, h, br, res, i0u); const int sh = 2 * br; const size_t rowb = (size_t)b * 4096;
        const bf16* qp = A.QB + (rowb + res + ((size_t)(i0u + 32 * wave + q) << sh)) * 512 + h * 64 + 8 * hi;
#pragma unroll
        for (int ks = 0; ks < 4; ++ks) qf[ks] = *(const bf16x8_t*)(qp + 16 * ks);
    };
    if (unit < NUNIT) request_q(unit);
    constexpr float SC2 = 0.125f * 1.4426950408889634f;
    for (; unit < NUNIT; unit += G) {
        int b, h, br, res, i0u; decode(unit, b, h, br, res, i0u); const int sh = 2 * br; const size_t rowb = (size_t)b * 4096;
        __syncthreads();
        commit(unit);
        __syncthreads();
        if (unit + G < NUNIT) request(unit + G);
        const int i0 = i0u + 32 * wave;
        const int tstart = i0 >= 128 ? 0 : ((128 - i0) >> 5);
        f32x16_t sc[5]; float mx = -INFINITY;
#pragma unroll
        for (int t = 0; t < 5; ++t) {
            if (t >= tstart) {
                const int row = 32 * (wave + t) + q;
                bf16x8_t kf[4];
#pragma unroll
                for (int ks = 0; ks < 4; ++ks) kf[ks] = *(const LAS bf16x8_t*)(lds + ATT_KIMG + row * 128 + (((2 * ks + hi) ^ (row & 7)) << 4));
                f32x16_t a = {0.f, 0.f, 0.f, 0.f, 0.f, 0.f, 0.f, 0.f, 0.f, 0.f, 0.f, 0.f, 0.f, 0.f, 0.f, 0.f};
#pragma unroll
                for (int ks = 0; ks < 4; ++ks) a = __builtin_amdgcn_mfma_f32_32x32x16_bf16(kf[ks], qf[ks], a, 0, 0, 0);
#pragma unroll
                for (int r = 0; r < 16; ++r) {
                    float v = a[r];
                    if (t == 0) { if (crow(r, hi) < q) v = -INFINITY; }
                    if (t == 4) { if (crow(r, hi) > q) v = -INFINITY; }
                    a[r] = v; mx = fmaxf(mx, v);
                }
                sc[t] = a;
            } else {
#pragma unroll
                for (int r = 0; r < 16; ++r) sc[t][r] = -INFINITY;
            }
        }
        if (unit + G < NUNIT) request_q(unit + G);
        mx = fmaxf(mx, __shfl_xor(mx, 32));
        const float mb = mx * SC2;
        float l = 0.f;
        unsigned pkp[5][8];
#pragma unroll
        for (int t = 0; t < 5; ++t)
#pragma unroll
            for (int k = 0; k < 8; ++k) { const float p0 = __builtin_amdgcn_exp2f(fmaf(sc[t][2 * k], SC2, -mb)), p1 = __builtin_amdgcn_exp2f(fmaf(sc[t][2 * k + 1], SC2, -mb)); l += p0 + p1; pkp[t][k] = cvtpk(p0, p1); }
        l += __shfl_xor(l, 32);
        f32x16_t o0 = {0.f, 0.f, 0.f, 0.f, 0.f, 0.f, 0.f, 0.f, 0.f, 0.f, 0.f, 0.f, 0.f, 0.f, 0.f, 0.f}, o1 = o0;
        const int vb = ((lane >> 4) & 1) * 32 + (lane & 3) * 8 + (4 * hi + ((lane & 15) >> 2)) * 64;
#pragma unroll
        for (int t = 0; t < 5; ++t) {
            if (t >= tstart) {
                const v4u pa0u = {pkp[t][0], pkp[t][1], pkp[t][2], pkp[t][3]}, pa1u = {pkp[t][4], pkp[t][5], pkp[t][6], pkp[t][7]};
                const bf16x8_t pa0 = __builtin_bit_cast(bf16x8_t, pa0u), pa1 = __builtin_bit_cast(bf16x8_t, pa1u);
                const LAS unsigned char* vp = lds + ATT_VIMG + 32 * (wave + t) * 64 + vb;
                s16x4_t lo, hh;
#define ATT_VFR() (bf16x8_t){lo[0], lo[1], lo[2], lo[3], hh[0], hh[1], hh[2], hh[3]}
                lo = vtr(vp);                      hh = vtr(vp + 512);                      o0 = __builtin_amdgcn_mfma_f32_32x32x16_bf16(ATT_VFR(), pa0, o0, 0, 0, 0);
                lo = vtr(vp + 1024);               hh = vtr(vp + 1024 + 512);               o0 = __builtin_amdgcn_mfma_f32_32x32x16_bf16(ATT_VFR(), pa1, o0, 0, 0, 0);
                lo = vtr(vp + ATT_VPLANE);         hh = vtr(vp + ATT_VPLANE + 512);         o1 = __builtin_amdgcn_mfma_f32_32x32x16_bf16(ATT_VFR(), pa0, o1, 0, 0, 0);
                lo = vtr(vp + ATT_VPLANE + 1024);  hh = vtr(vp + ATT_VPLANE + 1024 + 512);  o1 = __builtin_amdgcn_mfma_f32_32x32x16_bf16(ATT_VFR(), pa1, o1, 0, 0, 0);
#undef ATT_VFR
            }
        }
        const float rl = 1.f / l;
        const size_t orow_ = rowb + res + ((size_t)(i0 + q) << sh);
        {
            LAS unsigned char* ot = lds + ATT_OTILE + wave * 4096;
            const int fq_ = (q >> 1) & 7;
#pragma unroll
            for (int g = 0; g < 4; ++g) {
                v2u w0, w1;
                w0.x = cvtpk(o0[4 * g] * rl, o0[4 * g + 1] * rl); w0.y = cvtpk(o0[4 * g + 2] * rl, o0[4 * g + 3] * rl);
                w1.x = cvtpk(o1[4 * g] * rl, o1[4 * g + 1] * rl); w1.y = cvtpk(o1[4 * g + 2] * rl, o1[4 * g + 3] * rl);
                *(LAS v2u*)(ot + q * 128 + ((g ^ fq_) << 4) + 8 * hi) = w0;
                *(LAS v2u*)(ot + q * 128 + (((4 + g) ^ fq_) << 4) + 8 * hi) = w1;
            }
            LDS_WAIT();
#pragma unroll
            for (int i = 0; i < 4; ++i) {
                const int r = 8 * i + (lane >> 3), c = lane & 7;
                const v4u w = *(const LAS v4u*)(ot + r * 128 + ((c ^ ((r >> 1) & 7)) << 4));
                *(v4u*)(A.OP + ((size_t)br * NTOK + rowb + res + ((size_t)(i0 + r) << sh)) * 512 + h * 64 + 8 * c) = w;
            }
            LDS_WAIT();
        }
        if (hi == 0) A.LSE[((size_t)br * NTOK + orow_) * 8 + h] = mx * 0.125f + __logf(l);
    }
}
__device__ __forceinline__ void attn_merge_row(const bf16* OP, const float* LSE, bf16* MIX, int r, int lane) {
    const int h = lane >> 3;
    const float l0 = LSE[((size_t)0 * NTOK + r) * 8 + h], l1 = LSE[((size_t)1 * NTOK + r) * 8 + h], l2 = LSE[((size_t)2 * NTOK + r) * 8 + h];
    const float m = fmaxf(l0, fmaxf(l1, l2));
    float w0 = __expf(l0 - m), w1 = __expf(l1 - m), w2 = __expf(l2 - m);
    const float inv = 1.f / (w0 + w1 + w2); w0 *= inv; w1 *= inv; w2 *= inv;
    const v4u a = *(const v4u*)(OP + ((size_t)0 * NTOK + r) * 512 + 8 * lane), bq = *(const v4u*)(OP + ((size_t)1 * NTOK + r) * 512 + 8 * lane), c = *(const v4u*)(OP + ((size_t)2 * NTOK + r) * 512 + 8 * lane);
    v4u o;
    o.x = cvtpk(w0 * bflo(a.x) + w1 * bflo(bq.x) + w2 * bflo(c.x), w0 * bfhi(a.x) + w1 * bfhi(bq.x) + w2 * bfhi(c.x));
    o.y = cvtpk(w0 * bflo(a.y) + w1 * bflo(bq.y) + w2 * bflo(c.y), w0 * bfhi(a.y) + w1 * bfhi(bq.y) + w2 * bfhi(c.y));
    o.z = cvtpk(w0 * bflo(a.z) + w1 * bflo(bq.z) + w2 * bflo(c.z), w0 * bfhi(a.z) + w1 * bfhi(bq.z) + w2 * bfhi(c.z));
    o.w = cvtpk(w0 * bflo(a.w) + w1 * bflo(bq.w) + w2 * bflo(c.w), w0 * bfhi(a.w) + w1 * bfhi(bq.w) + w2 * bfhi(c.w));
    *(v4u*)(MIX + (size_t)r * 1024 + 8 * lane) = o;
}

__device__ __forceinline__ void cswap(unsigned& a, unsigned& b) { const unsigned hi_ = a > b ? a : b, lo_ = a > b ? b : a; a = hi_; b = lo_; }
__device__ __forceinline__ void sort16_desc(unsigned (&x)[16]) {
#pragma unroll
    for (int k = 2; k <= 16; k <<= 1)
#pragma unroll
        for (int j = k >> 1; j > 0; j >>= 1)
#pragma unroll
            for (int i = 0; i < 16; ++i) { const int l = i ^ j; if (l > i) { if ((i & k) == 0) cswap(x[i], x[l]); else cswap(x[l], x[i]); } }
}
__device__ __forceinline__ void merge16_desc(unsigned (&a)[16], const unsigned (&b)[16]) {
#pragma unroll
    for (int i = 0; i < 16; ++i) a[i] = umax2(a[i], b[15 - i]);
#pragma unroll
    for (int j = 8; j > 0; j >>= 1)
#pragma unroll
        for (int i = 0; i < 16; ++i) { const int l = i ^ j; if (l > i) cswap(a[i], a[l]); }
}
__device__ __forceinline__ void pair_merge16(unsigned (&a)[16]) {
    unsigned pb[16];
#pragma unroll
    for (int i = 0; i < 16; ++i) pb[i] = (unsigned)__shfl_xor((int)a[i], 32);
    merge16_desc(a, pb);
}
struct CacheCopy { const f32x4* ck; const f32x4* cv; f32x4* ok; f32x4* ov; };
__device__ __forceinline__ void top16_of_half(const bf16* PQ, const LAS unsigned char* skl, int token0, int h, int p, int lane, unsigned (&top)[16], const CacheCopy& cc, int slot0) {
    const int tok = lane & 31, hi = lane >> 5;
    const bf16* qp = PQ + (size_t)(token0 + tok) * PQD + h * 256 + p * 128 + 8 * hi;
    bf16x8_t bq[8];
#pragma unroll
    for (int ks = 0; ks < 8; ++ks) bq[ks] = *(const bf16x8_t*)(qp + 16 * ks);
    unsigned g0[16];
    constexpr long CPB = 2040L * 128, CTOT = NSB * CPB;
    int ci[2]; f32x4 ca[2], cb[2];
#pragma unroll 1
    for (int kt = 0; kt < 4; ++kt) {
        if (kt > 0) {
#pragma unroll
            for (int u = 0; u < 2; ++u) { cc.ok[ci[u]] = ca[u]; cc.ov[ci[u]] = cb[u]; }
        }
#pragma unroll
        for (int u = 0; u < 2; ++u) {
            int idx = (slot0 + kt) * 128 + lane + 64 * u; if (idx >= (int)CTOT) idx = (int)CTOT - 1;
            const int b = idx / (int)CPB, rem = idx - b * (int)CPB; ci[u] = b * 2048 * 128 + rem; ca[u] = cc.ck[ci[u] + 8 * 128]; cb[u] = cc.cv[ci[u] + 8 * 128];
        }
        f32x16_t a = {0.f, 0.f, 0.f, 0.f, 0.f, 0.f, 0.f, 0.f, 0.f, 0.f, 0.f, 0.f, 0.f, 0.f, 0.f, 0.f};
#pragma unroll
        for (int ks = 0; ks < 8; ++ks) { const int row = p * 128 + 32 * kt + tok; const bf16x8_t ka = *(const LAS bf16x8_t*)(skl + row * 256 + (((2 * ks + hi) ^ (row & 15)) << 4)); a = __builtin_amdgcn_mfma_f32_32x32x16_bf16(ka, bq[ks], a, 0, 0, 0); }
        unsigned x[16];
#pragma unroll
        for (int r = 0; r < 16; ++r) x[r] = (f2key(a[r]) & ~127u) | (unsigned)(32 * kt + crow(r, hi));
        sort16_desc(x);
        if (kt == 0) {
#pragma unroll
            for (int i = 0; i < 16; ++i) g0[i] = x[i];
        } else { merge16_desc(g0, x); }
    }
    pair_merge16(g0);
#pragma unroll
    for (int u = 0; u < 2; ++u) { cc.ok[ci[u]] = ca[u]; cc.ov[ci[u]] = cb[u]; }
#pragma unroll
    for (int i = 0; i < 16; ++i) top[i] = g0[i];
}
__device__ __forceinline__ void topk_mfma_task(const bf16* PQ, const LAS unsigned char* skl, int* IDX, float* GATE, int tile, int h, int lane, const CacheCopy& cc) {
    const int token0 = tile * 32;
    const int tok = lane & 31, hi = lane >> 5;
    unsigned t0[16], t1[16];
    const int slot0 = (tile * 8 + h) * 8;
    top16_of_half(PQ, skl, token0, h, 0, lane, t0, cc, slot0);
    top16_of_half(PQ, skl, token0, h, 1, lane, t1, cc, slot0 + 4);
    float v0[16], v1[16];
#pragma unroll
    for (int i = 0; i < 16; ++i) { v0[i] = key2f(t0[i] & ~127u); v1[i] = key2f(t1[i] & ~127u); }
    unsigned ca[16], cb[16];
#define CAND(dst, i0_, j0_, i1_, j1_, pad1) do { const float a_ = hi ? v0[i1_] : v0[i0_], b_ = hi ? v1[j1_] : v1[j0_]; \
        const unsigned pa_ = hi ? (t0[i1_] & 127u) : (t0[i0_] & 127u), pb_ = hi ? (t1[j1_] & 127u) : (t1[j0_] & 127u); \
        const unsigned fx_ = umin2((unsigned)fmaxf(fmaf(a_ + b_, 4096.f, 131072.5f), 0.f), 262143u);     \
        const unsigned k_ = (fx_ << 14) | (pa_ << 7) | pb_; dst = ((pad1) && hi) ? 0u : k_; } while (0)
    CAND(ca[0], 0, 0, 1, 0, 0);  CAND(ca[1], 0, 1, 1, 1, 0);  CAND(ca[2], 0, 2, 1, 2, 0);  CAND(ca[3], 0, 3, 1, 3, 0);
    CAND(ca[4], 0, 4, 1, 4, 0);  CAND(ca[5], 0, 5, 1, 5, 0);  CAND(ca[6], 0, 6, 1, 6, 0);  CAND(ca[7], 0, 7, 1, 7, 0);
    CAND(ca[8], 0, 8, 3, 0, 0);  CAND(ca[9], 0, 9, 3, 1, 0);  CAND(ca[10], 0, 10, 3, 2, 0); CAND(ca[11], 0, 11, 3, 3, 0);
    CAND(ca[12], 0, 12, 5, 0, 0); CAND(ca[13], 0, 13, 5, 1, 0); CAND(ca[14], 0, 14, 6, 0, 0); CAND(ca[15], 0, 15, 6, 1, 0);
    CAND(cb[0], 2, 0, 7, 0, 0);  CAND(cb[1], 2, 1, 7, 1, 0);  CAND(cb[2], 2, 2, 0, 0, 1);  CAND(cb[3], 2, 3, 0, 0, 1);
    CAND(cb[4], 2, 4, 0, 0, 1);  CAND(cb[5], 4, 0, 0, 0, 1);  CAND(cb[6], 4, 1, 0, 0, 1);  CAND(cb[7], 4, 2, 0, 0, 1);
    CAND(cb[8], 8, 0, 0, 0, 1);  CAND(cb[9], 9, 0, 0, 0, 1);  CAND(cb[10], 10, 0, 0, 0, 1); CAND(cb[11], 11, 0, 0, 0, 1);
    CAND(cb[12], 12, 0, 0, 0, 1); CAND(cb[13], 13, 0, 0, 0, 1); CAND(cb[14], 14, 0, 0, 0, 1); CAND(cb[15], 15, 0, 0, 0, 1);
#undef CAND
    sort16_desc(ca); sort16_desc(cb);
    merge16_desc(ca, cb);
    pair_merge16(ca);
    float g[16]; float sum = 0.f;
    const float gm = (float)(ca[0] >> 14);
#pragma unroll
    for (int k = 0; k < 16; ++k) { g[k] = __expf(((float)(ca[k] >> 14) - gm) * (1.f / 4096.f)); sum += g[k]; }
    const float inv = 1.f / sum;
    v4u e0, e1; f32x4 g0, g1;
    e0.x = (hi ? ca[8] : ca[0]) & 0x3fffu; e0.y = (hi ? ca[9] : ca[1]) & 0x3fffu; e0.z = (hi ? ca[10] : ca[2]) & 0x3fffu; e0.w = (hi ? ca[11] : ca[3]) & 0x3fffu;
    e1.x = (hi ? ca[12] : ca[4]) & 0x3fffu; e1.y = (hi ? ca[13] : ca[5]) & 0x3fffu; e1.z = (hi ? ca[14] : ca[6]) & 0x3fffu; e1.w = (hi ? ca[15] : ca[7]) & 0x3fffu;
    g0.x = (hi ? g[8] : g[0]) * inv; g0.y = (hi ? g[9] : g[1]) * inv; g0.z = (hi ? g[10] : g[2]) * inv; g0.w = (hi ? g[11] : g[3]) * inv;
    g1.x = (hi ? g[12] : g[4]) * inv; g1.y = (hi ? g[13] : g[5]) * inv; g1.z = (hi ? g[14] : g[6]) * inv; g1.w = (hi ? g[15] : g[7]) * inv;
    const size_t o = (size_t)(token0 + tok) * 128 + h * 16 + 8 * hi;
    *(v4u*)(IDX + o) = e0; *(v4u*)(IDX + o + 4) = e1;
    *(f32x4*)(GATE + o) = g0; *(f32x4*)(GATE + o + 4) = g1;
}

__device__ __forceinline__ float gelu_erf(float x) { return 0.5f * x * (1.f + erff(x * 0.70710678118654752f)); }
__device__ __forceinline__ int rdlane_i(int v, int l) { return __builtin_amdgcn_readlane(v, l); }
__device__ __forceinline__ float rdlane_f(float v, int l) { return __int_as_float(__builtin_amdgcn_readlane(__float_as_int(v), l)); }
__device__ __forceinline__ void peer_finish_token6(f32x2_t (&acc2)[16], const bf16* X1B, const float* g2, const float* b2, float* Y, int r, int lane) {
    const int lp = lane & 31, hf = lane >> 5;
    float acc[32];
#pragma unroll
    for (int i = 0; i < 16; ++i) { acc[2 * i] = acc2[i].x; acc[2 * i + 1] = acc2[i].y; }
#pragma unroll
    for (int i = 0; i < 32; ++i) acc[i] += __shfl_xor(acc[i], 32);
    const v4u* hp = (const v4u*)(X1B + (size_t)r * DM) + 4 * lp;
    float z[32];
#pragma unroll
    for (int k = 0; k < 4; ++k) { const v4u a = hp[k];
        z[8 * k + 0] = bflo(a.x); z[8 * k + 1] = bfhi(a.x); z[8 * k + 2] = bflo(a.y); z[8 * k + 3] = bfhi(a.y); z[8 * k + 4] = bflo(a.z); z[8 * k + 5] = bfhi(a.z); z[8 * k + 6] = bflo(a.w); z[8 * k + 7] = bfhi(a.w); }
    float s = 0.f;
#pragma unroll
    for (int i = 0; i < 32; ++i) { z[i] = ALPHA * z[i] + acc[i]; s += z[i]; }
    const float mean = wave_sum(s) * (0.5f / DM); float s2 = 0.f;
#pragma unroll
    for (int i = 0; i < 32; ++i) { z[i] -= mean; s2 += z[i] * z[i]; }
    const float rstd = rsqrtf(wave_sum(s2) * (0.5f / DM) + LN_EPS);
    const int c0 = 32 * lp + 16 * hf;
    const f32x4* gp = (const f32x4*)(g2 + c0); const f32x4* bp = (const f32x4*)(b2 + c0);
    f32x4* yp = (f32x4*)(Y + (size_t)r * DM + c0);
#pragma unroll
    for (int q = 0; q < 4; ++q) {
        const f32x4 gv = gp[q], bv = bp[q];
        f32x4 o;
        o.x = (hf ? z[16 + 4 * q] : z[4 * q]) * rstd * gv.x + bv.x; o.y = (hf ? z[16 + 4 * q + 1] : z[4 * q + 1]) * rstd * gv.y + bv.y;
        o.z = (hf ? z[16 + 4 * q + 2] : z[4 * q + 2]) * rstd * gv.z + bv.z; o.w = (hf ? z[16 + 4 * q + 3] : z[4 * q + 3]) * rstd * gv.w + bv.w;
        yp[q] = o;
    }
}
__device__ __forceinline__ void peer_phase6(const bf16* X1B, const int* IDX, const float* GATE, const unsigned char* EU6, const unsigned char* EV6, const float* SU, const float* SV,
                                            const float* g2, const float* b2, float* Y, int gw, int NGW, int lane, LAS unsigned char* wl, LAS unsigned char* lds0, int wave, int nblk) {
    constexpr int TT = 2;
    LAS unsigned char* xl = wl;
    LAS v2u* Q = (LAS v2u*)(wl + TT * 4096);
    const __amdgpu_buffer_rsrc_t rsu = __builtin_amdgcn_make_buffer_rsrc((void*)EU6, 0, 16384 * 768, 0x00020000);
    const __amdgpu_buffer_rsrc_t rsv = __builtin_amdgcn_make_buffer_rsrc((void*)EV6, 0, 16384 * 768, 0x00020000);
    const int full = NTOK / (TT * NGW);
#define P6_XSTORE(BASE, A, B) do { LAS f32x4* xd_ = (LAS f32x4*)(BASE) + (4 * (lane & 1)) * 32 + (lane >> 1); \
        f32x4 f_; f_.x = bflo(A.x); f_.y = bfhi(A.x); f_.z = bflo(A.y); f_.w = bfhi(A.y); xd_[0] = f_; \
        f_.x = bflo(A.z); f_.y = bfhi(A.z); f_.z = bflo(A.w); f_.w = bfhi(A.w); xd_[32] = f_; \
        f_.x = bflo(B.x); f_.y = bfhi(B.x); f_.z = bflo(B.y); f_.w = bfhi(B.y); xd_[64] = f_; \
        f_.x = bflo(B.z); f_.y = bfhi(B.z); f_.z = bflo(B.w); f_.w = bfhi(B.w); xd_[96] = f_; } while (0)
#pragma unroll 1
    for (int pass = 0; pass < full; ++pass) {
        asm volatile("" : "+v"(lane));
        const int lp = lane & 31, hf = lane >> 5; const int voff24 = lp * 24;
        const int tok0 = (pass * NGW + gw) * TT; constexpr int T = TT;
        int e[2 * TT]; float g[2 * TT];
#pragma unroll
        for (int t = 0; t < TT; ++t) {
            if (t < T) {
                const size_t o = (size_t)(tok0 + t) * 128;
                e[2 * t] = IDX[o + lane]; e[2 * t + 1] = IDX[o + 64 + lane]; g[2 * t] = GATE[o + lane]; g[2 * t + 1] = GATE[o + 64 + lane];
                const v4u* xp = (const v4u*)(X1B + (size_t)(tok0 + t) * DM) + 2 * lane; const v4u a = xp[0], b = xp[1];
                P6_XSTORE(xl + t * 4096, a, b);
            } else { e[2 * t] = 1 << 20; e[2 * t + 1] = 1 << 20; g[2 * t] = 0.f; g[2 * t + 1] = 0.f; }
        }
        int pos[2 * TT];
#pragma unroll
        for (int r = 0; r < 2 * TT; ++r) pos[r] = 0;
        unsigned base[TT];
#pragma unroll
        for (int t = 0; t < TT; ++t) base[t] = 0u;
#pragma unroll 1
        for (int sl = 0; sl < 64; ++sl) {
#pragma unroll
            for (int r = 0; r < 2 * TT; ++r) {
                const bool hit = (e[r] >> 8) == sl;
                const unsigned long long m = __ballot(hit);
                const unsigned below = __builtin_amdgcn_mbcnt_hi((unsigned)(m >> 32), __builtin_amdgcn_mbcnt_lo((unsigned)m, 0u));
                if (hit) pos[r] = (int)(base[r >> 1] + below);
                base[r >> 1] += (unsigned)__popcll(m);
            }
        }
#pragma unroll
        for (int r = 0; r < 2 * TT; ++r) if ((e[r] >> 8) < 64) { v2u ent; ent.x = (unsigned)e[r]; ent.y = __float_as_uint(g[r]); Q[(r >> 1) * 128 + pos[r]] = ent; }
        LDS_WAIT();
        f32x2_t acc0[16], acc1[16];
#pragma unroll
        for (int i = 0; i < 16; ++i) { acc0[i] = (f32x2_t){0.f, 0.f}; acc1[i] = (f32x2_t){0.f, 0.f}; }
        v4u ub[4], vb[4]; v2u ub2[4], vb2[4];
        float gA, suA, svA;
#define P6_FETCH(QOFF) do { \
            const v2u ql_ = Q[(QOFF) + 2 * (lane & 3) + hf]; const int el_ = (int)ql_.x; gA = __uint_as_float(ql_.y); \
            _Pragma("unroll") for (int s_ = 0; s_ < 4; ++s_) { \
                const int ea_ = __builtin_amdgcn_readfirstlane((int)Q[(QOFF) + 2 * s_].x), eb_ = __builtin_amdgcn_readfirstlane((int)Q[(QOFF) + 2 * s_ + 1].x); \
                const int vo_ = (hf ? eb_ : ea_) * 768 + voff24; \
                ub[s_] = __builtin_amdgcn_raw_buffer_load_b128(rsu, vo_, 0, 0); ub2[s_] = __builtin_amdgcn_raw_buffer_load_b64(rsu, vo_ + 16, 0, 0); \
                vb[s_] = __builtin_amdgcn_raw_buffer_load_b128(rsv, vo_, 0, 0); vb2[s_] = __builtin_amdgcn_raw_buffer_load_b64(rsv, vo_ + 16, 0, 0); } \
            suA = SU[el_]; svA = SV[el_]; } while (0)
#define P6_CVT(RA, RB) __builtin_amdgcn_cvt_scalef32_pk32_f32_fp6((v6i_t){(int)RA.x, (int)RA.y, (int)RA.z, (int)RA.w, (int)RB.x, (int)RB.y}, 1.0f)
#define P6_MATH(TI, ACC) do { \
            f32x4 xq_[8]; \
            { const LAS f32x4* xp_ = (const LAS f32x4*)(xl + (TI) * 4096) + lp; \
              _Pragma("unroll") for (int k_ = 0; k_ < 8; ++k_) xq_[k_] = xp_[32 * k_]; } \
            float part[4]; \
            _Pragma("unroll") for (int s_ = 0; s_ < 4; ++s_) { const v32f_t uf_ = P6_CVT(ub[s_], ub2[s_]); f32x2_t d01_ = {0.f, 0.f}, d23_ = {0.f, 0.f}; \
                _Pragma("unroll") for (int k_ = 0; k_ < 8; ++k_) { \
                    d01_ = __builtin_elementwise_fma((f32x2_t){uf_[4 * k_], uf_[4 * k_ + 1]}, (f32x2_t){xq_[k_].x, xq_[k_].y}, d01_); \
                    d23_ = __builtin_elementwise_fma((f32x2_t){uf_[4 * k_ + 2], uf_[4 * k_ + 3]}, (f32x2_t){xq_[k_].z, xq_[k_].w}, d23_); } \
                part[s_] = (d01_.x + d01_.y) + (d23_.x + d23_.y); } \
            _Pragma("unroll") for (int off_ = 2; off_ >= 1; off_ >>= 1) { const bool up_ = (lane & off_) != 0; \
                _Pragma("unroll") for (int i_ = 0; i_ < off_; ++i_) { float pa_ = part[i_], pb_ = part[i_ + off_]; asm("" : "+v"(pa_), "+v"(pb_)); const float keep_ = up_ ? pb_ : pa_; const float send_ = up_ ? pa_ : pb_; part[i_] = keep_ + __shfl_xor(send_, off_); } } \
            float tot_ = part[0]; tot_ += __shfl_xor(tot_, 4); tot_ += __shfl_xor(tot_, 8); tot_ += __shfl_xor(tot_, 16);         \
            const float coefv_ = gA * svA * gelu_erf(suA * tot_); \
            _Pragma("unroll") for (int s_ = 0; s_ < 4; ++s_) { const float cf_ = __shfl(coefv_, (lane & 32) | s_); const f32x2_t cf2_ = {cf_, cf_}; const v32f_t vf_ = P6_CVT(vb[s_], vb2[s_]); \
                _Pragma("unroll") for (int i_ = 0; i_ < 16; ++i_) ACC[i_] = __builtin_elementwise_fma((f32x2_t){vf_[2 * i_], vf_[2 * i_ + 1]}, cf2_, ACC[i_]); } \
        } while (0)
#define P6_SB() __builtin_amdgcn_sched_barrier(0)
#define P6_ROUND(TI, ACC, QNEXT) do { \
            int von_[4]; \
            const v2u qn_ = Q[(QNEXT) + 2 * (lane & 3) + hf]; \
            _Pragma("unroll") for (int s_ = 0; s_ < 4; ++s_) { \
                const int ea_ = __builtin_amdgcn_readfirstlane((int)Q[(QNEXT) + 2 * s_].x), eb_ = __builtin_amdgcn_readfirstlane((int)Q[(QNEXT) + 2 * s_ + 1].x); \
                von_[s_] = (hf ? eb_ : ea_) * 768 + voff24; } \
            f32x4 xq_[8]; \
            { const LAS f32x4* xp_ = (const LAS f32x4*)(xl + (TI) * 4096) + lp; \
              _Pragma("unroll") for (int k_ = 0; k_ < 8; ++k_) xq_[k_] = xp_[32 * k_]; } \
            float part[4]; \
            _Pragma("unroll") for (int s_ = 0; s_ < 4; ++s_) { const v32f_t uf_ = P6_CVT(ub[s_], ub2[s_]); P6_SB(); \
                ub[s_] = __builtin_amdgcn_raw_buffer_load_b128(rsu, von_[s_], 0, 0); ub2[s_] = __builtin_amdgcn_raw_buffer_load_b64(rsu, von_[s_] + 16, 0, 0); P6_SB(); \
                f32x2_t d01_ = {0.f, 0.f}, d23_ = {0.f, 0.f}; \
                _Pragma("unroll") for (int k_ = 0; k_ < 8; ++k_) { \
                    d01_ = __builtin_elementwise_fma((f32x2_t){uf_[4 * k_], uf_[4 * k_ + 1]}, (f32x2_t){xq_[k_].x, xq_[k_].y}, d01_); \
                    d23_ = __builtin_elementwise_fma((f32x2_t){uf_[4 * k_ + 2], uf_[4 * k_ + 3]}, (f32x2_t){xq_[k_].z, xq_[k_].w}, d23_); } \
                part[s_] = (d01_.x + d01_.y) + (d23_.x + d23_.y); } \
            _Pragma("unroll") for (int off_ = 2; off_ >= 1; off_ >>= 1) { const bool up_ = (lane & off_) != 0; \
                _Pragma("unroll") for (int i_ = 0; i_ < off_; ++i_) { float pa_ = part[i_], pb_ = part[i_ + off_]; asm("" : "+v"(pa_), "+v"(pb_)); const float keep_ = up_ ? pb_ : pa_; const float send_ = up_ ? pa_ : pb_; part[i_] = keep_ + __shfl_xor(send_, off_); } } \
            float tot_ = part[0]; tot_ += __shfl_xor(tot_, 4); tot_ += __shfl_xor(tot_, 8); tot_ += __shfl_xor(tot_, 16); \
            const float coefv_ = gA * svA * gelu_erf(suA * tot_); \
            P6_SB(); gA = __uint_as_float(qn_.y); suA = SU[(int)qn_.x]; svA = SV[(int)qn_.x]; P6_SB(); \
            _Pragma("unroll") for (int s_ = 0; s_ < 4; ++s_) { const float cf_ = __shfl(coefv_, (lane & 32) | s_); const f32x2_t cf2_ = {cf_, cf_}; const v32f_t vf_ = P6_CVT(vb[s_], vb2[s_]); P6_SB(); \
                vb[s_] = __builtin_amdgcn_raw_buffer_load_b128(rsv, von_[s_], 0, 0); vb2[s_] = __builtin_amdgcn_raw_buffer_load_b64(rsv, von_[s_] + 16, 0, 0); P6_SB(); \
                _Pragma("unroll") for (int i_ = 0; i_ < 16; ++i_) ACC[i_] = __builtin_elementwise_fma((f32x2_t){vf_[2 * i_], vf_[2 * i_ + 1]}, cf2_, ACC[i_]); } \
        } while (0)
        if (T == 2) {
            P6_SB(); P6_FETCH(0); P6_SB();
#pragma unroll 1
            for (int jj = 0; jj < 16; ++jj) {
                if ((jj & 3) == 0) __builtin_amdgcn_s_barrier();
                P6_ROUND(0, acc0, 128 + 8 * jj); P6_SB();
                P6_ROUND(1, acc1, (jj < 15 ? 8 * jj + 8 : 120)); P6_SB();
            }
        } else {
#pragma unroll 1
            for (int jj = 0; jj < 16; ++jj) { P6_SB(); P6_FETCH(8 * jj); P6_SB(); P6_MATH(0, acc0); }
        }
        asm volatile("" ::: "memory"); __builtin_amdgcn_sched_barrier(0);
        peer_finish_token6(acc0, X1B, g2, b2, Y, tok0, lane);
        asm volatile("" ::: "memory"); __builtin_amdgcn_sched_barrier(0);
        if (T > 1) peer_finish_token6(acc1, X1B, g2, b2, Y, tok0 + 1, lane);
        LDS_WAIT();
    }
    {
        asm volatile("" : "+v"(lane));
        const int lp = lane & 31, hf = lane >> 5; const int voff24 = lp * 24;
        float gA, suA, svA; v4u ub[4], vb[4]; v2u ub2[4], vb2[4];
#pragma unroll 1
        for (int tr = full * TT * NGW + (int)blockIdx.x; tr < NTOK; tr += nblk) {
            __syncthreads();
            {
                const size_t o = (size_t)tr * 128 + 16 * wave + (lane & 15);
                if (lane < 16) { v2u ent; ent.x = (unsigned)IDX[o]; ent.y = __float_as_uint(GATE[o]); Q[lane] = ent; }
                const v4u* xp = (const v4u*)(X1B + (size_t)tr * DM) + 2 * lane; const v4u a = xp[0], b = xp[1];
                P6_XSTORE(xl, a, b);
            }
            LDS_WAIT();
            f32x2_t acc0[16];
#pragma unroll
            for (int i = 0; i < 16; ++i) acc0[i] = (f32x2_t){0.f, 0.f};
            P6_SB(); P6_FETCH(0); P6_SB(); P6_MATH(0, acc0);
            P6_SB(); P6_FETCH(8); P6_SB(); P6_MATH(0, acc0);
#pragma unroll
            for (int i = 0; i < 32; ++i) ((LAS float*)(wl + 4096))[i * 64 + lane] = (i & 1) ? acc0[i >> 1].y : acc0[i >> 1].x;
            __syncthreads();
            if (wave == 0) {
#pragma unroll 1
                for (int w = 1; w < 8; ++w) {
                    const LAS float* rp = (const LAS float*)(lds0 + w * 12288 + 4096) + lane;
#pragma unroll
                    for (int i = 0; i < 16; ++i) { acc0[i].x += rp[(2 * i) * 64]; acc0[i].y += rp[(2 * i + 1) * 64]; }
                }
                peer_finish_token6(acc0, X1B, g2, b2, Y, tr, lane);
            }
        }
    }
#undef P6_FETCH
#undef P6_XSTORE
#undef P6_CVT
#undef P6_MATH
#undef P6_ROUND
#undef P6_SB
}

template <int NB>
__device__ __forceinline__ void block_gemm32(const bf16* A, const bf16* Bt, int row0, int n0, int n1, LAS float* part, float (&v0)[2], float (&v1)[2], int tid) {
    const int lane = tid & 63, w = tid >> 6, q = lane & 31, hi = lane >> 5;
    const bf16* ap = A + (size_t)(row0 + q) * DM + 128 * w + 8 * hi;
    const bf16* b0p = Bt + (size_t)(n0 + q) * DM + 128 * w + 8 * hi;
    const bf16* b1p = Bt + (size_t)(n1 + q) * DM + 128 * w + 8 * hi;
    bf16x8_t af[8], bf0[8], bf1[8];
#pragma unroll
    for (int ks = 0; ks < 8; ++ks) { af[ks] = *(const bf16x8_t*)(ap + 16 * ks); bf0[ks] = *(const bf16x8_t*)(b0p + 16 * ks); if constexpr (NB == 2) bf1[ks] = *(const bf16x8_t*)(b1p + 16 * ks); }
    f32x16_t acc0 = {0.f, 0.f, 0.f, 0.f, 0.f, 0.f, 0.f, 0.f, 0.f, 0.f, 0.f, 0.f, 0.f, 0.f, 0.f, 0.f}, acc1 = acc0;
#pragma unroll
    for (int ks = 0; ks < 8; ++ks) {
        acc0 = __builtin_amdgcn_mfma_f32_32x32x16_bf16(af[ks], bf0[ks], acc0, 0, 0, 0);
        if constexpr (NB == 2) acc1 = __builtin_amdgcn_mfma_f32_32x32x16_bf16(af[ks], bf1[ks], acc1, 0, 0, 0);
    }
    __syncthreads();
#pragma unroll
    for (int r = 0; r < 16; ++r) { part[(w * 16 + r) * 64 + lane] = acc0[r]; if constexpr (NB == 2) part[8192 + (w * 16 + r) * 64 + lane] = acc1[r]; }
    __syncthreads();
#pragma unroll
    for (int e = 0; e < 2; ++e) {
        float s0 = 0.f, s1 = 0.f;
#pragma unroll
        for (int ww = 0; ww < 8; ++ww) { s0 += part[ww * 1024 + tid + 512 * e]; if constexpr (NB == 2) s1 += part[8192 + ww * 1024 + tid + 512 * e]; }
        v0[e] = s0; v1[e] = s1;
    }
}
__device__ __forceinline__ void tile_ij(int tid, int e, int& i, int& j) { const int idx = tid + 512 * e, r = idx >> 6, ln = idx & 63; i = crow(r, ln >> 5); j = ln & 31; }
__device__ __forceinline__ void sample_inproj_task(const bf16* XB, const bf16* WT1, bf16* QB, bf16* GB, float* out, int task, LAS float* part, int tid) {
    const int rt = task >> 6, ct = task & 63;
    float v0[2], v1[2];
    if (ct < 48) {
        block_gemm32<1>(XB, WT1, NP + 32 * rt, 32 * ct, 0, part, v0, v1, tid);
        const int which = ct >> 4;
#pragma unroll
        for (int e = 0; e < 2; ++e) {
            int i, j; tile_ij(tid, e, i, j);
            const int s_ = 32 * rt + i, col = (ct & 15) * 32 + j;
            QB[(size_t)which * ((size_t)NTOK * 512) + (size_t)(NP + s_) * 512 + col] = (bf16)(cvtpk(v0[e], 0.f) & 0xffffu);
            if (which != 0) out[(which == 1 ? O_KS : O_VS) + ((size_t)(s_ >> 3) * 2048 + 2040 + (s_ & 7)) * 512 + col] = v0[e];
        }
    } else {
        const int cb = ct - 48; const int na = 1536 + 256 * (cb >> 2) + (cb & 3) * 32;
        block_gemm32<2>(XB, WT1, NP + 32 * rt, na, na + 128, part, v0, v1, tid);
#pragma unroll
        for (int e = 0; e < 2; ++e) {
            int i, j; tile_ij(tid, e, i, j);
            const int s_ = 32 * rt + i, ch = cb * 32 + j;
            const float g = v0[e] / (1.f + __expf(-v1[e]));
            GB[(size_t)(NP + s_) * 512 + ch] = (bf16)(cvtpk(g, 0.f) & 0xffffu);
            out[O_CS + ((size_t)(s_ >> 3) * 30 + 22 + (s_ & 7)) * 512 + ch] = g;
        }
    }
}
__device__ __forceinline__ void sample_outproj_task(const bf16* MIX, const bf16* WT2, const float* xs, bf16* H, int task, LAS float* part, int tid) {
    const int rt = task >> 5, ct = task & 31;
    float v0[2], v1[2];
    block_gemm32<1>(MIX, WT2, NP + 32 * rt, 32 * ct, 0, part, v0, v1, tid);
#pragma unroll
    for (int e = 0; e < 2; ++e) { int i, j; tile_ij(tid, e, i, j); const int s_ = 32 * rt + i; H[(size_t)(NP + s_) * DM + 32 * ct + j] = (bf16)(cvtpk(ALPHA * xs[(size_t)s_ * DM + 32 * ct + j] + v0[e], 0.f) & 0xffffu); }
}
__device__ __forceinline__ void sample_query_task(const bf16* X1B, const bf16* WT3, bf16* PQ, int task, LAS float* part, int tid) {
    const int rt = task >> 6, ct = task & 63;
    float v0[2], v1[2];
    block_gemm32<1>(X1B, WT3, NP + 32 * rt, 32 * ct, 0, part, v0, v1, tid);
#pragma unroll
    for (int e = 0; e < 2; ++e) { int i, j; tile_ij(tid, e, i, j); const int s_ = 32 * rt + i; PQ[(size_t)(NP + s_) * PQD + 32 * ct + j] = (bf16)(cvtpk(v0[e], 0.f) & 0xffffu); }
}

#define XB_TMO      128
#define XB_XCNT(j)  (256  + 64 * (j))
#define XB_XSUB(j)  (1280 + 64 * (j))
#define XB_XGEN(j)  (2304 + 64 * (j))
#define XB_TOP      3328
#define XB_TOPGEN   3392
#define XCD_BAR_WORDS 3456
#define XB_SPIN_CAP (1u << 18)
__device__ __forceinline__ unsigned xb_ld(unsigned* p)              { return __hip_atomic_load(p, __ATOMIC_RELAXED, __HIP_MEMORY_SCOPE_AGENT); }
__device__ __forceinline__ unsigned xb_add(unsigned* p, unsigned v) { return __hip_atomic_fetch_add(p, v, __ATOMIC_RELAXED, __HIP_MEMORY_SCOPE_AGENT); }
__device__ __forceinline__ unsigned xb_xcc_id() { return (unsigned)__builtin_amdgcn_s_getreg((3 << 11) | 20) & 0xFu; }
#define XB_SPIN(cond, bar) do { unsigned _sp = 0; while (cond) { __builtin_amdgcn_s_sleep(1); \
    if ((++_sp & 255u) == 0u) { if (xb_ld(&(bar)[XB_TMO])) break; if (_sp > XB_SPIN_CAP) { atomicAdd(&(bar)[XB_TMO], 1u); break; } } } } while (0)
struct XcdBarrier { unsigned* bar; unsigned x; volatile LAS unsigned* st; };
__device__ __forceinline__ XcdBarrier xcd_barrier_post(unsigned* bar, volatile LAS unsigned* st) {
    XcdBarrier b; b.bar = bar; b.x = xb_xcc_id(); b.st = st;
    if (threadIdx.x == 0) (void)xb_add(&bar[XB_XCNT(b.x)], 1u);
    return b;
}
__device__ __forceinline__ void xcd_barrier_complete(unsigned* bar, unsigned x, unsigned& nloc, unsigned& nx) {
    const unsigned G = gridDim.x * gridDim.y * gridDim.z;
    unsigned sum, cnt, mine, sp = 0u;
    for (;;) {
        sum = 0u; cnt = 0u; mine = 0u;
#pragma unroll
        for (unsigned j = 0; j < 16; ++j) { const unsigned c = xb_ld(&bar[XB_XCNT(j)]); sum += c; cnt += (c > 0u) ? 1u : 0u; mine = (j == x) ? c : mine; }
        if (sum == G) break;
        __builtin_amdgcn_s_sleep(1);
        if ((++sp & 255u) == 0u) { if (xb_ld(&bar[XB_TMO])) break; if (sp > XB_SPIN_CAP) { atomicAdd(&bar[XB_TMO], 1u); break; } }
    }
    nloc = mine > 0u ? mine : 1u; nx = cnt > 0u ? cnt : 1u;
}
__device__ __forceinline__ void xcd_barrier(const XcdBarrier& b) {
    asm volatile("s_waitcnt vmcnt(0)" ::: "memory");
    __syncthreads();
    if (threadIdx.x == 0) {
        unsigned* bar = b.bar;
        __builtin_amdgcn_s_waitcnt(0);
        unsigned nloc = b.st[0], nx = b.st[1];
        if (nloc == 0u) { xcd_barrier_complete(bar, b.x, nloc, nx); b.st[0] = nloc; b.st[1] = nx; }
        const unsigned old = xb_add(&bar[XB_XSUB(b.x)], 1u);
        const unsigned gen = old / nloc;
        if (old + 1u == (gen + 1u) * nloc) {
            __builtin_amdgcn_fence(__ATOMIC_RELEASE, "agent");
            asm volatile("s_waitcnt vmcnt(0)" ::: "memory");
            const unsigned og = xb_add(&bar[XB_TOP], 1u);
            const unsigned tg = og / nx;
            if (og + 1u == (tg + 1u) * nx) xb_add(&bar[XB_TOPGEN], 1u);
            else XB_SPIN(xb_ld(&bar[XB_TOPGEN]) == tg, bar);
            __builtin_amdgcn_fence(__ATOMIC_ACQUIRE, "agent");
            xb_add(&bar[XB_XGEN(b.x)], 1u);
            asm volatile("s_waitcnt vmcnt(0)" ::: "memory");
        } else {
            XB_SPIN(xb_ld(&bar[XB_XGEN(b.x)]) == gen, bar);
            __builtin_amdgcn_fence(__ATOMIC_ACQUIRE, "agent");
            asm volatile("s_waitcnt vmcnt(0)" ::: "memory");
        }
    }
    __syncthreads();
}

__global__ void __launch_bounds__(NTHREADS, 2) fwd_megakernel(Params p) {
    extern __shared__ __attribute__((aligned(16))) unsigned char lds_raw[];
    LAS unsigned char* lds = (LAS unsigned char*)lds_raw;
    cg::grid_group grid = cg::this_grid();
    int tid = threadIdx.x, lane = tid & 63; const int wave = __builtin_amdgcn_readfirstlane(tid >> 6);
    const int G = gridDim.x, gw = blockIdx.x * NWAVES + wave, NGW = G * NWAVES;
    const long gt = (long)blockIdx.x * NTHREADS + tid, NGT = (long)G * NTHREADS;
    unsigned char* ws = p.ws;
    float* out = p.out;
    volatile LAS unsigned* bst = (volatile LAS unsigned*)(lds + LDS_BYTES - 64);
    if (tid < 16) bst[tid] = 0u;
    __syncthreads();
    const XcdBarrier xbar = xcd_barrier_post((unsigned*)(ws + WS_CTL), bst);
    bf16* WT1 = (bf16*)(ws + WS_WT1); bf16* WT2 = (bf16*)(ws + WS_WT2); bf16* WT3 = (bf16*)(ws + WS_WT3); bf16* SKB = (bf16*)(ws + WS_SK);
    unsigned char* EU8 = ws + WS_EU; unsigned char* EV8 = ws + WS_EV;
    float* SU = (float*)(ws + WS_EU + 16 * MiB); float* SV = (float*)(ws + WS_EV + 16 * MiB);
    bf16* XB = (bf16*)(ws + WS_XB);
    bf16* CSB = (bf16*)(ws + WS_EU + 20 * MiB);
    bf16* QB = (bf16*)(ws + WS_QKVG); bf16* KB = (bf16*)(ws + WS_QKVG + QSZ); bf16* VB = (bf16*)(ws + WS_QKVG + 2 * QSZ); bf16* GB = (bf16*)(ws + WS_QKVG + 3 * QSZ);
    bf16* MIX = (bf16*)(ws + WS_MIX); bf16* HBB = (bf16*)(ws + WS_H);

    {
        LAS float* scr = (LAS float*)(lds + wave * 16384);
        constexpr int I1 = 16 * (INC / 32), I2 = 16 * (DM / 32), I3 = 16 * (PQD / 32);
        for (int it = gw; it < I1 + I2 + I3; it += NGW) {
            int r = it;
            if (r < I1) { const int kb = r / (INC / 32), nb = r % (INC / 32); p0_transpose_item(p.in[5], INC, DM, w1_src_col(32 * nb), WT1, 32 * nb, 64 * kb, scr, lane); continue; } r -= I1;
            if (r < I2) { const int kb = r / (DM / 32), nb = r % (DM / 32); p0_transpose_item(p.in[6], DM, DM, 32 * nb, WT2, 32 * nb, 64 * kb, scr, lane); continue; } r -= I2;
            { const int kb = r / (PQD / 32), nb = r % (PQD / 32); p0_transpose_item(p.in[13], PQD, DM, 32 * nb, WT3, 32 * nb, 64 * kb, scr, lane); }
        }
        constexpr int I_XP = NP / 4, I_XS = NS / 4, I_SK = 64, I_EU = 8192, I_EV = 8192, I_CS = NSB * 30 * 512 / 4096;
        for (int it = gw; it < I_XP + I_XS + I_SK + I_CS + I_EU + I_EV; it += NGW) {
            int r = it;
            if (r < I_XP) { rows4_to_bf16(p.in[0] + (size_t)r * 4096, XB + (size_t)r * 4096, lane); continue; } r -= I_XP;
            if (r < I_XS) { rows4_to_bf16(p.in[1] + (size_t)r * 4096, XB + (size_t)NP * DM + (size_t)r * 4096, lane); continue; } r -= I_XS;
            if (r < I_SK) { rows4_to_bf16(p.in[14] + (size_t)r * 4096, SKB + (size_t)r * 4096, lane); continue; } r -= I_SK;
            if (r < I_CS) { rows4_to_bf16(p.in[4] + (size_t)r * 4096, CSB + (size_t)r * 4096, lane); continue; } r -= I_CS;
            if (r < I_EU) { rows2_to_fp6(p.in[15] + (size_t)r * 2048, EU8 + (size_t)r * 1536, SU + 2 * r, lane); continue; } r -= I_EU;
            rows2_to_fp6(p.in[16] + (size_t)r * 2048, EV8 + (size_t)r * 1536, SV + 2 * r, lane);
        }
        {
            constexpr long PER_BC = 22L * 128, TOTC = NSB * PER_BC;
            const f32x4* sc = (const f32x4*)p.in[4]; f32x4* oc = (f32x4*)(out + O_CS);
            for (long i = gt; i < TOTC; i += NGT) { const long b = i / PER_BC, rem = i - b * PER_BC; oc[b * 30 * 128 + rem] = sc[b * 30 * 128 + 8 * 128 + rem]; }
        }
    }
    xcd_barrier(xbar); asm volatile("" : "+v"(tid), "+v"(lane));

    {
        pg8::Gemm g{XB, WT1, NP, INC, DM}; pg8::StaticOrder S; S.init(NP, INC, G, (int)blockIdx.x);
        EpiInProj E{QB, GB, out};
        pg8::gemm_phase<EpiInProj, pg8::StaticOrder, true, true>(lds, g, S, E);
        for (int task = blockIdx.x; task < 8 * 64; task += G) sample_inproj_task(XB, WT1, QB, GB, out, task, (LAS float*)lds, tid);
    }
    xcd_barrier(xbar); asm volatile("" : "+v"(tid), "+v"(lane));

    bf16* OP = (bf16*)(ws + WS_H); float* LSE = (float*)(ws + WS_H + (size_t)3 * NTOK * 512 * 2);
    {
        LAS float* wl = (LAS float*)(lds + 65536);
        for (int i = tid; i < (CK + 1) * CC / 4; i += NTHREADS) ((LAS f32x4*)wl)[i] = i < CK * CC / 4 ? ((const f32x4*)p.in[7])[i] : (f32x4){0.f, 0.f, 0.f, 0.f};
        __syncthreads();
        LAS unsigned char* vbuf = lds + wave * 8192;
        const AttnArgs AA{QB, KB, VB, p.in[2], p.in[3], out, OP, LSE};
        constexpr int T_CONV = 4096 + NSB, T_SA = NSB * NH * 13;
        const __amdgpu_buffer_rsrc_t rsw = __builtin_amdgcn_make_buffer_rsrc((void*)ws, 0, 0x40000000, 0x00020000);
        for (int task = gw; task < T_CONV + T_SA; task += NGW) {
            asm volatile("" : "+v"(lane));
            int k = task;
            if (k < T_SA) { attn_mfma_task<true, false>(AA, k, vbuf, lane); continue; }
            k -= T_SA;
            conv_task(rsw, (unsigned)((const unsigned char*)GB - ws), (unsigned)((const unsigned char*)CSB - ws), wl, p.in[8], p.in[9], p.in[10], MIX, k, lane);
        }
        attn_block_phase(AA, lds, G, tid, wave, lane);
    }
    xcd_barrier(xbar); asm volatile("" : "+v"(tid), "+v"(lane));
    for (int r = gw; r < NTOK; r += NGW) attn_merge_row(OP, LSE, MIX, r, lane);
    xcd_barrier(xbar); asm volatile("" : "+v"(tid), "+v"(lane));

    {
        pg8::Gemm g{MIX, WT2, NP, DM, DM}; pg8::StaticOrder S; S.init(NP, DM, G, (int)blockIdx.x);
        EpiResid E{XB, HBB};
        pg8::gemm_phase<EpiResid, pg8::StaticOrder, true, true>(lds, g, S, E);
        for (int task = blockIdx.x; task < 8 * 32; task += G) sample_outproj_task(MIX, WT2, p.in[1], HBB, task, (LAS float*)lds, tid);
    }
    xcd_barrier(xbar); asm volatile("" : "+v"(tid), "+v"(lane));

    bf16* X1B = XB;
    for (int r = 4 * gw; r < NTOK; r += 4 * NGW) ln1_rows4(HBB, X1B, p.in[11], p.in[12], r, lane);
    xcd_barrier(xbar); asm volatile("" : "+v"(tid), "+v"(lane));

    bf16* PQ = (bf16*)(ws + WS_QKVG);
    {
        pg8::Gemm g{X1B, WT3, NP, PQD, DM}; pg8::StaticOrder S; S.init(NP, PQD, G, (int)blockIdx.x);
        EpiPlainBf16 E{PQ, PQD};
        pg8::gemm_phase<EpiPlainBf16, pg8::StaticOrder, true, true>(lds, g, S, E);
        for (int task = blockIdx.x; task < 8 * 64; task += G) sample_query_task(X1B, WT3, PQ, task, (LAS float*)lds, tid);
    }
    xcd_barrier(xbar); asm volatile("" : "+v"(tid), "+v"(lane));

    int* IDX = (int*)(ws + WS_MIX); float* GATE = (float*)(ws + WS_MIX + (size_t)NTOK * 128 * 4);
    {
        constexpr int NTILE = NTOK / 32;
        const CacheCopy CC{(const f32x4*)p.in[2], (const f32x4*)p.in[3], (f32x4*)(out + O_KS), (f32x4*)(out + O_VS)};
        const int ntb = ((int)blockIdx.x < NTILE) ? (NTILE - 1 - (int)blockIdx.x) / G + 1 : 0;
        for (int hp = 0; hp < 4; ++hp) {
            __syncthreads();
            const v4u* src = (const v4u*)(SKB + (size_t)hp * 2 * 2 * 128 * 128);
#pragma unroll 4
            for (int i = 0; i < 16; ++i) { const int gch = tid + NTHREADS * i, row = gch >> 4, ch = gch & 15; *(LAS v4u*)(lds + row * 256 + ((ch ^ (row & 15)) << 4)) = src[gch]; }
            __syncthreads();
            if (G == 256) {
                topk_mfma_task(PQ, lds + (wave & 1) * 65536, IDX, GATE, (int)blockIdx.x * 4 + (wave >> 1), 2 * hp + (wave & 1), lane, CC);
                const int x = (int)blockIdx.x - 8;
                if (x >= 0 && x < 64 && ((x >> 4) == hp) && wave == 0) topk_mfma_task(PQ, lds + ((x >> 3) & 1) * 65536, IDX, GATE, 1024 + (x & 7), x >> 3, lane, CC);
            } else {
                for (int k0 = 0; k0 < ntb; k0 += 4) {
                    const int k = k0 + (wave >> 1);
                    if (k < ntb) topk_mfma_task(PQ, lds + (wave & 1) * 65536, IDX, GATE, (int)blockIdx.x + G * k, 2 * hp + (wave & 1), lane, CC);
                }
            }
        }
    }
    xcd_barrier(xbar); asm volatile("" : "+v"(tid), "+v"(lane));

#ifdef PEER_TOKEN_MAJOR
    peer_phase(X1B, HB, IDX, GATE, EU8, EV8, SU, SV, p.in[17], p.in[18], out + O_Y, gw, NGW, lane);
#else
    peer_phase6(X1B, IDX, GATE, EU8, EV8, SU, SV, p.in[17], p.in[18], out + O_Y, gw, NGW, lane, lds + wave * 12288, lds, wave, G);
    grid.sync();
#endif
}

extern "C" void kernel_launch(void* const* d_in, const int* in_sizes, int n_in, void* d_out, int out_size, void* d_ws, size_t ws_size, hipStream_t stream) {
    static int grid_blocks = 0;
    if (grid_blocks == 0) {
        if (n_in != 19 || (size_t)out_size != O_END || ws_size < WS_END) { fprintf(stderr, "kernel_launch: unexpected shapes n_in %d out %d ws %zu\n", n_in, out_size, ws_size); grid_blocks = -1; return; }
        int dev = 0, cus = 0, per_cu = 0;
        (void)hipGetDevice(&dev);
        (void)hipDeviceGetAttribute(&cus, hipDeviceAttributeMultiprocessorCount, dev);
        (void)hipFuncSetAttribute((const void*)fwd_megakernel, hipFuncAttributeMaxDynamicSharedMemorySize, LDS_BYTES);
        (void)hipOccupancyMaxActiveBlocksPerMultiprocessor(&per_cu, (const void*)fwd_megakernel, NTHREADS, LDS_BYTES);
        if (per_cu < 1) { fprintf(stderr, "kernel_launch: occupancy query says %d blocks per CU\n", per_cu); per_cu = 1; }
        if (per_cu > 1) per_cu = 1;
        grid_blocks = cus * per_cu;
        (void)hipGetLastError();
    }
    if (grid_blocks < 0) return;
    (void)hipMemsetAsync((char*)d_ws + WS_CTL, 0, 16384, stream);
    Params p{};
    for (int i = 0; i < 19; ++i) p.in[i] = (const float*)d_in[i];
    p.out = (float*)d_out; p.ws = (unsigned char*)d_ws;
    void* args[] = {&p};
    hipError_t e = hipLaunchCooperativeKernel((const void*)fwd_megakernel, dim3(grid_blocks), dim3(NTHREADS), args, LDS_BYTES, stream);
    if (e != hipSuccess) fprintf(stderr, "cooperative launch failed: %s (grid %d)\n", hipGetErrorString(e), grid_blocks);
}
```

```cpp
#include <hip/hip_runtime.h>
#include <hip/hip_cooperative_groups.h>
#include <cstdio>
#include <cstdint>
namespace cg = cooperative_groups;

namespace pg8 {
#define PG8_LAS __attribute__((address_space(3)))
typedef unsigned short bf16_t;
typedef short bf16x8 __attribute__((ext_vector_type(8)));
typedef float f32x4 __attribute__((ext_vector_type(4)));
typedef unsigned u32x4 __attribute__((ext_vector_type(4)));
typedef unsigned u32x2 __attribute__((ext_vector_type(2)));
constexpr int BM = 256, BK = 64, HALF = 128, HTB = HALF * BK * 2, STAGE_BYTES = 8 * HTB, NXCD = 8, WGM = 4;

__host__ __device__ __forceinline__ int lds_byte(int r, int c) { const int st = (r >> 4) * 2 + (c >> 5), rr = r & 15, cc = c & 31, ob = rr * 64 + cc * 2; return st * 1024 + (ob ^ (((ob >> 9) & 1) << 5)); }
__host__ __device__ __forceinline__ void stage_rc(int b, int& R, int& C) { const int st = b / 1024, sb = b % 1024, swz = sb ^ (((sb >> 9) & 1) << 5); R = (st >> 1) * 16 + swz / 64; C = (st & 1) * 32 + (swz % 64) / 2; }
__host__ __device__ __forceinline__ int perm32(int rho) { const int n = rho >> 4, i = rho & 15; return 8 * (i >> 2) + 4 * n + (i & 3); }

struct Unit { int pm, pn; };
struct Gemm { const bf16_t* A; const bf16_t* Bt; int M, N, K; };

struct StaticOrder {
    int nM, nN, nwg, G, c;
    __host__ __device__ void init(int M, int N, int G_, int c_) { nM = M / BM; nN = N / BM; nwg = nM * nN; G = G_; c = c_; }
    __host__ __device__ bool next(int i, Unit& u) const {
        const long L = (long)i * G + c; if (L >= nwg) return false;
        int wgid = (int)L; { const int q = nwg / NXCD, r = nwg % NXCD, xcd = wgid % NXCD, off = wgid / NXCD; wgid = (xcd < r ? xcd * (q + 1) : r * (q + 1) + (xcd - r) * q) + off; }
        const int nig = WGM * nN, gid = wgid / nig, fm = gid * WGM, gsz = (nM - fm) < WGM ? (nM - fm) : WGM;
        u.pm = fm + ((wgid % nig) % gsz); u.pn = (wgid % nig) / gsz; return true;
    }
    __device__ __forceinline__ void a_ready(const Unit&) const {}
    __device__ __forceinline__ void done(const Unit&) const {}
};

template <class Epi, class Sched, bool ALIGN_EPI = false, bool SP2 = false>
__device__ __forceinline__ void gemm_phase(PG8_LAS unsigned char* lds, const Gemm g, const Sched& S, const Epi& E) {
    int tid = threadIdx.x; asm volatile("" : "+v"(tid));
    const int wid = __builtin_amdgcn_readfirstlane(tid >> 6), lane = tid & 63, wr = wid >> 2, wc = wid & 3, fr = lane & 15, fq = lane >> 4;
    const int K = g.K, nt = K / BK;
    unsigned voffA[2], voffB[2];
#pragma unroll
    for (int i = 0; i < 2; ++i) { int R, C; stage_rc(tid * 16 + i * 8192, R, C); const int Rb = Epi::PERM ? ((R & ~31) + perm32(R & 31)) : R;
        voffA[i] = (unsigned)(R * K + C) * 2u; voffB[i] = (unsigned)(Rb * K + C) * 2u; }
    const size_t kstep = (size_t)(BK * 2);
    const size_t hstep = (size_t)HALF * K * 2;
    const size_t tstep = 2 * hstep;
    const unsigned ldsw = (unsigned)wid * 1024u;
    const int aoff = lds_byte(wr * 64 + fr, fq * 8), boff = lds_byte(wc * 32 + fr, fq * 8);
#define PG8_SA(b, h) (((b) * 2 + (h)) * HTB)
#define PG8_SB(b, h) ((4 + (b) * 2 + (h)) * HTB)
#define PG8_STAGE(bufoff, gbase, voff) do { _Pragma("unroll") for (int _i = 0; _i < 2; ++_i) \
        __builtin_amdgcn_global_load_lds((const unsigned*)((const char*)(gbase) + (voff)[_i]), (PG8_LAS unsigned*)(lds + (bufoff) + ldsw + _i * 8192), 16, 0, 0); } while (0)
#define PG8_LDA(dst, b, h) do { _Pragma("unroll") for (int m = 0; m < 4; ++m) _Pragma("unroll") for (int k = 0; k < 2; ++k) dst[m][k] = *(const PG8_LAS bf16x8*)(lds + PG8_SA(b, h) + aoff + m * 2048 + k * 1024); } while (0)
#define PG8_LDB(dst, b, h) do { _Pragma("unroll") for (int n = 0; n < 2; ++n) _Pragma("unroll") for (int k = 0; k < 2; ++k) dst[n][k] = *(const PG8_LAS bf16x8*)(lds + PG8_SB(b, h) + boff + n * 2048 + k * 1024); } while (0)
#define PG8_MMA(ai, bj, At, Bt) do { __builtin_amdgcn_s_setprio(1); _Pragma("unroll") for (int m = 0; m < 4; ++m) _Pragma("unroll") for (int n = 0; n < 2; ++n) _Pragma("unroll") for (int k = 0; k < 2; ++k) \
        acc[ai][bj][m][n] = __builtin_amdgcn_mfma_f32_16x16x32_bf16(Bt[n][k], At[m][k], acc[ai][bj][m][n], 0, 0, 0); __builtin_amdgcn_s_setprio(0); } while (0)
#define PG8_WAIT_V(n) asm volatile("s_waitcnt vmcnt(" #n ")" ::: "memory")
#define PG8_WAIT_L(n) asm volatile("s_waitcnt lgkmcnt(" #n ")" ::: "memory")
#define PG8_BAR __builtin_amdgcn_s_barrier()
#define PG8_SCHED __builtin_amdgcn_sched_barrier(0)
    Unit cur, nxt; int ui = 0;
    if (!S.next(0, cur)) return;
    f32x4 acc[2][2][4][2];
#pragma unroll
    for (int a = 0; a < 2; ++a)
#pragma unroll
        for (int b = 0; b < 2; ++b)
#pragma unroll
            for (int m = 0; m < 4; ++m)
#pragma unroll
                for (int n = 0; n < 2; ++n) acc[a][b][m][n] = (f32x4){0.f, 0.f, 0.f, 0.f};
    bf16x8 At[4][2], B0[2][2], B1[2][2];
    const char* cA = (const char*)g.A + (size_t)cur.pm * tstep; const char* cB = (const char*)g.Bt + (size_t)cur.pn * tstep;
    S.a_ready(cur);
    if constexpr (SP2) {
        PG8_STAGE(PG8_SB(0, 0), cB, voffB); PG8_STAGE(PG8_SB(0, 1), cB + hstep, voffB); PG8_STAGE(PG8_SA(0, 0), cA, voffA); PG8_STAGE(PG8_SA(0, 1), cA + hstep, voffA);
        if (wr == 1) PG8_BAR;
        PG8_WAIT_V(2); PG8_BAR;
        PG8_STAGE(PG8_SB(1, 0), cB + kstep, voffB); PG8_STAGE(PG8_SA(1, 0), cA + kstep, voffA); PG8_STAGE(PG8_SB(1, 1), cB + hstep + kstep, voffB);
        PG8_WAIT_V(6); PG8_BAR;
    } else {
        PG8_STAGE(PG8_SB(0, 0), cB, voffB); PG8_STAGE(PG8_SA(0, 0), cA, voffA); PG8_STAGE(PG8_SB(0, 1), cB + hstep, voffB); PG8_STAGE(PG8_SA(0, 1), cA + hstep, voffA);
        if (wr == 1) PG8_BAR;
        PG8_WAIT_V(4); PG8_BAR;
        PG8_STAGE(PG8_SB(1, 0), cB + kstep, voffB); PG8_STAGE(PG8_SA(1, 0), cA + kstep, voffA); PG8_STAGE(PG8_SB(1, 1), cB + hstep + kstep, voffB);
        PG8_WAIT_V(6); PG8_BAR;
    }
    for (;;) {
        const bool has_next = S.next(ui + 1, nxt);
        const char* nA = has_next ? (const char*)g.A + (size_t)nxt.pm * tstep : cA; const char* nB = has_next ? (const char*)g.Bt + (size_t)nxt.pn * tstep : cB;
        for (int t = 0; t < nt; t += 2) {
            const bool last = (t == nt - 2);
            const char* a1 = cA + (size_t)(t + 1) * kstep;
            const char* a2 = last ? nA : cA + (size_t)(t + 2) * kstep; const char* b2 = last ? nB : cB + (size_t)(t + 2) * kstep;
            const char* a3 = a2 + kstep; const char* b3 = b2 + kstep;
            if (last && has_next) S.a_ready(nxt);
            if constexpr (SP2) {
            PG8_LDB(B0, 0, 0); PG8_LDB(B1, 0, 1); PG8_SCHED; PG8_LDA(At, 0, 0); PG8_STAGE(PG8_SA(1, 1), a1 + hstep, voffA);
            PG8_WAIT_V(8); PG8_WAIT_L(0); PG8_BAR; PG8_MMA(0, 0, At, B0); PG8_MMA(0, 1, At, B1); PG8_BAR; PG8_SCHED;
            PG8_LDA(At, 0, 1); PG8_STAGE(PG8_SB(0, 0), b2, voffB); PG8_STAGE(PG8_SB(0, 1), b2 + hstep, voffB); PG8_STAGE(PG8_SA(0, 0), a2, voffA);
            PG8_WAIT_V(8); PG8_WAIT_L(0); PG8_BAR; PG8_MMA(1, 0, At, B0); PG8_MMA(1, 1, At, B1); PG8_BAR; PG8_SCHED;
            PG8_LDB(B0, 1, 0); PG8_LDB(B1, 1, 1); PG8_SCHED; PG8_LDA(At, 1, 0); PG8_STAGE(PG8_SA(0, 1), a2 + hstep, voffA);
            PG8_WAIT_V(8); PG8_WAIT_L(0); PG8_BAR; PG8_MMA(0, 0, At, B0); PG8_MMA(0, 1, At, B1); PG8_BAR; PG8_SCHED;
            PG8_LDA(At, 1, 1); PG8_STAGE(PG8_SB(1, 0), b3, voffB); PG8_STAGE(PG8_SB(1, 1), b3 + hstep, voffB); PG8_STAGE(PG8_SA(1, 0), a3, voffA);
            PG8_WAIT_V(8); PG8_WAIT_L(0); PG8_BAR; PG8_MMA(1, 0, At, B0); PG8_MMA(1, 1, At, B1); PG8_BAR; PG8_SCHED;
            } else {
            PG8_LDB(B0, 0, 0); PG8_SCHED; PG8_LDA(At, 0, 0); PG8_STAGE(PG8_SA(1, 1), a1 + hstep, voffA);
            PG8_WAIT_L(8); PG8_BAR; PG8_WAIT_L(0); PG8_MMA(0, 0, At, B0); PG8_BAR; PG8_SCHED;
            PG8_LDB(B1, 0, 1); PG8_STAGE(PG8_SB(0, 0), b2, voffB);
            PG8_BAR; PG8_WAIT_L(0); PG8_MMA(0, 1, At, B1); PG8_BAR;
            PG8_LDA(At, 0, 1); PG8_STAGE(PG8_SA(0, 0), a2, voffA);
            PG8_BAR; PG8_WAIT_L(0); PG8_MMA(1, 0, At, B0); PG8_BAR; PG8_SCHED;
            PG8_STAGE(PG8_SB(0, 1), b2 + hstep, voffB);
            PG8_WAIT_V(6); PG8_BAR; PG8_MMA(1, 1, At, B1); PG8_BAR;
            PG8_LDB(B0, 1, 0); PG8_SCHED; PG8_LDA(At, 1, 0); PG8_STAGE(PG8_SA(0, 1), a2 + hstep, voffA);
            PG8_WAIT_L(8); PG8_BAR; PG8_WAIT_L(0); PG8_MMA(0, 0, At, B0); PG8_BAR; PG8_SCHED;
            PG8_LDB(B1, 1, 1); PG8_STAGE(PG8_SB(1, 0), b3, voffB);
            PG8_BAR; PG8_WAIT_L(0); PG8_MMA(0, 1, At, B1); PG8_BAR;
            PG8_LDA(At, 1, 1); PG8_STAGE(PG8_SA(1, 0), a3, voffA);
            PG8_BAR; PG8_WAIT_L(0); PG8_MMA(1, 0, At, B0); PG8_BAR; PG8_SCHED;
            PG8_STAGE(PG8_SB(1, 1), b3 + hstep, voffB);
            PG8_WAIT_V(6); PG8_BAR; PG8_MMA(1, 1, At, B1); PG8_BAR;
            }
        }
        if constexpr (ALIGN_EPI) { if (wr == 0) PG8_BAR; }
        if constexpr (!Epi::AFTER_DRAIN) { E(acc, cur, wr, wc, fr, fq); S.done(cur); }
        if (!has_next) break;
#pragma unroll
        for (int a = 0; a < 2; ++a)
#pragma unroll
            for (int b = 0; b < 2; ++b)
#pragma unroll
                for (int m = 0; m < 4; ++m)
#pragma unroll
                    for (int n = 0; n < 2; ++n) acc[a][b][m][n] = (f32x4){0.f, 0.f, 0.f, 0.f};
        cur = nxt; cA = nA; cB = nB; ++ui;
        if constexpr (ALIGN_EPI) { if (wr == 1) PG8_BAR; }
    }
    PG8_WAIT_V(0);
    if constexpr (!ALIGN_EPI) { if (wr == 0) PG8_BAR; }
    PG8_BAR;
    if constexpr (Epi::AFTER_DRAIN) { E.fused(acc, cur, wr, wc, fr, fq, lds, wid, lane); S.done(cur); }
#undef PG8_SA
#undef PG8_SB
#undef PG8_STAGE
#undef PG8_LDA
#undef PG8_LDB
#undef PG8_MMA
#undef PG8_WAIT_V
#undef PG8_WAIT_L
#undef PG8_BAR
#undef PG8_SCHED
}
}

#define GAS __attribute__((address_space(1)))
#define LAS __attribute__((address_space(3)))
typedef unsigned short bf16;
typedef unsigned v4u __attribute__((ext_vector_type(4)));
typedef unsigned v2u __attribute__((ext_vector_type(2)));
typedef float f32x4 __attribute__((ext_vector_type(4)));
typedef float f32x2_t __attribute__((ext_vector_type(2)));
typedef __bf16 bf16x2_t __attribute__((ext_vector_type(2)));

constexpr int DM = 1024, NPB = 8, SEQ = 4096, NSB = 32, DSEQ = 8, LB = 2048;
constexpr int NP = NPB * SEQ, NS = NSB * DSEQ, NTOK = NP + NS;
constexpr int AW = 512, CC = 512, NH = 8, HD = 64, INC = 2560, CK = 31;
constexpr int NKEYS = 128, PH = 8, PQD = 2048;
constexpr float ALPHA = 1.18920711500272f, LN_EPS = 1e-5f;
constexpr size_t O_Y = 0, O_KP = (size_t)NTOK * DM, O_VP = O_KP + (size_t)NPB * 2048 * 512, O_CP = O_VP + (size_t)NPB * 2048 * 512,
                 O_KS = O_CP + (size_t)NPB * 30 * 512, O_VS = O_KS + (size_t)NSB * 2048 * 512, O_CS = O_VS + (size_t)NSB * 2048 * 512, O_END = O_CS + (size_t)NSB * 30 * 512;
static_assert(O_END == 118317056ull, "output map");
constexpr size_t MiB = 1u << 20;
constexpr size_t WS_CTL = 0, WS_WT1 = 1 * MiB, WS_WT2 = 6 * MiB, WS_WT3 = 8 * MiB, WS_SK = 12 * MiB, WS_EU = 13 * MiB, WS_EV = 45 * MiB,
                 WS_XB = 77 * MiB, WS_QKVG = 142 * MiB, WS_MIX = 271 * MiB, WS_H = 336 * MiB, WS_END = 465 * MiB;
constexpr size_t QSZ = (size_t)NTOK * 512 * 2;
static_assert(WS_XB + (size_t)NTOK * DM * 2 <= WS_QKVG && WS_QKVG + 4 * QSZ <= WS_MIX && WS_QKVG + (size_t)NTOK * PQD * 2 <= WS_MIX && WS_MIX + (size_t)NTOK * DM * 2 <= WS_H && WS_H + (size_t)NTOK * DM * 4 <= WS_END, "ws map");
static_assert(WS_MIX + (size_t)NTOK * 128 * 8 <= WS_H, "idx+gate overlay");

constexpr int NWAVES = 8, NTHREADS = 512;
constexpr int LDS_BYTES = 147456;

struct Params { const float* in[19]; float* out; unsigned char* ws; };

__device__ __forceinline__ unsigned cvtpk(float lo, float hi) { f32x2_t v = {lo, hi}; bf16x2_t b = __builtin_convertvector(v, bf16x2_t); return __builtin_bit_cast(unsigned, b); }
__device__ __forceinline__ float bflo(unsigned u) { return __uint_as_float(u << 16); }
__device__ __forceinline__ float bfhi(unsigned u) { return __uint_as_float(u & 0xffff0000u); }
__device__ __forceinline__ float dot2(unsigned a, unsigned b, float c) { return __builtin_amdgcn_fdot2_f32_bf16(__builtin_bit_cast(bf16x2_t, a), __builtin_bit_cast(bf16x2_t, b), c, false); }
__device__ __forceinline__ float wave_sum(float v) {
#pragma unroll
    for (int o = 1; o < 64; o <<= 1) v += __shfl_xor(v, o);
    return v;
}
__device__ __forceinline__ float wave_max(float v) {
#pragma unroll
    for (int o = 1; o < 64; o <<= 1) v = fmaxf(v, __shfl_xor(v, o));
    return v;
}
__device__ __forceinline__ unsigned wave_maxu(unsigned v) {
#pragma unroll
    for (int o = 1; o < 64; o <<= 1) { const unsigned w = (unsigned)__shfl_xor((int)v, o); v = v > w ? v : w; }
    return v;
}
#define LDS_WAIT() asm volatile("s_waitcnt lgkmcnt(0)" ::: "memory")

__device__ __forceinline__ void p0_transpose_item(const float* W, int N, int K, int srcn0, bf16* WT, int dstn0, int k0, LAS float* scr, int lane) {
#pragma unroll 8
    for (int i = 0; i < 32; ++i) { const int kk = 2 * i + (lane >> 5); scr[kk * 33 + (lane & 31)] = W[(size_t)(k0 + kk) * N + srcn0 + (lane & 31)]; }
    LDS_WAIT(); asm volatile("" ::: "memory");
    const int c = lane & 7;
#pragma unroll
    for (int j = 0; j < 4; ++j) { const int n = (lane >> 3) + 8 * j; const LAS float* s = scr + (8 * c) * 33 + n;
        v4u o; o.x = cvtpk(s[0 * 33], s[1 * 33]); o.y = cvtpk(s[2 * 33], s[3 * 33]); o.z = cvtpk(s[4 * 33], s[5 * 33]); o.w = cvtpk(s[6 * 33], s[7 * 33]);
        *(v4u*)(WT + (size_t)(dstn0 + n) * K + k0 + 8 * c) = o; }
    LDS_WAIT(); asm volatile("" ::: "memory");
}
__device__ __forceinline__ int w1_src_col(int n0) {
    if (n0 < 1536) return n0;
    const int t = n0 - 1536, j = t >> 8, c = t & 255;
    return c < 128 ? 1536 + 128 * j + c : 2048 + 128 * j + (c - 128);
}
__device__ __forceinline__ void rows4_to_bf16(const float* src, bf16* dst, int lane) {
    const f32x4* s = (const f32x4*)src + lane; v2u* d = (v2u*)dst + lane;
    f32x4 v[16];
#pragma unroll
    for (int j = 0; j < 16; ++j) v[j] = s[64 * j];
#pragma unroll
    for (int j = 0; j < 16; ++j) { v2u o; o.x = cvtpk(v[j].x, v[j].y); o.y = cvtpk(v[j].z, v[j].w); d[64 * j] = o; }
}

typedef int v6i_t __attribute__((ext_vector_type(6)));
typedef float v32f_t __attribute__((ext_vector_type(32)));
typedef float v16f_t __attribute__((ext_vector_type(16)));
typedef unsigned v3u __attribute__((ext_vector_type(3)));
__device__ __forceinline__ void rows2_to_fp6(const float* src, unsigned char* dst, float* scale_out, int lane) {
    const int lp = lane & 31, hf = lane >> 5;
    const f32x4* s = (const f32x4*)(src + (size_t)hf * DM + 32 * lp);
    f32x4 v[8]; float m = 0.f;
#pragma unroll
    for (int j = 0; j < 8; ++j) { v[j] = s[j]; m = fmaxf(m, fmaxf(fmaxf(fabsf(v[j].x), fabsf(v[j].y)), fmaxf(fabsf(v[j].z), fabsf(v[j].w)))); }
#pragma unroll
    for (int o = 1; o < 32; o <<= 1) m = fmaxf(m, __shfl_xor(m, o));
    const float sc = m > 0.f ? m * (1.f / 7.5f) : 1.f, inv = 1.f / sc;
    unsigned long long acc64 = 0ull; int nb = 0; unsigned pkw[6]; int wi = 0;
#pragma unroll
    for (int j = 0; j < 8; ++j) {
        const float f4[4] = {v[j].x * inv, v[j].y * inv, v[j].z * inv, v[j].w * inv};
#pragma unroll
        for (int c = 0; c < 4; ++c) {
            const float a_ = fminf(fabsf(f4[c]), 7.5f);
            const float cf = a_ < 1.f ? a_ * 8.f : (a_ < 2.f ? 8.f + (a_ - 1.f) * 8.f : (a_ < 4.f ? 16.f + (a_ - 2.f) * 4.f : 24.f + (a_ - 4.f) * 2.f));
            unsigned code = (unsigned)__builtin_rintf(cf); if (code > 31u) code = 31u;
            if (f4[c] < 0.f) code |= 32u;
            acc64 |= (unsigned long long)code << nb; nb += 6;
            if (nb >= 32) { pkw[wi++] = (unsigned)acc64; acc64 >>= 32; nb -= 32; }
        }
    }
    v6i_t pk; pk[0] = (int)pkw[0]; pk[1] = (int)pkw[1]; pk[2] = (int)pkw[2]; pk[3] = (int)pkw[3]; pk[4] = (int)pkw[4]; pk[5] = (int)pkw[5];
    v2u* d = (v2u*)(dst + (size_t)hf * 768 + 24 * lp);
    v2u w; w.x = (unsigned)pk[0]; w.y = (unsigned)pk[1]; d[0] = w; w.x = (unsigned)pk[2]; w.y = (unsigned)pk[3]; d[1] = w; w.x = (unsigned)pk[4]; w.y = (unsigned)pk[5]; d[2] = w;
    if (lp == 0) scale_out[hf] = sc;
}

struct EpiInProj {
    static constexpr bool PERM = true, AFTER_DRAIN = false;
    bf16 *qb, *gb; float* out;
    __device__ __forceinline__ void operator()(const f32x4 (&acc)[2][2][4][2], const pg8::Unit& u, int wr, int wc, int fr, int fq) const {
        const int pn = u.pn;
#pragma unroll
        for (int ai = 0; ai < 2; ++ai)
#pragma unroll
            for (int m = 0; m < 4; ++m) {
                const int row = u.pm * 256 + ai * 128 + wr * 64 + m * 16 + fr;
                long kvrow = -1, cvrow = -1;
                bool samp = row >= NP;
                if (!samp) { const int b = row >> 12, t = row & 4095; if (t >= 2048) kvrow = (long)b * 2048 + (t - 2048); if (t >= SEQ - 30) cvrow = (long)b * 30 + (t - (SEQ - 30)); }
                else { const int s = row - NP, b = s >> 3, tt = s & 7; kvrow = (long)b * 2048 + 2040 + tt; cvrow = (long)b * 30 + 22 + tt; }
                if (pn < 6) {
                    const int which = pn >> 1;
                    bf16* dst = qb + (size_t)which * ((size_t)NTOK * 512) + (size_t)row * 512;
                    const size_t fbase = samp ? O_KS : O_KP, fstride = samp ? (O_VS - O_KS) : (O_VP - O_KP);
                    const bool dof = (which != 0) && (kvrow >= 0);
                    float* fo = out + fbase + (size_t)(which == 2 ? 1 : 0) * fstride + (size_t)(kvrow < 0 ? 0 : kvrow) * 512;
#pragma unroll
                    for (int bj = 0; bj < 2; ++bj) {
                        const int col = (pn & 1) * 256 + bj * 128 + wc * 32 + fq * 8;
                        const f32x4 v0 = acc[ai][bj][m][0], v1 = acc[ai][bj][m][1];
                        v4u o; o.x = cvtpk(v0.x, v0.y); o.y = cvtpk(v0.z, v0.w); o.z = cvtpk(v1.x, v1.y); o.w = cvtpk(v1.z, v1.w);
                        *(v4u*)(dst + col) = o;
                        if (dof) { *(f32x4*)(fo + col) = v0; *(f32x4*)(fo + col + 4) = v1; }
                    }
                } else {
                    const int j = pn - 6;
                    const bool dof = cvrow >= 0;
                    float* fo = out + (samp ? O_CS : O_CP) + (size_t)(cvrow < 0 ? 0 : cvrow) * 512;
                    const int ch = j * 128 + wc * 32 + fq * 8;
                    f32x4 r[2];
#pragma unroll
                    for (int n = 0; n < 2; ++n) {
                        const f32x4 a = acc[ai][0][m][n], g = acc[ai][1][m][n];
                        r[n].x = a.x / (1.f + __expf(-g.x)); r[n].y = a.y / (1.f + __expf(-g.y)); r[n].z = a.z / (1.f + __expf(-g.z)); r[n].w = a.w / (1.f + __expf(-g.w));
                    }
                    v4u o; o.x = cvtpk(r[0].x, r[0].y); o.y = cvtpk(r[0].z, r[0].w); o.z = cvtpk(r[1].x, r[1].y); o.w = cvtpk(r[1].z, r[1].w);
                    *(v4u*)(gb + (size_t)row * 512 + ch) = o;
                    if (dof) { *(f32x4*)(fo + ch) = r[0]; *(f32x4*)(fo + ch + 4) = r[1]; }
                }
            }
    }
};
struct EpiResid {
    static constexpr bool PERM = true, AFTER_DRAIN = false;
    const bf16* XBp; bf16* H;
    __device__ __forceinline__ void operator()(const f32x4 (&acc)[2][2][4][2], const pg8::Unit& u, int wr, int wc, int fr, int fq) const {
#pragma unroll
        for (int ai = 0; ai < 2; ++ai)
#pragma unroll
            for (int m = 0; m < 4; ++m) {
                const int row = u.pm * 256 + ai * 128 + wr * 64 + m * 16 + fr;
#pragma unroll
                for (int bj = 0; bj < 2; ++bj) {
                    const int col = u.pn * 256 + bj * 128 + wc * 32 + fq * 8;
                    const v4u xv = *(const v4u*)(XBp + (size_t)row * DM + col);
                    const f32x4 a0 = acc[ai][bj][m][0], a1 = acc[ai][bj][m][1];
                    v4u o;
                    o.x = cvtpk(ALPHA * bflo(xv.x) + a0.x, ALPHA * bfhi(xv.x) + a0.y); o.y = cvtpk(ALPHA * bflo(xv.y) + a0.z, ALPHA * bfhi(xv.y) + a0.w);
                    o.z = cvtpk(ALPHA * bflo(xv.z) + a1.x, ALPHA * bfhi(xv.z) + a1.y); o.w = cvtpk(ALPHA * bflo(xv.w) + a1.z, ALPHA * bfhi(xv.w) + a1.w);
                    *(v4u*)(H + (size_t)row * DM + col) = o;
                }
            }
    }
};
struct EpiPlainBf16 {
    static constexpr bool PERM = true, AFTER_DRAIN = false;
    bf16* O; int ldc;
    __device__ __forceinline__ void operator()(const f32x4 (&acc)[2][2][4][2], const pg8::Unit& u, int wr, int wc, int fr, int fq) const {
#pragma unroll
        for (int ai = 0; ai < 2; ++ai)
#pragma unroll
            for (int m = 0; m < 4; ++m) {
                const int row = u.pm * 256 + ai * 128 + wr * 64 + m * 16 + fr;
#pragma unroll
                for (int bj = 0; bj < 2; ++bj) {
                    const int col = u.pn * 256 + bj * 128 + wc * 32 + fq * 8;
                    const f32x4 v0 = acc[ai][bj][m][0], v1 = acc[ai][bj][m][1];
                    v4u o; o.x = cvtpk(v0.x, v0.y); o.y = cvtpk(v0.z, v0.w); o.z = cvtpk(v1.x, v1.y); o.w = cvtpk(v1.z, v1.w);
                    *(v4u*)(O + (size_t)row * ldc + col) = o;
                }
            }
    }
};


__device__ __forceinline__ void conv_task(const __amdgpu_buffer_rsrc_t rs, unsigned gb_off, unsigned csb_off, const LAS float* wl, const float* cb, const float* lg, const float* lb, bf16* MIX, int task, int lane) {
    const bool samp = task >= 4096;
    const int b = samp ? task - 4096 : task >> 9, t0 = samp ? 0 : (task & 511) * 8;
    const size_t rowbase = samp ? (size_t)NP + (size_t)b * 8 : (size_t)b * 4096;
    f32x2_t acc2[8][4];
    f32x4 wA[8], wB[8];
#pragma unroll
    for (int tt = 0; tt < 8; ++tt) {
        wA[tt] = (f32x4){0.f, 0.f, 0.f, 0.f}; wB[tt] = (f32x4){0.f, 0.f, 0.f, 0.f};
#pragma unroll
        for (int c = 0; c < 4; ++c) acc2[tt][c] = (f32x2_t){0.f, 0.f};
    }
    v4u cur[16];
    const unsigned baseB = gb_off + (unsigned)((int)rowbase + t0 - 30) * 1024u;
    const unsigned baseA = samp ? csb_off + (unsigned)(b * 30) * 1024u : baseB;
    const int rmin = samp ? 0 : (30 - t0 > 0 ? 30 - t0 : 0);
#define CONV_LOADROW(RR, DST) do { const int rr_ = (RR); \
            const unsigned bs_ = rr_ < 30 ? baseA : baseB; const bool ok_ = (rr_ >= rmin) & (rr_ < 38); \
            const unsigned ro_ = ok_ ? bs_ + (unsigned)rr_ * 1024u : 0x80000000u; \
            DST = __builtin_amdgcn_raw_buffer_load_b128(rs, (int)(ro_ + lane16), 0, 0); } while (0)
    const unsigned lane16 = 16u * (unsigned)lane;
#pragma unroll
    for (int i = 0; i < 16; ++i) CONV_LOADROW(i, cur[i]);
    { const LAS f32x4* wp = (const LAS f32x4*)(wl + 8 * lane); wA[0] = wp[0]; wB[0] = wp[1]; }
#define CONV_FMA(I, TT) do { const int sl_ = ((I) - (TT)) & 7; \
                acc2[TT][0] = __builtin_elementwise_fma((f32x2_t){wA[sl_].x, wA[sl_].y}, x01, acc2[TT][0]); \
                acc2[TT][1] = __builtin_elementwise_fma((f32x2_t){wA[sl_].z, wA[sl_].w}, x23, acc2[TT][1]); \
                acc2[TT][2] = __builtin_elementwise_fma((f32x2_t){wB[sl_].x, wB[sl_].y}, x45, acc2[TT][2]); \
                acc2[TT][3] = __builtin_elementwise_fma((f32x2_t){wB[sl_].z, wB[sl_].w}, x67, acc2[TT][3]); } while (0)
#define CONV_ROW(I, RR, REFILL) do { const int rr = (RR); \
            const v4u u = cur[I]; \
            const f32x2_t x01 = {bflo(u.x), bfhi(u.x)}, x23 = {bflo(u.y), bfhi(u.y)}, x45 = {bflo(u.z), bfhi(u.z)}, x67 = {bflo(u.w), bfhi(u.w)}; \
            if (REFILL) CONV_LOADROW(rr + 16, cur[I]); \
            CONV_FMA(I, 7); \
            __builtin_amdgcn_sched_barrier(0); \
            { const int kk = rr + 1 > 31 ? 31 : rr + 1; const LAS f32x4* wp = (const LAS f32x4*)(wl + kk * 512 + 8 * lane); wA[((I) + 1) & 7] = wp[0]; wB[((I) + 1) & 7] = wp[1]; }     \
            __builtin_amdgcn_sched_barrier(0); \
            CONV_FMA(I, 0); CONV_FMA(I, 1); CONV_FMA(I, 2); CONV_FMA(I, 3); CONV_FMA(I, 4); CONV_FMA(I, 5); CONV_FMA(I, 6); \
            __builtin_amdgcn_sched_barrier(0); } while (0)
#pragma unroll 1
    for (int c0 = 0; c0 < 32; c0 += 16) {
#pragma unroll
        for (int i = 0; i < 16; ++i) CONV_ROW(i, c0 + i, true);
    }
#pragma unroll
    for (int i = 0; i < 8; ++i) CONV_ROW(i, 32 + i, false);
#undef CONV_ROW
#undef CONV_FMA
#undef CONV_LOADROW
    float acc[8][8];
#pragma unroll
    for (int tt = 0; tt < 8; ++tt)
#pragma unroll
        for (int c = 0; c < 4; ++c) { acc[tt][2 * c] = acc2[tt][c].x; acc[tt][2 * c + 1] = acc2[tt][c].y; }
    const f32x4 cb0 = *(const f32x4*)(cb + 8 * lane), cb1 = *(const f32x4*)(cb + 8 * lane + 4);
    const f32x4 lg0 = *(const f32x4*)(lg + 8 * lane), lg1 = *(const f32x4*)(lg + 8 * lane + 4);
    const f32x4 lb0 = *(const f32x4*)(lb + 8 * lane), lb1 = *(const f32x4*)(lb + 8 * lane + 4);
    const float cbv[8] = {cb0.x, cb0.y, cb0.z, cb0.w, cb1.x, cb1.y, cb1.z, cb1.w};
    const float lgv[8] = {lg0.x, lg0.y, lg0.z, lg0.w, lg1.x, lg1.y, lg1.z, lg1.w};
    const float lbv[8] = {lb0.x, lb0.y, lb0.z, lb0.w, lb1.x, lb1.y, lb1.z, lb1.w};
#pragma unroll
    for (int tt = 0; tt < 8; ++tt) {
        float y[8]; float s1 = 0.f;
#pragma unroll
        for (int c = 0; c < 8; ++c) { y[c] = acc[tt][c] + cbv[c]; s1 += y[c]; }
        const float mean = wave_sum(s1) * (1.f / 512.f);
        float s2 = 0.f;
#pragma unroll
        for (int c = 0; c < 8; ++c) { y[c] -= mean; s2 += y[c] * y[c]; }
        const float rstd = rsqrtf(wave_sum(s2) * (1.f / 512.f) + LN_EPS);
        float z[8];
#pragma unroll
        for (int c = 0; c < 8; ++c) { const float v = y[c] * rstd * lgv[c] + lbv[c]; z[c] = v / (1.f + __expf(-v)); }
        v4u o; o.x = cvtpk(z[0], z[1]); o.y = cvtpk(z[2], z[3]); o.z = cvtpk(z[4], z[5]); o.w = cvtpk(z[6], z[7]);
        *(v4u*)(MIX + (rowbase + t0 + tt) * 1024 + 512 + 8 * lane) = o;
    }
}

__device__ __forceinline__ void ln1_rows4(const bf16* H, bf16* X1B, const float* g, const float* bt, int r, int lane) {
    const v4u* hr = (const v4u*)(H + (size_t)r * DM) + 2 * lane;
    v4u hv[4][2];
#pragma unroll
    for (int u = 0; u < 4; ++u) { hv[u][0] = hr[u * 128]; hv[u][1] = hr[u * 128 + 1]; }
    const f32x4* gp = (const f32x4*)g + 4 * lane; const f32x4* bp = (const f32x4*)bt + 4 * lane;
    float gv[16], bv[16];
#pragma unroll
    for (int q = 0; q < 4; ++q) { const f32x4 a = gp[q], b = bp[q]; gv[4 * q] = a.x; gv[4 * q + 1] = a.y; gv[4 * q + 2] = a.z; gv[4 * q + 3] = a.w; bv[4 * q] = b.x; bv[4 * q + 1] = b.y; bv[4 * q + 2] = b.z; bv[4 * q + 3] = b.w; }
#pragma unroll
    for (int u = 0; u < 4; ++u) {
        float v[16];
#pragma unroll
        for (int k = 0; k < 2; ++k) { const v4u a = hv[u][k];
            v[8 * k] = bflo(a.x); v[8 * k + 1] = bfhi(a.x); v[8 * k + 2] = bflo(a.y); v[8 * k + 3] = bfhi(a.y); v[8 * k + 4] = bflo(a.z); v[8 * k + 5] = bfhi(a.z); v[8 * k + 6] = bflo(a.w); v[8 * k + 7] = bfhi(a.w); }
        float s = 0.f;
#pragma unroll
        for (int i = 0; i < 16; ++i) s += v[i];
        const float mean = wave_sum(s) * (1.f / DM); float s2 = 0.f;
#pragma unroll
        for (int i = 0; i < 16; ++i) { v[i] -= mean; s2 += v[i] * v[i]; }
        const float rstd = rsqrtf(wave_sum(s2) * (1.f / DM) + LN_EPS);
        float o[16];
#pragma unroll
        for (int i = 0; i < 16; ++i) o[i] = v[i] * rstd * gv[i] + bv[i];
        v4u w0, w1;
        w0.x = cvtpk(o[0], o[1]); w0.y = cvtpk(o[2], o[3]); w0.z = cvtpk(o[4], o[5]); w0.w = cvtpk(o[6], o[7]);
        w1.x = cvtpk(o[8], o[9]); w1.y = cvtpk(o[10], o[11]); w1.z = cvtpk(o[12], o[13]); w1.w = cvtpk(o[14], o[15]);
        v4u* od = (v4u*)(X1B + (size_t)(r + u) * DM) + 2 * lane; od[0] = w0; od[1] = w1;
    }
}

__device__ __forceinline__ unsigned f2key(float f) { const unsigned u = __float_as_uint(f); return (u & 0x80000000u) ? ~u : (u | 0x80000000u); }
__device__ __forceinline__ float key2f(unsigned k) { const unsigned u = (k & 0x80000000u) ? (k & 0x7fffffffu) : ~k; return __uint_as_float(u); }
__device__ __forceinline__ unsigned umax2(unsigned a, unsigned b) { return a > b ? a : b; }
__device__ __forceinline__ unsigned umin2(unsigned a, unsigned b) { return a < b ? a : b; }

typedef short bf16x8_t __attribute__((ext_vector_type(8)));
typedef float f32x16_t __attribute__((ext_vector_type(16)));
typedef short s16x4_t __attribute__((ext_vector_type(4)));
__device__ __forceinline__ int crow(int r, int hi) { return (r & 3) + 8 * (r >> 2) + 4 * hi; }
__device__ __forceinline__ s16x4_t vtr(const LAS unsigned char* p) { return __builtin_bit_cast(s16x4_t, __builtin_amdgcn_ds_read_tr16_b64_v4i16((LAS s16x4_t*)p)); }
struct AttnArgs { const bf16* QB; const bf16* KB; const bf16* VB; const float* ck; const float* cv; const float* out; bf16* OP; float* LSE; };
__device__ __forceinline__ bf16x8_t cvt8(const f32x4 a, const f32x4 b) { const v4u u = {cvtpk(a.x, a.y), cvtpk(a.z, a.w), cvtpk(b.x, b.y), cvtpk(b.z, b.w)}; return __builtin_bit_cast(bf16x8_t, u); }
template <bool SAMP, bool FULL>
__device__ __forceinline__ void attn_mfma_task(const AttnArgs& A, int task, LAS unsigned char* vbuf, int lane) {
    int b, h, br, res, i0, nq;
    if constexpr (!SAMP) {
        const int ti = task & 127; int rest = task >> 7; br = rest % 3; rest /= 3; h = rest & 7; b = rest >> 3;
        const int sh_ = 2 * br; res = ti >> (7 - sh_); i0 = (ti & ((128 >> sh_) - 1)) * 32; nq = 32;
    } else {
        const int sub = task % 13; int rest = task / 13; h = rest & 7; b = rest >> 3;
        if (sub == 0) { br = 0; res = 0; i0 = 2048; nq = 8; } else if (sub < 5) { br = 1; res = sub - 1; i0 = 512; nq = 2; } else { br = 2; res = sub - 5; i0 = 128; nq = 1; }
    }
    const int sh = 2 * br;
    const int q = lane & 31, hi = lane >> 5;
    const size_t rowb = (size_t)b * 4096;
    auto srow = [&](const float* cache, size_t onew, int pp) -> const float* {
        const int pc = pp > 2055 ? 2055 : pp;
        return pc < LB ? cache + ((size_t)b * 2048 + pc) * 512 + h * 64 : A.out + onew + ((size_t)b * 2048 + pc - 8) * 512 + h * 64;
    };
    const int iq = i0 + (q < nq ? q : nq - 1);
    const int posq = res + (iq << sh);
    const size_t qrow = SAMP ? (size_t)NP + (size_t)b * 8 + (posq - LB) : rowb + posq;
    bf16x8_t qf[4];
    { const bf16* qp = A.QB + qrow * 512 + h * 64 + 8 * hi;
#pragma unroll
      for (int ks = 0; ks < 4; ++ks) qf[ks] = *(const bf16x8_t*)(qp + 16 * ks); }
    const int tstart = FULL ? 0 : (i0 >= 128 ? 0 : ((128 - i0) >> 5));
    const int vc = lane & 7, vr = lane >> 3;
    const int vdst = (vc >> 2) * 2048 + vr * 64 + (vc & 3) * 16;
    v4u vreg[4];
    auto loadv = [&](int t) {
#pragma unroll
        for (int i_ = 0; i_ < 4; ++i_) {
            const int j_ = i0 - 128 + 32 * t + vr + 8 * i_;
            if constexpr (!SAMP) { vreg[i_] = *(const v4u*)(A.VB + (rowb + res + ((size_t)j_ << sh)) * 512 + h * 64 + 8 * vc); }
            else { const f32x4* vp_ = (const f32x4*)(srow(A.cv, O_VS, res + (j_ << sh)) + 8 * vc); vreg[i_] = __builtin_bit_cast(v4u, cvt8(vp_[0], vp_[1])); }
        }
    };
    if (tstart == 0) loadv(0); else if (tstart == 1) loadv(1); else if (tstart == 2) loadv(2); else if (tstart == 3) loadv(3); else loadv(4);
    f32x16_t sc[5];
    float mx = -INFINITY;
    bf16x8_t kall[FULL ? 5 : 1][4];
    if constexpr (FULL) {
#pragma unroll
        for (int t = 0; t < 5; ++t) {
            const int j = i0 - 128 + 32 * t + q;
            if constexpr (!SAMP) {
                const bf16* kp = A.KB + (rowb + res + ((size_t)j << sh)) * 512 + h * 64 + 8 * hi;
#pragma unroll
                for (int ks = 0; ks < 4; ++ks) kall[t][ks] = *(const bf16x8_t*)(kp + 16 * ks);
            } else {
                const f32x4* kp = (const f32x4*)(srow(A.ck, O_KS, res + (j << sh)) + 8 * hi);
#pragma unroll
                for (int ks = 0; ks < 4; ++ks) kall[t][ks] = cvt8(kp[4 * ks], kp[4 * ks + 1]);
            }
        }
        __builtin_amdgcn_sched_barrier(0);
    }
#pragma unroll
    for (int t = 0; t < 5; ++t) {
        if (t >= tstart) {
            const int j = i0 - 128 + 32 * t + q;
            bf16x8_t kf[4];
            if constexpr (FULL) {
#pragma unroll
                for (int ks = 0; ks < 4; ++ks) kf[ks] = kall[t][ks];
            } else if constexpr (!SAMP) {
                const bf16* kp = A.KB + (rowb + res + ((size_t)j << sh)) * 512 + h * 64 + 8 * hi;
#pragma unroll
                for (int ks = 0; ks < 4; ++ks) kf[ks] = *(const bf16x8_t*)(kp + 16 * ks);
            } else {
                const f32x4* kp = (const f32x4*)(srow(A.ck, O_KS, res + (j << sh)) + 8 * hi);
#pragma unroll
                for (int ks = 0; ks < 4; ++ks) kf[ks] = cvt8(kp[4 * ks], kp[4 * ks + 1]);
            }
            f32x16_t a = {0.f, 0.f, 0.f, 0.f, 0.f, 0.f, 0.f, 0.f, 0.f, 0.f, 0.f, 0.f, 0.f, 0.f, 0.f, 0.f};
#pragma unroll
            for (int ks = 0; ks < 4; ++ks) a = __builtin_amdgcn_mfma_f32_32x32x16_bf16(kf[ks], qf[ks], a, 0, 0, 0);
#pragma unroll
            for (int r = 0; r < 16; ++r) {
                float v = a[r] * 0.125f;
                if (t == 0) { if (crow(r, hi) < q) v = -INFINITY; }
                if (t == 4) { if (crow(r, hi) > q) v = -INFINITY; }
                a[r] = v; mx = fmaxf(mx, v);
            }
            sc[t] = a;
        } else {
#pragma unroll
            for (int r = 0; r < 16; ++r) sc[t][r] = -INFINITY;
        }
    }
    mx = fmaxf(mx, __shfl_xor(mx, 32));
    float l = 0.f;
#pragma unroll
    for (int t = 0; t < 5; ++t)
#pragma unroll
        for (int r = 0; r < 16; ++r) { const float pv = __expf(sc[t][r] - mx); sc[t][r] = pv; l += pv; }
    l += __shfl_xor(l, 32);
    f32x16_t o0 = {0.f, 0.f, 0.f, 0.f, 0.f, 0.f, 0.f, 0.f, 0.f, 0.f, 0.f, 0.f, 0.f, 0.f, 0.f, 0.f}, o1 = o0;
    const int vb = ((lane >> 4) & 1) * 32 + (lane & 3) * 8 + (4 * hi + ((lane & 15) >> 2)) * 64;
#pragma unroll
    for (int t = 0; t < 5; ++t) {
        if (t >= tstart) {
            LAS unsigned char* buf = vbuf + (t & 1) * 4096;
#pragma unroll
            for (int i = 0; i < 4; ++i) *(LAS v4u*)(buf + vdst + i * 512) = vreg[i];
            if (t < 4) loadv(t + 1);
            LDS_WAIT();
            unsigned pw_[8];
#pragma unroll
            for (int k = 0; k < 8; ++k) pw_[k] = cvtpk(sc[t][2 * k], sc[t][2 * k + 1]);
            const v4u pa0u = {pw_[0], pw_[1], pw_[2], pw_[3]}, pa1u = {pw_[4], pw_[5], pw_[6], pw_[7]};
            const bf16x8_t pa0 = __builtin_bit_cast(bf16x8_t, pa0u), pa1 = __builtin_bit_cast(bf16x8_t, pa1u);
            const LAS unsigned char* vp = buf + vb;
            s16x4_t lo, hh;
#define ATT_VFR() (bf16x8_t){lo[0], lo[1], lo[2], lo[3], hh[0], hh[1], hh[2], hh[3]}
            lo = vtr(vp);               hh = vtr(vp + 512);         o0 = __builtin_amdgcn_mfma_f32_32x32x16_bf16(pa0, ATT_VFR(), o0, 0, 0, 0);
            lo = vtr(vp + 1024);        hh = vtr(vp + 1024 + 512);  o0 = __builtin_amdgcn_mfma_f32_32x32x16_bf16(pa1, ATT_VFR(), o0, 0, 0, 0);
            lo = vtr(vp + 2048);        hh = vtr(vp + 2048 + 512);  o1 = __builtin_amdgcn_mfma_f32_32x32x16_bf16(pa0, ATT_VFR(), o1, 0, 0, 0);
            lo = vtr(vp + 3072);        hh = vtr(vp + 3072 + 512);  o1 = __builtin_amdgcn_mfma_f32_32x32x16_bf16(pa1, ATT_VFR(), o1, 0, 0, 0);
#undef ATT_VFR
            LDS_WAIT();
        }
    }
    const float rl = 1.f / l;
#pragma unroll
    for (int r = 0; r < 16; ++r) {
        const int qq = crow(r, hi);
        const float ri = __shfl(rl, qq);
        const int pp = res + ((i0 + qq) << sh);
        const size_t orow_ = SAMP ? (size_t)NP + (size_t)b * 8 + (pp - LB) : rowb + pp;
        if (qq < nq) {
            bf16* orow = A.OP + ((size_t)br * NTOK + orow_) * 512 + h * 64 + q;
            orow[0] = (bf16)(cvtpk(o0[r] * ri, 0.f) & 0xffffu);
            orow[32] = (bf16)(cvtpk(o1[r] * ri, 0.f) & 0xffffu);
        }
    }
    if (hi == 0 && q < nq) A.LSE[((size_t)br * NTOK + qrow) * 8 + h] = mx + __logf(l);
}
constexpr int ATT_KIMG = 0, ATT_VIMG = 49152, ATT_VPLANE = 24576, ATT_OTILE = 98304;
__device__ __forceinline__ void attn_block_phase(const AttnArgs& A, LAS unsigned char* lds, int G, int tid, int wave, int lane) {
    constexpr int NUNIT = NPB * NH * 3 * 16;
    asm volatile("" : "+v"(lane));
    const int q = lane & 31, hi = lane >> 5;
    const int srow0 = wave * 8 + (lane >> 3), sch = lane & 7;
    v4u pk_[6], pv_[6];
    auto decode = [&](int unit, int& b, int& h, int& br, int& res, int& i0u) {
        const int uu = unit & 15; int rest = unit >> 4; br = rest % 3; rest /= 3; h = rest & 7; b = rest >> 3;
        const int sh_ = 2 * br, upr = 16 >> sh_; res = uu / upr; i0u = (uu % upr) * 256;
    };
    auto request = [&](int unit) {
        int b, h, br, res, i0u; decode(unit, b, h, br, res, i0u); const int sh = 2 * br; const size_t rowb = (size_t)b * 4096;
#pragma unroll
        for (int p_ = 0; p_ < 6; ++p_) {
            const int row = srow0 + 64 * p_, j = i0u - 128 + row;
            if (j >= 0) { const size_t o = (rowb + res + ((size_t)j << sh)) * 512 + h * 64 + 8 * sch; pk_[p_] = *(const v4u*)(A.KB + o); pv_[p_] = *(const v4u*)(A.VB + o); }
        }
    };
    auto commit = [&](int unit) {
        int b, h, br, res, i0u; decode(unit, b, h, br, res, i0u);
#pragma unroll
        for (int p_ = 0; p_ < 6; ++p_) {
            const int row = srow0 + 64 * p_, j = i0u - 128 + row;
            if (j >= 0) {
                *(LAS v4u*)(lds + ATT_KIMG + row * 128 + ((sch ^ (row & 7)) << 4)) = pk_[p_];
                *(LAS v4u*)(lds + ATT_VIMG + (sch >> 2) * ATT_VPLANE + row * 64 + (sch & 3) * 16) = pv_[p_];
            }
        }
    };
    int unit = (int)blockIdx.x;
    if (unit < NUNIT) request(unit);
    bf16x8_t qf[4];
    auto request_q = [&](int u_) {
        int b, h, br, res, i0u; decode(u_, b, h, br, res, i0u); const int sh = 2 * br; const size_t rowb = (size_t)b * 4096;
        const bf16* qp = A.QB + (rowb + res + ((size_t)(i0u + 32 * wave + q) << sh)) * 512 + h * 64 + 8 * hi;
#pragma unroll
        for (int ks = 0; ks < 4; ++ks) qf[ks] = *(const bf16x8_t*)(qp + 16 * ks);
    };
    if (unit < NUNIT) request_q(unit);
    constexpr float SC2 = 0.125f * 1.4426950408889634f;
    for (; unit < NUNIT; unit += G) {
        int b, h, br, res, i0u; decode(unit, b, h, br, res, i0u); const int sh = 2 * br; const size_t rowb = (size_t)b * 4096;
        __syncthreads();
        commit(unit);
        __syncthreads();
        if (unit + G < NUNIT) request(unit + G);
        const int i0 = i0u + 32 * wave;
        const int tstart = i0 >= 128 ? 0 : ((128 - i0) >> 5);
        f32x16_t sc[5]; float mx = -INFINITY;
#pragma unroll
        for (int t = 0; t < 5; ++t) {
            if (t >= tstart) {
                const int row = 32 * (wave + t) + q;
                bf16x8_t kf[4];
#pragma unroll
                for (int ks = 0; ks < 4; ++ks) kf[ks] = *(const LAS bf16x8_t*)(lds + ATT_KIMG + row * 128 + (((2 * ks + hi) ^ (row & 7)) << 4));
                f32x16_t a = {0.f, 0.f, 0.f, 0.f, 0.f, 0.f, 0.f, 0.f, 0.f, 0.f, 0.f, 0.f, 0.f, 0.f, 0.f, 0.f};
#pragma unroll
                for (int ks = 0; ks < 4; ++ks) a = __builtin_amdgcn_mfma_f32_32x32x16_bf16(kf[ks], qf[ks], a, 0, 0, 0);
#pragma unroll
                for (int r = 0; r < 16; ++r) {
                    float v = a[r];
                    if (t == 0) { if (crow(r, hi) < q) v = -INFINITY; }
                    if (t == 4) { if (crow(r, hi) > q) v = -INFINITY; }
                    a[r] = v; mx = fmaxf(mx, v);
                }
                sc[t] = a;
            } else {
#pragma unroll
                for (int r = 0; r < 16; ++r) sc[t][r] = -INFINITY;
            }
        }
        if (unit + G < NUNIT) request_q(unit + G);
        mx = fmaxf(mx, __shfl_xor(mx, 32));
        const float mb = mx * SC2;
        float l = 0.f;
        unsigned pkp[5][8];
#pragma unroll
        for (int t = 0; t < 5; ++t)
#pragma unroll
            for (int k = 0; k < 8; ++k) { const float p0 = __builtin_amdgcn_exp2f(fmaf(sc[t][2 * k], SC2, -mb)), p1 = __builtin_amdgcn_exp2f(fmaf(sc[t][2 * k + 1], SC2, -mb)); l += p0 + p1; pkp[t][k] = cvtpk(p0, p1); }
        l += __shfl_xor(l, 32);
        f32x16_t o0 = {0.f, 0.f, 0.f, 0.f, 0.f, 0.f, 0.f, 0.f, 0.f, 0.f, 0.f, 0.f, 0.f, 0.f, 0.f, 0.f}, o1 = o0;
        const int vb = ((lane >> 4) & 1) * 32 + (lane & 3) * 8 + (4 * hi + ((lane & 15) >> 2)) * 64;
#pragma unroll
        for (int t = 0; t < 5; ++t) {
            if (t >= tstart) {
                const v4u pa0u = {pkp[t][0], pkp[t][1], pkp[t][2], pkp[t][3]}, pa1u = {pkp[t][4], pkp[t][5], pkp[t][6], pkp[t][7]};
                const bf16x8_t pa0 = __builtin_bit_cast(bf16x8_t, pa0u), pa1 = __builtin_bit_cast(bf16x8_t, pa1u);
                const LAS unsigned char* vp = lds + ATT_VIMG + 32 * (wave + t) * 64 + vb;
                s16x4_t lo, hh;
#define ATT_VFR() (bf16x8_t){lo[0], lo[1], lo[2], lo[3], hh[0], hh[1], hh[2], hh[3]}
                lo = vtr(vp);                      hh = vtr(vp + 512);                      o0 = __builtin_amdgcn_mfma_f32_32x32x16_bf16(ATT_VFR(), pa0, o0, 0, 0, 0);
                lo = vtr(vp + 1024);               hh = vtr(vp + 1024 + 512);               o0 = __builtin_amdgcn_mfma_f32_32x32x16_bf16(ATT_VFR(), pa1, o0, 0, 0, 0);
                lo = vtr(vp + ATT_VPLANE);         hh = vtr(vp + ATT_VPLANE + 512);         o1 = __builtin_amdgcn_mfma_f32_32x32x16_bf16(ATT_VFR(), pa0, o1, 0, 0, 0);
                lo = vtr(vp + ATT_VPLANE + 1024);  hh = vtr(vp + ATT_VPLANE + 1024 + 512);  o1 = __builtin_amdgcn_mfma_f32_32x32x16_bf16(ATT_VFR(), pa1, o1, 0, 0, 0);
#undef ATT_VFR
            }
        }
        const float rl = 1.f / l;
        const size_t orow_ = rowb + res + ((size_t)(i0 + q) << sh);
        {
            LAS unsigned char* ot = lds + ATT_OTILE + wave * 4096;
            const int fq_ = (q >> 1) & 7;
#pragma unroll
            for (int g = 0; g < 4; ++g) {
                v2u w0, w1;
                w0.x = cvtpk(o0[4 * g] * rl, o0[4 * g + 1] * rl); w0.y = cvtpk(o0[4 * g + 2] * rl, o0[4 * g + 3] * rl);
                w1.x = cvtpk(o1[4 * g] * rl, o1[4 * g + 1] * rl); w1.y = cvtpk(o1[4 * g + 2] * rl, o1[4 * g + 3] * rl);
                *(LAS v2u*)(ot + q * 128 + ((g ^ fq_) << 4) + 8 * hi) = w0;
                *(LAS v2u*)(ot + q * 128 + (((4 + g) ^ fq_) << 4) + 8 * hi) = w1;
            }
            LDS_WAIT();
#pragma unroll
            for (int i = 0; i < 4; ++i) {
                const int r = 8 * i + (lane >> 3), c = lane & 7;
                const v4u w = *(const LAS v4u*)(ot + r * 128 + ((c ^ ((r >> 1) & 7)) << 4));
                *(v4u*)(A.OP + ((size_t)br * NTOK + rowb + res + ((size_t)(i0 + r) << sh)) * 512 + h * 64 + 8 * c) = w;
            }
            LDS_WAIT();
        }
        if (hi == 0) A.LSE[((size_t)br * NTOK + orow_) * 8 + h] = mx * 0.125f + __logf(l);
    }
}
__device__ __forceinline__ void attn_merge_row(const bf16* OP, const float* LSE, bf16* MIX, int r, int lane) {
    const int h = lane >> 3;
    const float l0 = LSE[((size_t)0 * NTOK + r) * 8 + h], l1 = LSE[((size_t)1 * NTOK + r) * 8 + h], l2 = LSE[((size_t)2 * NTOK + r) * 8 + h];
    const float m = fmaxf(l0, fmaxf(l1, l2));
    float w0 = __expf(l0 - m), w1 = __expf(l1 - m), w2 = __expf(l2 - m);
    const float inv = 1.f / (w0 + w1 + w2); w0 *= inv; w1 *= inv; w2 *= inv;
    const v4u a = *(const v4u*)(OP + ((size_t)0 * NTOK + r) * 512 + 8 * lane), bq = *(const v4u*)(OP + ((size_t)1 * NTOK + r) * 512 + 8 * lane), c = *(const v4u*)(OP + ((size_t)2 * NTOK + r) * 512 + 8 * lane);
    v4u o;
    o.x = cvtpk(w0 * bflo(a.x) + w1 * bflo(bq.x) + w2 * bflo(c.x), w0 * bfhi(a.x) + w1 * bfhi(bq.x) + w2 * bfhi(c.x));
    o.y = cvtpk(w0 * bflo(a.y) + w1 * bflo(bq.y) + w2 * bflo(c.y), w0 * bfhi(a.y) + w1 * bfhi(bq.y) + w2 * bfhi(c.y));
    o.z = cvtpk(w0 * bflo(a.z) + w1 * bflo(bq.z) + w2 * bflo(c.z), w0 * bfhi(a.z) + w1 * bfhi(bq.z) + w2 * bfhi(c.z));
    o.w = cvtpk(w0 * bflo(a.w) + w1 * bflo(bq.w) + w2 * bflo(c.w), w0 * bfhi(a.w) + w1 * bfhi(bq.w) + w2 * bfhi(c.w));
    *(v4u*)(MIX + (size_t)r * 1024 + 8 * lane) = o;
}

__device__ __forceinline__ void cswap(unsigned& a, unsigned& b) { const unsigned hi_ = a > b ? a : b, lo_ = a > b ? b : a; a = hi_; b = lo_; }
__device__ __forceinline__ void sort16_desc(unsigned (&x)[16]) {
#pragma unroll
    for (int k = 2; k <= 16; k <<= 1)
#pragma unroll
        for (int j = k >> 1; j > 0; j >>= 1)
#pragma unroll
            for (int i = 0; i < 16; ++i) { const int l = i ^ j; if (l > i) { if ((i & k) == 0) cswap(x[i], x[l]); else cswap(x[l], x[i]); } }
}
__device__ __forceinline__ void merge16_desc(unsigned (&a)[16], const unsigned (&b)[16]) {
#pragma unroll
    for (int i = 0; i < 16; ++i) a[i] = umax2(a[i], b[15 - i]);
#pragma unroll
    for (int j = 8; j > 0; j >>= 1)
#pragma unroll
        for (int i = 0; i < 16; ++i) { const int l = i ^ j; if (l > i) cswap(a[i], a[l]); }
}
__device__ __forceinline__ void pair_merge16(unsigned (&a)[16]) {
    unsigned pb[16];
#pragma unroll
    for (int i = 0; i < 16; ++i) pb[i] = (unsigned)__shfl_xor((int)a[i], 32);
    merge16_desc(a, pb);
}
struct CacheCopy { const f32x4* ck; const f32x4* cv; f32x4* ok; f32x4* ov; };
__device__ __forceinline__ void top16_of_half(const bf16* PQ, const LAS unsigned char* skl, int token0, int h, int p, int lane, unsigned (&top)[16], const CacheCopy& cc, int slot0) {
    const int tok = lane & 31, hi = lane >> 5;
    const bf16* qp = PQ + (size_t)(token0 + tok) * PQD + h * 256 + p * 128 + 8 * hi;
    bf16x8_t bq[8];
#pragma unroll
    for (int ks = 0; ks < 8; ++ks) bq[ks] = *(const bf16x8_t*)(qp + 16 * ks);
    unsigned g0[16];
    constexpr long CPB = 2040L * 128, CTOT = NSB * CPB;
    int ci[2]; f32x4 ca[2], cb[2];
#pragma unroll 1
    for (int kt = 0; kt < 4; ++kt) {
        if (kt > 0) {
#pragma unroll
            for (int u = 0; u < 2; ++u) { cc.ok[ci[u]] = ca[u]; cc.ov[ci[u]] = cb[u]; }
        }
#pragma unroll
        for (int u = 0; u < 2; ++u) {
            int idx = (slot0 + kt) * 128 + lane + 64 * u; if (idx >= (int)CTOT) idx = (int)CTOT - 1;
            const int b = idx / (int)CPB, rem = idx - b * (int)CPB; ci[u] = b * 2048 * 128 + rem; ca[u] = cc.ck[ci[u] + 8 * 128]; cb[u] = cc.cv[ci[u] + 8 * 128];
        }
        f32x16_t a = {0.f, 0.f, 0.f, 0.f, 0.f, 0.f, 0.f, 0.f, 0.f, 0.f, 0.f, 0.f, 0.f, 0.f, 0.f, 0.f};
#pragma unroll
        for (int ks = 0; ks < 8; ++ks) { const int row = p * 128 + 32 * kt + tok; const bf16x8_t ka = *(const LAS bf16x8_t*)(skl + row * 256 + (((2 * ks + hi) ^ (row & 15)) << 4)); a = __builtin_amdgcn_mfma_f32_32x32x16_bf16(ka, bq[ks], a, 0, 0, 0); }
        unsigned x[16];
#pragma unroll
        for (int r = 0; r < 16; ++r) x[r] = (f2key(a[r]) & ~127u) | (unsigned)(32 * kt + crow(r, hi));
        sort16_desc(x);
        if (kt == 0) {
#pragma unroll
            for (int i = 0; i < 16; ++i) g0[i] = x[i];
        } else { merge16_desc(g0, x); }
    }
    pair_merge16(g0);
#pragma unroll
    for (int u = 0; u < 2; ++u) { cc.ok[ci[u]] = ca[u]; cc.ov[ci[u]] = cb[u]; }
#pragma unroll
    for (int i = 0; i < 16; ++i) top[i] = g0[i];
}
__device__ __forceinline__ void topk_mfma_task(const bf16* PQ, const LAS unsigned char* skl, int* IDX, float* GATE, int tile, int h, int lane, const CacheCopy& cc) {
    const int token0 = tile * 32;
    const int tok = lane & 31, hi = lane >> 5;
    unsigned t0[16], t1[16];
    const int slot0 = (tile * 8 + h) * 8;
    top16_of_half(PQ, skl, token0, h, 0, lane, t0, cc, slot0);
    top16_of_half(PQ, skl, token0, h, 1, lane, t1, cc, slot0 + 4);
    float v0[16], v1[16];
#pragma unroll
    for (int i = 0; i < 16; ++i) { v0[i] = key2f(t0[i] & ~127u); v1[i] = key2f(t1[i] & ~127u); }
    unsigned ca[16], cb[16];
#define CAND(dst, i0_, j0_, i1_, j1_, pad1) do { const float a_ = hi ? v0[i1_] : v0[i0_], b_ = hi ? v1[j1_] : v1[j0_]; \
        const unsigned pa_ = hi ? (t0[i1_] & 127u) : (t0[i0_] & 127u), pb_ = hi ? (t1[j1_] & 127u) : (t1[j0_] & 127u); \
        const unsigned fx_ = umin2((unsigned)fmaxf(fmaf(a_ + b_, 4096.f, 131072.5f), 0.f), 262143u);     \
        const unsigned k_ = (fx_ << 14) | (pa_ << 7) | pb_; dst = ((pad1) && hi) ? 0u : k_; } while (0)
    CAND(ca[0], 0, 0, 1, 0, 0);  CAND(ca[1], 0, 1, 1, 1, 0);  CAND(ca[2], 0, 2, 1, 2, 0);  CAND(ca[3], 0, 3, 1, 3, 0);
    CAND(ca[4], 0, 4, 1, 4, 0);  CAND(ca[5], 0, 5, 1, 5, 0);  CAND(ca[6], 0, 6, 1, 6, 0);  CAND(ca[7], 0, 7, 1, 7, 0);
    CAND(ca[8], 0, 8, 3, 0, 0);  CAND(ca[9], 0, 9, 3, 1, 0);  CAND(ca[10], 0, 10, 3, 2, 0); CAND(ca[11], 0, 11, 3, 3, 0);
    CAND(ca[12], 0, 12, 5, 0, 0); CAND(ca[13], 0, 13, 5, 1, 0); CAND(ca[14], 0, 14, 6, 0, 0); CAND(ca[15], 0, 15, 6, 1, 0);
    CAND(cb[0], 2, 0, 7, 0, 0);  CAND(cb[1], 2, 1, 7, 1, 0);  CAND(cb[2], 2, 2, 0, 0, 1);  CAND(cb[3], 2, 3, 0, 0, 1);
    CAND(cb[4], 2, 4, 0, 0, 1);  CAND(cb[5], 4, 0, 0, 0, 1);  CAND(cb[6], 4, 1, 0, 0, 1);  CAND(cb[7], 4, 2, 0, 0, 1);
    CAND(cb[8], 8, 0, 0, 0, 1);  CAND(cb[9], 9, 0, 0, 0, 1);  CAND(cb[10], 10, 0, 0, 0, 1); CAND(cb[11], 11, 0, 0, 0, 1);
    CAND(cb[12], 12, 0, 0, 0, 1); CAND(cb[13], 13, 0, 0, 0, 1); CAND(cb[14], 14, 0, 0, 0, 1); CAND(cb[15], 15, 0, 0, 0, 1);
#undef CAND
    sort16_desc(ca); sort16_desc(cb);
    merge16_desc(ca, cb);
    pair_merge16(ca);
    float g[16]; float sum = 0.f;
    const float gm = (float)(ca[0] >> 14);
#pragma unroll
    for (int k = 0; k < 16; ++k) { g[k] = __expf(((float)(ca[k] >> 14) - gm) * (1.f / 4096.f)); sum += g[k]; }
    const float inv = 1.f / sum;
    v4u e0, e1; f32x4 g0, g1;
    e0.x = (hi ? ca[8] : ca[0]) & 0x3fffu; e0.y = (hi ? ca[9] : ca[1]) & 0x3fffu; e0.z = (hi ? ca[10] : ca[2]) & 0x3fffu; e0.w = (hi ? ca[11] : ca[3]) & 0x3fffu;
    e1.x = (hi ? ca[12] : ca[4]) & 0x3fffu; e1.y = (hi ? ca[13] : ca[5]) & 0x3fffu; e1.z = (hi ? ca[14] : ca[6]) & 0x3fffu; e1.w = (hi ? ca[15] : ca[7]) & 0x3fffu;
    g0.x = (hi ? g[8] : g[0]) * inv; g0.y = (hi ? g[9] : g[1]) * inv; g0.z = (hi ? g[10] : g[2]) * inv; g0.w = (hi ? g[11] : g[3]) * inv;
    g1.x = (hi ? g[12] : g[4]) * inv; g1.y = (hi ? g[13] : g[5]) * inv; g1.z = (hi ? g[14] : g[6]) * inv; g1.w = (hi ? g[15] : g[7]) * inv;
    const size_t o = (size_t)(token0 + tok) * 128 + h * 16 + 8 * hi;
    *(v4u*)(IDX + o) = e0; *(v4u*)(IDX + o + 4) = e1;
    *(f32x4*)(GATE + o) = g0; *(f32x4*)(GATE + o + 4) = g1;
}

__device__ __forceinline__ float gelu_erf(float x) { return 0.5f * x * (1.f + erff(x * 0.70710678118654752f)); }
__device__ __forceinline__ int rdlane_i(int v, int l) { return __builtin_amdgcn_readlane(v, l); }
__device__ __forceinline__ float rdlane_f(float v, int l) { return __int_as_float(__builtin_amdgcn_readlane(__float_as_int(v), l)); }
__device__ __forceinline__ void peer_finish_token6(f32x2_t (&acc2)[16], const bf16* X1B, const float* g2, const float* b2, float* Y, int r, int lane) {
    const int lp = lane & 31, hf = lane >> 5;
    float acc[32];
#pragma unroll
    for (int i = 0; i < 16; ++i) { acc[2 * i] = acc2[i].x; acc[2 * i + 1] = acc2[i].y; }
#pragma unroll
    for (int i = 0; i < 32; ++i) acc[i] += __shfl_xor(acc[i], 32);
    const v4u* hp = (const v4u*)(X1B + (size_t)r * DM) + 4 * lp;
    float z[32];
#pragma unroll
    for (int k = 0; k < 4; ++k) { const v4u a = hp[k];
        z[8 * k + 0] = bflo(a.x); z[8 * k + 1] = bfhi(a.x); z[8 * k + 2] = bflo(a.y); z[8 * k + 3] = bfhi(a.y); z[8 * k + 4] = bflo(a.z); z[8 * k + 5] = bfhi(a.z); z[8 * k + 6] = bflo(a.w); z[8 * k + 7] = bfhi(a.w); }
    float s = 0.f;
#pragma unroll
    for (int i = 0; i < 32; ++i) { z[i] = ALPHA * z[i] + acc[i]; s += z[i]; }
    const float mean = wave_sum(s) * (0.5f / DM); float s2 = 0.f;
#pragma unroll
    for (int i = 0; i < 32; ++i) { z[i] -= mean; s2 += z[i] * z[i]; }
    const float rstd = rsqrtf(wave_sum(s2) * (0.5f / DM) + LN_EPS);
    const int c0 = 32 * lp + 16 * hf;
    const f32x4* gp = (const f32x4*)(g2 + c0); const f32x4* bp = (const f32x4*)(b2 + c0);
    f32x4* yp = (f32x4*)(Y + (size_t)r * DM + c0);
#pragma unroll
    for (int q = 0; q < 4; ++q) {
        const f32x4 gv = gp[q], bv = bp[q];
        f32x4 o;
        o.x = (hf ? z[16 + 4 * q] : z[4 * q]) * rstd * gv.x + bv.x; o.y = (hf ? z[16 + 4 * q + 1] : z[4 * q + 1]) * rstd * gv.y + bv.y;
        o.z = (hf ? z[16 + 4 * q + 2] : z[4 * q + 2]) * rstd * gv.z + bv.z; o.w = (hf ? z[16 + 4 * q + 3] : z[4 * q + 3]) * rstd * gv.w + bv.w;
        yp[q] = o;
    }
}
__device__ __forceinline__ void peer_phase6(const bf16* X1B, const int* IDX, const float* GATE, const unsigned char* EU6, const unsigned char* EV6, const float* SU, const float* SV,
                                            const float* g2, const float* b2, float* Y, int gw, int NGW, int lane, LAS unsigned char* wl, LAS unsigned char* lds0, int wave, int nblk) {
    constexpr int TT = 2;
    LAS unsigned char* xl = wl;
    LAS v2u* Q = (LAS v2u*)(wl + TT * 4096);
    const __amdgpu_buffer_rsrc_t rsu = __builtin_amdgcn_make_buffer_rsrc((void*)EU6, 0, 16384 * 768, 0x00020000);
    const __amdgpu_buffer_rsrc_t rsv = __builtin_amdgcn_make_buffer_rsrc((void*)EV6, 0, 16384 * 768, 0x00020000);
    const int full = NTOK / (TT * NGW);
#define P6_XSTORE(BASE, A, B) do { LAS f32x4* xd_ = (LAS f32x4*)(BASE) + (4 * (lane & 1)) * 32 + (lane >> 1); \
        f32x4 f_; f_.x = bflo(A.x); f_.y = bfhi(A.x); f_.z = bflo(A.y); f_.w = bfhi(A.y); xd_[0] = f_; \
        f_.x = bflo(A.z); f_.y = bfhi(A.z); f_.z = bflo(A.w); f_.w = bfhi(A.w); xd_[32] = f_; \
        f_.x = bflo(B.x); f_.y = bfhi(B.x); f_.z = bflo(B.y); f_.w = bfhi(B.y); xd_[64] = f_; \
        f_.x = bflo(B.z); f_.y = bfhi(B.z); f_.z = bflo(B.w); f_.w = bfhi(B.w); xd_[96] = f_; } while (0)
#pragma unroll 1
    for (int pass = 0; pass < full; ++pass) {
        asm volatile("" : "+v"(lane));
        const int lp = lane & 31, hf = lane >> 5; const int voff24 = lp * 24;
        const int tok0 = (pass * NGW + gw) * TT; constexpr int T = TT;
        int e[2 * TT]; float g[2 * TT];
#pragma unroll
        for (int t = 0; t < TT; ++t) {
            if (t < T) {
                const size_t o = (size_t)(tok0 + t) * 128;
                e[2 * t] = IDX[o + lane]; e[2 * t + 1] = IDX[o + 64 + lane]; g[2 * t] = GATE[o + lane]; g[2 * t + 1] = GATE[o + 64 + lane];
                const v4u* xp = (const v4u*)(X1B + (size_t)(tok0 + t) * DM) + 2 * lane; const v4u a = xp[0], b = xp[1];
                P6_XSTORE(xl + t * 4096, a, b);
            } else { e[2 * t] = 1 << 20; e[2 * t + 1] = 1 << 20; g[2 * t] = 0.f; g[2 * t + 1] = 0.f; }
        }
        int pos[2 * TT];
#pragma unroll
        for (int r = 0; r < 2 * TT; ++r) pos[r] = 0;
        unsigned base[TT];
#pragma unroll
        for (int t = 0; t < TT; ++t) base[t] = 0u;
#pragma unroll 1
        for (int sl = 0; sl < 64; ++sl) {
#pragma unroll
            for (int r = 0; r < 2 * TT; ++r) {
                const bool hit = (e[r] >> 8) == sl;
                const unsigned long long m = __ballot(hit);
                const unsigned below = __builtin_amdgcn_mbcnt_hi((unsigned)(m >> 32), __builtin_amdgcn_mbcnt_lo((unsigned)m, 0u));
                if (hit) pos[r] = (int)(base[r >> 1] + below);
                base[r >> 1] += (unsigned)__popcll(m);
            }
        }
#pragma unroll
        for (int r = 0; r < 2 * TT; ++r) if ((e[r] >> 8) < 64) { v2u ent; ent.x = (unsigned)e[r]; ent.y = __float_as_uint(g[r]); Q[(r >> 1) * 128 + pos[r]] = ent; }
        LDS_WAIT();
        f32x2_t acc0[16], acc1[16];
#pragma unroll
        for (int i = 0; i < 16; ++i) { acc0[i] = (f32x2_t){0.f, 0.f}; acc1[i] = (f32x2_t){0.f, 0.f}; }
        v4u ub[4], vb[4]; v2u ub2[4], vb2[4];
        float gA, suA, svA;
#define P6_FETCH(QOFF) do { \
            const v2u ql_ = Q[(QOFF) + 2 * (lane & 3) + hf]; const int el_ = (int)ql_.x; gA = __uint_as_float(ql_.y); \
            _Pragma("unroll") for (int s_ = 0; s_ < 4; ++s_) { \
                const int ea_ = __builtin_amdgcn_readfirstlane((int)Q[(QOFF) + 2 * s_].x), eb_ = __builtin_amdgcn_readfirstlane((int)Q[(QOFF) + 2 * s_ + 1].x); \
                const int vo_ = (hf ? eb_ : ea_) * 768 + voff24; \
                ub[s_] = __builtin_amdgcn_raw_buffer_load_b128(rsu, vo_, 0, 0); ub2[s_] = __builtin_amdgcn_raw_buffer_load_b64(rsu, vo_ + 16, 0, 0); \
                vb[s_] = __builtin_amdgcn_raw_buffer_load_b128(rsv, vo_, 0, 0); vb2[s_] = __builtin_amdgcn_raw_buffer_load_b64(rsv, vo_ + 16, 0, 0); } \
            suA = SU[el_]; svA = SV[el_]; } while (0)
#define P6_CVT(RA, RB) __builtin_amdgcn_cvt_scalef32_pk32_f32_fp6((v6i_t){(int)RA.x, (int)RA.y, (int)RA.z, (int)RA.w, (int)RB.x, (int)RB.y}, 1.0f)
#define P6_MATH(TI, ACC) do { \
            f32x4 xq_[8]; \
            { const LAS f32x4* xp_ = (const LAS f32x4*)(xl + (TI) * 4096) + lp; \
              _Pragma("unroll") for (int k_ = 0; k_ < 8; ++k_) xq_[k_] = xp_[32 * k_]; } \
            float part[4]; \
            _Pragma("unroll") for (int s_ = 0; s_ < 4; ++s_) { const v32f_t uf_ = P6_CVT(ub[s_], ub2[s_]); f32x2_t d01_ = {0.f, 0.f}, d23_ = {0.f, 0.f}; \
                _Pragma("unroll") for (int k_ = 0; k_ < 8; ++k_) { \
                    d01_ = __builtin_elementwise_fma((f32x2_t){uf_[4 * k_], uf_[4 * k_ + 1]}, (f32x2_t){xq_[k_].x, xq_[k_].y}, d01_); \
                    d23_ = __builtin_elementwise_fma((f32x2_t){uf_[4 * k_ + 2], uf_[4 * k_ + 3]}, (f32x2_t){xq_[k_].z, xq_[k_].w}, d23_); } \
                part[s_] = (d01_.x + d01_.y) + (d23_.x + d23_.y); } \
            _Pragma("unroll") for (int off_ = 2; off_ >= 1; off_ >>= 1) { const bool up_ = (lane & off_) != 0; \
                _Pragma("unroll") for (int i_ = 0; i_ < off_; ++i_) { float pa_ = part[i_], pb_ = part[i_ + off_]; asm("" : "+v"(pa_), "+v"(pb_)); const float keep_ = up_ ? pb_ : pa_; const float send_ = up_ ? pa_ : pb_; part[i_] = keep_ + __shfl_xor(send_, off_); } } \
            float tot_ = part[0]; tot_ += __shfl_xor(tot_, 4); tot_ += __shfl_xor(tot_, 8); tot_ += __shfl_xor(tot_, 16);         \
            const float coefv_ = gA * svA * gelu_erf(suA * tot_); \
            _Pragma("unroll") for (int s_ = 0; s_ < 4; ++s_) { const float cf_ = __shfl(coefv_, (lane & 32) | s_); const f32x2_t cf2_ = {cf_, cf_}; const v32f_t vf_ = P6_CVT(vb[s_], vb2[s_]); \
                _Pragma("unroll") for (int i_ = 0; i_ < 16; ++i_) ACC[i_] = __builtin_elementwise_fma((f32x2_t){vf_[2 * i_], vf_[2 * i_ + 1]}, cf2_, ACC[i_]); } \
        } while (0)
#define P6_SB() __builtin_amdgcn_sched_barrier(0)
#define P6_ROUND(TI, ACC, QNEXT) do { \
            int von_[4]; \
            const v2u qn_ = Q[(QNEXT) + 2 * (lane & 3) + hf]; \
            _Pragma("unroll") for (int s_ = 0; s_ < 4; ++s_) { \
                const int ea_ = __builtin_amdgcn_readfirstlane((int)Q[(QNEXT) + 2 * s_].x), eb_ = __builtin_amdgcn_readfirstlane((int)Q[(QNEXT) + 2 * s_ + 1].x); \
                von_[s_] = (hf ? eb_ : ea_) * 768 + voff24; } \
            f32x4 xq_[8]; \
            { const LAS f32x4* xp_ = (const LAS f32x4*)(xl + (TI) * 4096) + lp; \
              _Pragma("unroll") for (int k_ = 0; k_ < 8; ++k_) xq_[k_] = xp_[32 * k_]; } \
            float part[4]; \
            _Pragma("unroll") for (int s_ = 0; s_ < 4; ++s_) { const v32f_t uf_ = P6_CVT(ub[s_], ub2[s_]); P6_SB(); \
                ub[s_] = __builtin_amdgcn_raw_buffer_load_b128(rsu, von_[s_], 0, 0); ub2[s_] = __builtin_amdgcn_raw_buffer_load_b64(rsu, von_[s_] + 16, 0, 0); P6_SB(); \
                f32x2_t d01_ = {0.f, 0.f}, d23_ = {0.f, 0.f}; \
                _Pragma("unroll") for (int k_ = 0; k_ < 8; ++k_) { \
                    d01_ = __builtin_elementwise_fma((f32x2_t){uf_[4 * k_], uf_[4 * k_ + 1]}, (f32x2_t){xq_[k_].x, xq_[k_].y}, d01_); \
                    d23_ = __builtin_elementwise_fma((f32x2_t){uf_[4 * k_ + 2], uf_[4 * k_ + 3]}, (f32x2_t){xq_[k_].z, xq_[k_].w}, d23_); } \
                part[s_] = (d01_.x + d01_.y) + (d23_.x + d23_.y); } \
            _Pragma("unroll") for (int off_ = 2; off_ >= 1; off_ >>= 1) { const bool up_ = (lane & off_) != 0; \
                _Pragma("unroll") for (int i_ = 0; i_ < off_; ++i_) { float pa_ = part[i_], pb_ = part[i_ + off_]; asm("" : "+v"(pa_), "+v"(pb_)); const float keep_ = up_ ? pb_ : pa_; const float send_ = up_ ? pa_ : pb_; part[i_] = keep_ + __shfl_xor(send_, off_); } } \
            float tot_ = part[0]; tot_ += __shfl_xor(tot_, 4); tot_ += __shfl_xor(tot_, 8); tot_ += __shfl_xor(tot_, 16); \
            const float coefv_ = gA * svA * gelu_erf(suA * tot_); \
            P6_SB(); gA = __uint_as_float(qn_.y); suA = SU[(int)qn_.x]; svA = SV[(int)qn_.x]; P6_SB(); \
            _Pragma("unroll") for (int s_ = 0; s_ < 4; ++s_) { const float cf_ = __shfl(coefv_, (lane & 32) | s_); const f32x2_t cf2_ = {cf_, cf_}; const v32f_t vf_ = P6_CVT(vb[s_], vb2[s_]); P6_SB(); \
                vb[s_] = __builtin_amdgcn_raw_buffer_load_b128(rsv, von_[s_], 0, 0); vb2[s_] = __builtin_amdgcn_raw_buffer_load_b64(rsv, von_[s_] + 16, 0, 0); P6_SB(); \
                _Pragma("unroll") for (int i_ = 0; i_ < 16; ++i_) ACC[i_] = __builtin_elementwise_fma((f32x2_t){vf_[2 * i_], vf_[2 * i_ + 1]}, cf2_, ACC[i_]); } \
        } while (0)
        if (T == 2) {
            P6_SB(); P6_FETCH(0); P6_SB();
#pragma unroll 1
            for (int jj = 0; jj < 16; ++jj) {
                if ((jj & 1) == 0) __builtin_amdgcn_s_barrier();
                P6_ROUND(0, acc0, 128 + 8 * jj); P6_SB();
                P6_ROUND(1, acc1, (jj < 15 ? 8 * jj + 8 : 120)); P6_SB();
            }
        } else {
#pragma unroll 1
            for (int jj = 0; jj < 16; ++jj) { P6_SB(); P6_FETCH(8 * jj); P6_SB(); P6_MATH(0, acc0); }
        }
        asm volatile("" ::: "memory"); __builtin_amdgcn_sched_barrier(0);
        peer_finish_token6(acc0, X1B, g2, b2, Y, tok0, lane);
        asm volatile("" ::: "memory"); __builtin_amdgcn_sched_barrier(0);
        if (T > 1) peer_finish_token6(acc1, X1B, g2, b2, Y, tok0 + 1, lane);
        LDS_WAIT();
    }
    {
        asm volatile("" : "+v"(lane));
        const int lp = lane & 31, hf = lane >> 5; const int voff24 = lp * 24;
        float gA, suA, svA; v4u ub[4], vb[4]; v2u ub2[4], vb2[4];
#pragma unroll 1
        for (int tr = full * TT * NGW + (int)blockIdx.x; tr < NTOK; tr += nblk) {
            __syncthreads();
            {
                const size_t o = (size_t)tr * 128 + 16 * wave + (lane & 15);
                if (lane < 16) { v2u ent; ent.x = (unsigned)IDX[o]; ent.y = __float_as_uint(GATE[o]); Q[lane] = ent; }
                const v4u* xp = (const v4u*)(X1B + (size_t)tr * DM) + 2 * lane; const v4u a = xp[0], b = xp[1];
                P6_XSTORE(xl, a, b);
            }
            LDS_WAIT();
            f32x2_t acc0[16];
#pragma unroll
            for (int i = 0; i < 16; ++i) acc0[i] = (f32x2_t){0.f, 0.f};
            P6_SB(); P6_FETCH(0); P6_SB(); P6_MATH(0, acc0);
            P6_SB(); P6_FETCH(8); P6_SB(); P6_MATH(0, acc0);
#pragma unroll
            for (int i = 0; i < 32; ++i) ((LAS float*)(wl + 4096))[i * 64 + lane] = (i & 1) ? acc0[i >> 1].y : acc0[i >> 1].x;
            __syncthreads();
            if (wave == 0) {
#pragma unroll 1
                for (int w = 1; w < 8; ++w) {
                    const LAS float* rp = (const LAS float*)(lds0 + w * 12288 + 4096) + lane;
#pragma unroll
                    for (int i = 0; i < 16; ++i) { acc0[i].x += rp[(2 * i) * 64]; acc0[i].y += rp[(2 * i + 1) * 64]; }
                }
                peer_finish_token6(acc0, X1B, g2, b2, Y, tr, lane);
            }
        }
    }
#undef P6_FETCH
#undef P6_XSTORE
#undef P6_CVT
#undef P6_MATH
#undef P6_ROUND
#undef P6_SB
}

template <int NB>
__device__ __forceinline__ void block_gemm32(const bf16* A, const bf16* Bt, int row0, int n0, int n1, LAS float* part, float (&v0)[2], float (&v1)[2], int tid) {
    const int lane = tid & 63, w = tid >> 6, q = lane & 31, hi = lane >> 5;
    const bf16* ap = A + (size_t)(row0 + q) * DM + 128 * w + 8 * hi;
    const bf16* b0p = Bt + (size_t)(n0 + q) * DM + 128 * w + 8 * hi;
    const bf16* b1p = Bt + (size_t)(n1 + q) * DM + 128 * w + 8 * hi;
    bf16x8_t af[8], bf0[8], bf1[8];
#pragma unroll
    for (int ks = 0; ks < 8; ++ks) { af[ks] = *(const bf16x8_t*)(ap + 16 * ks); bf0[ks] = *(const bf16x8_t*)(b0p + 16 * ks); if constexpr (NB == 2) bf1[ks] = *(const bf16x8_t*)(b1p + 16 * ks); }
    f32x16_t acc0 = {0.f, 0.f, 0.f, 0.f, 0.f, 0.f, 0.f, 0.f, 0.f, 0.f, 0.f, 0.f, 0.f, 0.f, 0.f, 0.f}, acc1 = acc0;
#pragma unroll
    for (int ks = 0; ks < 8; ++ks) {
        acc0 = __builtin_amdgcn_mfma_f32_32x32x16_bf16(af[ks], bf0[ks], acc0, 0, 0, 0);
        if constexpr (NB == 2) acc1 = __builtin_amdgcn_mfma_f32_32x32x16_bf16(af[ks], bf1[ks], acc1, 0, 0, 0);
    }
    __syncthreads();
#pragma unroll
    for (int r = 0; r < 16; ++r) { part[(w * 16 + r) * 64 + lane] = acc0[r]; if constexpr (NB == 2) part[8192 + (w * 16 + r) * 64 + lane] = acc1[r]; }
    __syncthreads();
#pragma unroll
    for (int e = 0; e < 2; ++e) {
        float s0 = 0.f, s1 = 0.f;
#pragma unroll
        for (int ww = 0; ww < 8; ++ww) { s0 += part[ww * 1024 + tid + 512 * e]; if constexpr (NB == 2) s1 += part[8192 + ww * 1024 + tid + 512 * e]; }
        v0[e] = s0; v1[e] = s1;
    }
}
__device__ __forceinline__ void tile_ij(int tid, int e, int& i, int& j) { const int idx = tid + 512 * e, r = idx >> 6, ln = idx & 63; i = crow(r, ln >> 5); j = ln & 31; }
__device__ __forceinline__ void sample_inproj_task(const bf16* XB, const bf16* WT1, bf16* QB, bf16* GB, float* out, int task, LAS float* part, int tid) {
    const int rt = task >> 6, ct = task & 63;
    float v0[2], v1[2];
    if (ct < 48) {
        block_gemm32<1>(XB, WT1, NP + 32 * rt, 32 * ct, 0, part, v0, v1, tid);
        const int which = ct >> 4;
#pragma unroll
        for (int e = 0; e < 2; ++e) {
            int i, j; tile_ij(tid, e, i, j);
            const int s_ = 32 * rt + i, col = (ct & 15) * 32 + j;
            QB[(size_t)which * ((size_t)NTOK * 512) + (size_t)(NP + s_) * 512 + col] = (bf16)(cvtpk(v0[e], 0.f) & 0xffffu);
            if (which != 0) out[(which == 1 ? O_KS : O_VS) + ((size_t)(s_ >> 3) * 2048 + 2040 + (s_ & 7)) * 512 + col] = v0[e];
        }
    } else {
        const int cb = ct - 48; const int na = 1536 + 256 * (cb >> 2) + (cb & 3) * 32;
        block_gemm32<2>(XB, WT1, NP + 32 * rt, na, na + 128, part, v0, v1, tid);
#pragma unroll
        for (int e = 0; e < 2; ++e) {
            int i, j; tile_ij(tid, e, i, j);
            const int s_ = 32 * rt + i, ch = cb * 32 + j;
            const float g = v0[e] / (1.f + __expf(-v1[e]));
            GB[(size_t)(NP + s_) * 512 + ch] = (bf16)(cvtpk(g, 0.f) & 0xffffu);
            out[O_CS + ((size_t)(s_ >> 3) * 30 + 22 + (s_ & 7)) * 512 + ch] = g;
        }
    }
}
__device__ __forceinline__ void sample_outproj_task(const bf16* MIX, const bf16* WT2, const float* xs, bf16* H, int task, LAS float* part, int tid) {
    const int rt = task >> 5, ct = task & 31;
    float v0[2], v1[2];
    block_gemm32<1>(MIX, WT2, NP + 32 * rt, 32 * ct, 0, part, v0, v1, tid);
#pragma unroll
    for (int e = 0; e < 2; ++e) { int i, j; tile_ij(tid, e, i, j); const int s_ = 32 * rt + i; H[(size_t)(NP + s_) * DM + 32 * ct + j] = (bf16)(cvtpk(ALPHA * xs[(size_t)s_ * DM + 32 * ct + j] + v0[e], 0.f) & 0xffffu); }
}
__device__ __forceinline__ void sample_query_task(const bf16* X1B, const bf16* WT3, bf16* PQ, int task, LAS float* part, int tid) {
    const int rt = task >> 6, ct = task & 63;
    float v0[2], v1[2];
    block_gemm32<1>(X1B, WT3, NP + 32 * rt, 32 * ct, 0, part, v0, v1, tid);
#pragma unroll
    for (int e = 0; e < 2; ++e) { int i, j; tile_ij(tid, e, i, j); const int s_ = 32 * rt + i; PQ[(size_t)(NP + s_) * PQD + 32 * ct + j] = (bf16)(cvtpk(v0[e], 0.f) & 0xffffu); }
}

#define XB_TMO      128
#define XB_XCNT(j)  (256  + 64 * (j))
#define XB_XSUB(j)  (1280 + 64 * (j))
#define XB_XGEN(j)  (2304 + 64 * (j))
#define XB_TOP      3328
#define XB_TOPGEN   3392
#define XCD_BAR_WORDS 3456
#define XB_SPIN_CAP (1u << 18)
__device__ __forceinline__ unsigned xb_ld(unsigned* p)              { return __hip_atomic_load(p, __ATOMIC_RELAXED, __HIP_MEMORY_SCOPE_AGENT); }
__device__ __forceinline__ unsigned xb_add(unsigned* p, unsigned v) { return __hip_atomic_fetch_add(p, v, __ATOMIC_RELAXED, __HIP_MEMORY_SCOPE_AGENT); }
__device__ __forceinline__ unsigned xb_xcc_id() { return (unsigned)__builtin_amdgcn_s_getreg((3 << 11) | 20) & 0xFu; }
#define XB_SPIN(cond, bar) do { unsigned _sp = 0; while (cond) { __builtin_amdgcn_s_sleep(1); \
    if ((++_sp & 255u) == 0u) { if (xb_ld(&(bar)[XB_TMO])) break; if (_sp > XB_SPIN_CAP) { atomicAdd(&(bar)[XB_TMO], 1u); break; } } } } while (0)
struct XcdBarrier { unsigned* bar; unsigned x; volatile LAS unsigned* st; };
__device__ __forceinline__ XcdBarrier xcd_barrier_post(unsigned* bar, volatile LAS unsigned* st) {
    XcdBarrier b; b.bar = bar; b.x = xb_xcc_id(); b.st = st;
    if (threadIdx.x == 0) (void)xb_add(&bar[XB_XCNT(b.x)], 1u);
    return b;
}
__device__ __forceinline__ void xcd_barrier_complete(unsigned* bar, unsigned x, unsigned& nloc, unsigned& nx) {
    const unsigned G = gridDim.x * gridDim.y * gridDim.z;
    unsigned sum, cnt, mine, sp = 0u;
    for (;;) {
        sum = 0u; cnt = 0u; mine = 0u;
#pragma unroll
        for (unsigned j = 0; j < 16; ++j) { const unsigned c = xb_ld(&bar[XB_XCNT(j)]); sum += c; cnt += (c > 0u) ? 1u : 0u; mine = (j == x) ? c : mine; }
        if (sum == G) break;
        __builtin_amdgcn_s_sleep(1);
        if ((++sp & 255u) == 0u) { if (xb_ld(&bar[XB_TMO])) break; if (sp > XB_SPIN_CAP) { atomicAdd(&bar[XB_TMO], 1u); break; } }
    }
    nloc = mine > 0u ? mine : 1u; nx = cnt > 0u ? cnt : 1u;
}
__device__ __forceinline__ void xcd_barrier(const XcdBarrier& b) {
    asm volatile("s_waitcnt vmcnt(0)" ::: "memory");
    __syncthreads();
    if (threadIdx.x == 0) {
        unsigned* bar = b.bar;
        __builtin_amdgcn_s_waitcnt(0);
        unsigned nloc = b.st[0], nx = b.st[1];
        if (nloc == 0u) { xcd_barrier_complete(bar, b.x, nloc, nx); b.st[0] = nloc; b.st[1] = nx; }
        const unsigned old = xb_add(&bar[XB_XSUB(b.x)], 1u);
        const unsigned gen = old / nloc;
        if (old + 1u == (gen + 1u) * nloc) {
            __builtin_amdgcn_fence(__ATOMIC_RELEASE, "agent");
            asm volatile("s_waitcnt vmcnt(0)" ::: "memory");
            const unsigned og = xb_add(&bar[XB_TOP], 1u);
            const unsigned tg = og / nx;
            if (og + 1u == (tg + 1u) * nx) xb_add(&bar[XB_TOPGEN], 1u);
            else XB_SPIN(xb_ld(&bar[XB_TOPGEN]) == tg, bar);
            __builtin_amdgcn_fence(__ATOMIC_ACQUIRE, "agent");
            xb_add(&bar[XB_XGEN(b.x)], 1u);
            asm volatile("s_waitcnt vmcnt(0)" ::: "memory");
        } else {
            XB_SPIN(xb_ld(&bar[XB_XGEN(b.x)]) == gen, bar);
            __builtin_amdgcn_fence(__ATOMIC_ACQUIRE, "agent");
            asm volatile("s_waitcnt vmcnt(0)" ::: "memory");
        }
    }
    __syncthreads();
}

__global__ void __launch_bounds__(NTHREADS, 2) fwd_megakernel(Params p) {
    extern __shared__ __attribute__((aligned(16))) unsigned char lds_raw[];
    LAS unsigned char* lds = (LAS unsigned char*)lds_raw;
    cg::grid_group grid = cg::this_grid();
    int tid = threadIdx.x, lane = tid & 63; const int wave = __builtin_amdgcn_readfirstlane(tid >> 6);
    const int G = gridDim.x, gw = blockIdx.x * NWAVES + wave, NGW = G * NWAVES;
    const long gt = (long)blockIdx.x * NTHREADS + tid, NGT = (long)G * NTHREADS;
    unsigned char* ws = p.ws;
    float* out = p.out;
    volatile LAS unsigned* bst = (volatile LAS unsigned*)(lds + LDS_BYTES - 64);
    if (tid < 16) bst[tid] = 0u;
    __syncthreads();
    const XcdBarrier xbar = xcd_barrier_post((unsigned*)(ws + WS_CTL), bst);
    bf16* WT1 = (bf16*)(ws + WS_WT1); bf16* WT2 = (bf16*)(ws + WS_WT2); bf16* WT3 = (bf16*)(ws + WS_WT3); bf16* SKB = (bf16*)(ws + WS_SK);
    unsigned char* EU8 = ws + WS_EU; unsigned char* EV8 = ws + WS_EV;
    float* SU = (float*)(ws + WS_EU + 16 * MiB); float* SV = (float*)(ws + WS_EV + 16 * MiB);
    bf16* XB = (bf16*)(ws + WS_XB);
    bf16* CSB = (bf16*)(ws + WS_EU + 20 * MiB);
    bf16* QB = (bf16*)(ws + WS_QKVG); bf16* KB = (bf16*)(ws + WS_QKVG + QSZ); bf16* VB = (bf16*)(ws + WS_QKVG + 2 * QSZ); bf16* GB = (bf16*)(ws + WS_QKVG + 3 * QSZ);
    bf16* MIX = (bf16*)(ws + WS_MIX); bf16* HBB = (bf16*)(ws + WS_H);

    {
        LAS float* scr = (LAS float*)(lds + wave * 16384);
        constexpr int I1 = 16 * (INC / 32), I2 = 16 * (DM / 32), I3 = 16 * (PQD / 32);
        for (int it = gw; it < I1 + I2 + I3; it += NGW) {
            int r = it;
            if (r < I1) { const int kb = r / (INC / 32), nb = r % (INC / 32); p0_transpose_item(p.in[5], INC, DM, w1_src_col(32 * nb), WT1, 32 * nb, 64 * kb, scr, lane); continue; } r -= I1;
            if (r < I2) { const int kb = r / (DM / 32), nb = r % (DM / 32); p0_transpose_item(p.in[6], DM, DM, 32 * nb, WT2, 32 * nb, 64 * kb, scr, lane); continue; } r -= I2;
            { const int kb = r / (PQD / 32), nb = r % (PQD / 32); p0_transpose_item(p.in[13], PQD, DM, 32 * nb, WT3, 32 * nb, 64 * kb, scr, lane); }
        }
        constexpr int I_XP = NP / 4, I_XS = NS / 4, I_SK = 64, I_EU = 8192, I_EV = 8192, I_CS = NSB * 30 * 512 / 4096;
        for (int it = gw; it < I_XP + I_XS + I_SK + I_CS + I_EU + I_EV; it += NGW) {
            int r = it;
            if (r < I_XP) { rows4_to_bf16(p.in[0] + (size_t)r * 4096, XB + (size_t)r * 4096, lane); continue; } r -= I_XP;
            if (r < I_XS) { rows4_to_bf16(p.in[1] + (size_t)r * 4096, XB + (size_t)NP * DM + (size_t)r * 4096, lane); continue; } r -= I_XS;
            if (r < I_SK) { rows4_to_bf16(p.in[14] + (size_t)r * 4096, SKB + (size_t)r * 4096, lane); continue; } r -= I_SK;
            if (r < I_CS) { rows4_to_bf16(p.in[4] + (size_t)r * 4096, CSB + (size_t)r * 4096, lane); continue; } r -= I_CS;
            if (r < I_EU) { rows2_to_fp6(p.in[15] + (size_t)r * 2048, EU8 + (size_t)r * 1536, SU + 2 * r, lane); continue; } r -= I_EU;
            rows2_to_fp6(p.in[16] + (size_t)r * 2048, EV8 + (size_t)r * 1536, SV + 2 * r, lane);
        }
        {
            constexpr long PER_BC = 22L * 128, TOTC = NSB * PER_BC;
            const f32x4* sc = (const f32x4*)p.in[4]; f32x4* oc = (f32x4*)(out + O_CS);
            for (long i = gt; i < TOTC; i += NGT) { const long b = i / PER_BC, rem = i - b * PER_BC; oc[b * 30 * 128 + rem] = sc[b * 30 * 128 + 8 * 128 + rem]; }
        }
    }
    xcd_barrier(xbar); asm volatile("" : "+v"(tid), "+v"(lane));

    {
        pg8::Gemm g{XB, WT1, NP, INC, DM}; pg8::StaticOrder S; S.init(NP, INC, G, (int)blockIdx.x);
        EpiInProj E{QB, GB, out};
        pg8::gemm_phase<EpiInProj, pg8::StaticOrder, true, true>(lds, g, S, E);
        for (int task = blockIdx.x; task < 8 * 64; task += G) sample_inproj_task(XB, WT1, QB, GB, out, task, (LAS float*)lds, tid);
    }
    xcd_barrier(xbar); asm volatile("" : "+v"(tid), "+v"(lane));

    bf16* OP = (bf16*)(ws + WS_H); float* LSE = (float*)(ws + WS_H + (size_t)3 * NTOK * 512 * 2);
    {
        LAS float* wl = (LAS float*)(lds + 65536);
        for (int i = tid; i < (CK + 1) * CC / 4; i += NTHREADS) ((LAS f32x4*)wl)[i] = i < CK * CC / 4 ? ((const f32x4*)p.in[7])[i] : (f32x4){0.f, 0.f, 0.f, 0.f};
        __syncthreads();
        LAS unsigned char* vbuf = lds + wave * 8192;
        const AttnArgs AA{QB, KB, VB, p.in[2], p.in[3], out, OP, LSE};
        constexpr int T_CONV = 4096 + NSB, T_SA = NSB * NH * 13;
        const __amdgpu_buffer_rsrc_t rsw = __builtin_amdgcn_make_buffer_rsrc((void*)ws, 0, 0x40000000, 0x00020000);
        for (int task = gw; task < T_CONV + T_SA; task += NGW) {
            asm volatile("" : "+v"(lane));
            int k = task;
            if (k < T_SA) { attn_mfma_task<true, false>(AA, k, vbuf, lane); continue; }
            k -= T_SA;
            conv_task(rsw, (unsigned)((const unsigned char*)GB - ws), (unsigned)((const unsigned char*)CSB - ws), wl, p.in[8], p.in[9], p.in[10], MIX, k, lane);
        }
        attn_block_phase(AA, lds, G, tid, wave, lane);
    }
    xcd_barrier(xbar); asm volatile("" : "+v"(tid), "+v"(lane));
    for (int r = gw; r < NTOK; r += NGW) attn_merge_row(OP, LSE, MIX, r, lane);
    xcd_barrier(xbar); asm volatile("" : "+v"(tid), "+v"(lane));

    {
        pg8::Gemm g{MIX, WT2, NP, DM, DM}; pg8::StaticOrder S; S.init(NP, DM, G, (int)blockIdx.x);
        EpiResid E{XB, HBB};
        pg8::gemm_phase<EpiResid, pg8::StaticOrder, true, true>(lds, g, S, E);
        for (int task = blockIdx.x; task < 8 * 32; task += G) sample_outproj_task(MIX, WT2, p.in[1], HBB, task, (LAS float*)lds, tid);
    }
    xcd_barrier(xbar); asm volatile("" : "+v"(tid), "+v"(lane));

    bf16* X1B = XB;
    for (int r = 4 * gw; r < NTOK; r += 4 * NGW) ln1_rows4(HBB, X1B, p.in[11], p.in[12], r, lane);
    xcd_barrier(xbar); asm volatile("" : "+v"(tid), "+v"(lane));

    bf16* PQ = (bf16*)(ws + WS_QKVG);
    {
        pg8::Gemm g{X1B, WT3, NP, PQD, DM}; pg8::StaticOrder S; S.init(NP, PQD, G, (int)blockIdx.x);
        EpiPlainBf16 E{PQ, PQD};
        pg8::gemm_phase<EpiPlainBf16, pg8::StaticOrder, true, true>(lds, g, S, E);
        for (int task = blockIdx.x; task < 8 * 64; task += G) sample_query_task(X1B, WT3, PQ, task, (LAS float*)lds, tid);
    }
    xcd_barrier(xbar); asm volatile("" : "+v"(tid), "+v"(lane));

    int* IDX = (int*)(ws + WS_MIX); float* GATE = (float*)(ws + WS_MIX + (size_t)NTOK * 128 * 4);
    {
        constexpr int NTILE = NTOK / 32;
        const CacheCopy CC{(const f32x4*)p.in[2], (const f32x4*)p.in[3], (f32x4*)(out + O_KS), (f32x4*)(out + O_VS)};
        const int ntb = ((int)blockIdx.x < NTILE) ? (NTILE - 1 - (int)blockIdx.x) / G + 1 : 0;
        for (int hp = 0; hp < 4; ++hp) {
            __syncthreads();
            const v4u* src = (const v4u*)(SKB + (size_t)hp * 2 * 2 * 128 * 128);
#pragma unroll 4
            for (int i = 0; i < 16; ++i) { const int gch = tid + NTHREADS * i, row = gch >> 4, ch = gch & 15; *(LAS v4u*)(lds + row * 256 + ((ch ^ (row & 15)) << 4)) = src[gch]; }
            __syncthreads();
            if (G == 256) {
                topk_mfma_task(PQ, lds + (wave & 1) * 65536, IDX, GATE, (int)blockIdx.x * 4 + (wave >> 1), 2 * hp + (wave & 1), lane, CC);
                const int x = (int)blockIdx.x - 8;
                if (x >= 0 && x < 64 && ((x >> 4) == hp) && wave == 0) topk_mfma_task(PQ, lds + ((x >> 3) & 1) * 65536, IDX, GATE, 1024 + (x & 7), x >> 3, lane, CC);
            } else {
                for (int k0 = 0; k0 < ntb; k0 += 4) {
                    const int k = k0 + (wave >> 1);
                    if (k < ntb) topk_mfma_task(PQ, lds + (wave & 1) * 65536, IDX, GATE, (int)blockIdx.x + G * k, 2 * hp + (wave & 1), lane, CC);
                }
            }
        }
    }
    xcd_barrier(xbar); asm volatile("" : "+v"(tid), "+v"(lane));

#ifdef PEER_TOKEN_MAJOR
    peer_phase(X1B, HB, IDX, GATE, EU8, EV8, SU, SV, p.in[17], p.in[18], out + O_Y, gw, NGW, lane);
#else
    peer_phase6(X1B, IDX, GATE, EU8, EV8, SU, SV, p.in[17], p.in[18], out + O_Y, gw, NGW, lane, lds + wave * 12288, lds, wave, G);
    grid.sync();
#endif
}

extern "C" void kernel_launch(void* const* d_in, const int* in_sizes, int n_in, void* d_out, int out_size, void* d_ws, size_t ws_size, hipStream_t stream) {
    static int grid_blocks = 0;
    if (grid_blocks == 0) {
        if (n_in != 19 || (size_t)out_size != O_END || ws_size < WS_END) { fprintf(stderr, "kernel_launch: unexpected shapes n_in %d out %d ws %zu\n", n_in, out_size, ws_size); grid_blocks = -1; return; }
        int dev = 0, cus = 0, per_cu = 0;
        (void)hipGetDevice(&dev);
        (void)hipDeviceGetAttribute(&cus, hipDeviceAttributeMultiprocessorCount, dev);
        (void)hipFuncSetAttribute((const void*)fwd_megakernel, hipFuncAttributeMaxDynamicSharedMemorySize, LDS_BYTES);
        (void)hipOccupancyMaxActiveBlocksPerMultiprocessor(&per_cu, (const void*)fwd_megakernel, NTHREADS, LDS_BYTES);
        if (per_cu < 1) { fprintf(stderr, "kernel_launch: occupancy query says %d blocks per CU\n", per_cu); per_cu = 1; }
        if (per_cu > 1) per_cu = 1;
        grid_blocks = cus * per_cu;
        (void)hipGetLastError();
    }
    if (grid_blocks < 0) return;
    (void)hipMemsetAsync((char*)d_ws + WS_CTL, 0, 16384, stream);
    Params p{};
    for (int i = 0; i < 19; ++i) p.in[i] = (const float*)d_in[i];
    p.out = (float*)d_out; p.ws = (unsigned char*)d_ws;
    void* args[] = {&p};
    hipError_t e = hipLaunchCooperativeKernel((const void*)fwd_megakernel, dim3(grid_blocks), dim3(NTHREADS), args, LDS_BYTES, stream);
    if (e != hipSuccess) fprintf(stderr, "cooperative launch failed: %s (grid %d)\n", hipGetErrorString(e), grid_blocks);
}
```

```cpp
#include <hip/hip_runtime.h>
#include <hip/hip_cooperative_groups.h>
#include <cstdio>
#include <cstdint>
namespace cg = cooperative_groups;

namespace pg8 {
#define PG8_LAS __attribute__((address_space(3)))
typedef unsigned short bf16_t;
typedef short bf16x8 __attribute__((ext_vector_type(8)));
typedef float f32x4 __attribute__((ext_vector_type(4)));
typedef unsigned u32x4 __attribute__((ext_vector_type(4)));
typedef unsigned u32x2 __attribute__((ext_vector_type(2)));
constexpr int BM = 256, BK = 64, HALF = 128, HTB = HALF * BK * 2, STAGE_BYTES = 8 * HTB, NXCD = 8, WGM = 4;

__host__ __device__ __forceinline__ int lds_byte(int r, int c) { const int st = (r >> 4) * 2 + (c >> 5), rr = r & 15, cc = c & 31, ob = rr * 64 + cc * 2; return st * 1024 + (ob ^ (((ob >> 9) & 1) << 5)); }
__host__ __device__ __forceinline__ void stage_rc(int b, int& R, int& C) { const int st = b / 1024, sb = b % 1024, swz = sb ^ (((sb >> 9) & 1) << 5); R = (st >> 1) * 16 + swz / 64; C = (st & 1) * 32 + (swz % 64) / 2; }
__host__ __device__ __forceinline__ int perm32(int rho) { const int n = rho >> 4, i = rho & 15; return 8 * (i >> 2) + 4 * n + (i & 3); }

struct Unit { int pm, pn; };
struct Gemm { const bf16_t* A; const bf16_t* Bt; int M, N, K; };

struct StaticOrder {
    int nM, nN, nwg, G, c;
    __host__ __device__ void init(int M, int N, int G_, int c_) { nM = M / BM; nN = N / BM; nwg = nM * nN; G = G_; c = c_; }
    __host__ __device__ bool next(int i, Unit& u) const {
        const long L = (long)i * G + c; if (L >= nwg) return false;
        int wgid = (int)L; { const int q = nwg / NXCD, r = nwg % NXCD, xcd = wgid % NXCD, off = wgid / NXCD; wgid = (xcd < r ? xcd * (q + 1) : r * (q + 1) + (xcd - r) * q) + off; }
        const int nig = WGM * nN, gid = wgid / nig, fm = gid * WGM, gsz = (nM - fm) < WGM ? (nM - fm) : WGM;
        u.pm = fm + ((wgid % nig) % gsz); u.pn = (wgid % nig) / gsz; return true;
    }
    __device__ __forceinline__ void a_ready(const Unit&) const {}
    __device__ __forceinline__ void done(const Unit&) const {}
};

template <class Epi, class Sched, bool ALIGN_EPI = false, bool SP2 = false>
__device__ __forceinline__ void gemm_phase(PG8_LAS unsigned char* lds, const Gemm g, const Sched& S, const Epi& E) {
    int tid = threadIdx.x; asm volatile("" : "+v"(tid));
    const int wid = __builtin_amdgcn_readfirstlane(tid >> 6), lane = tid & 63, wr = wid >> 2, wc = wid & 3, fr = lane & 15, fq = lane >> 4;
    const int K = g.K, nt = K / BK;
    unsigned voffA[2], voffB[2];
#pragma unroll
    for (int i = 0; i < 2; ++i) { int R, C; stage_rc(tid * 16 + i * 8192, R, C); const int Rb = Epi::PERM ? ((R & ~31) + perm32(R & 31)) : R;
        voffA[i] = (unsigned)(R * K + C) * 2u; voffB[i] = (unsigned)(Rb * K + C) * 2u; }
    const size_t kstep = (size_t)(BK * 2);
    const size_t hstep = (size_t)HALF * K * 2;
    const size_t tstep = 2 * hstep;
    const unsigned ldsw = (unsigned)wid * 1024u;
    const int aoff = lds_byte(wr * 64 + fr, fq * 8), boff = lds_byte(wc * 32 + fr, fq * 8);
#define PG8_SA(b, h) (((b) * 2 + (h)) * HTB)
#define PG8_SB(b, h) ((4 + (b) * 2 + (h)) * HTB)
#define PG8_STAGE(bufoff, gbase, voff) do { _Pragma("unroll") for (int _i = 0; _i < 2; ++_i) \
        __builtin_amdgcn_global_load_lds((const unsigned*)((const char*)(gbase) + (voff)[_i]), (PG8_LAS unsigned*)(lds + (bufoff) + ldsw + _i * 8192), 16, 0, 0); } while (0)
#define PG8_LDA(dst, b, h) do { _Pragma("unroll") for (int m = 0; m < 4; ++m) _Pragma("unroll") for (int k = 0; k < 2; ++k) dst[m][k] = *(const PG8_LAS bf16x8*)(lds + PG8_SA(b, h) + aoff + m * 2048 + k * 1024); } while (0)
#define PG8_LDB(dst, b, h) do { _Pragma("unroll") for (int n = 0; n < 2; ++n) _Pragma("unroll") for (int k = 0; k < 2; ++k) dst[n][k] = *(const PG8_LAS bf16x8*)(lds + PG8_SB(b, h) + boff + n * 2048 + k * 1024); } while (0)
#define PG8_MMA(ai, bj, At, Bt) do { __builtin_amdgcn_s_setprio(1); _Pragma("unroll") for (int m = 0; m < 4; ++m) _Pragma("unroll") for (int n = 0; n < 2; ++n) _Pragma("unroll") for (int k = 0; k < 2; ++k) \
        acc[ai][bj][m][n] = __builtin_amdgcn_mfma_f32_16x16x32_bf16(Bt[n][k], At[m][k], acc[ai][bj][m][n], 0, 0, 0); __builtin_amdgcn_s_setprio(0); } while (0)
#define PG8_WAIT_V(n) asm volatile("s_waitcnt vmcnt(" #n ")" ::: "memory")
#define PG8_WAIT_L(n) asm volatile("s_waitcnt lgkmcnt(" #n ")" ::: "memory")
#define PG8_BAR __builtin_amdgcn_s_barrier()
#define PG8_SCHED __builtin_amdgcn_sched_barrier(0)
    Unit cur, nxt; int ui = 0;
    if (!S.next(0, cur)) return;
    f32x4 acc[2][2][4][2];
#pragma unroll
    for (int a = 0; a < 2; ++a)
#pragma unroll
        for (int b = 0; b < 2; ++b)
#pragma unroll
            for (int m = 0; m < 4; ++m)
#pragma unroll
                for (int n = 0; n < 2; ++n) acc[a][b][m][n] = (f32x4){0.f, 0.f, 0.f, 0.f};
    bf16x8 At[4][2], B0[2][2], B1[2][2];
    const char* cA = (const char*)g.A + (size_t)cur.pm * tstep; const char* cB = (const char*)g.Bt + (size_t)cur.pn * tstep;
    S.a_ready(cur);
    if constexpr (SP2) {
        PG8_STAGE(PG8_SB(0, 0), cB, voffB); PG8_STAGE(PG8_SB(0, 1), cB + hstep, voffB); PG8_STAGE(PG8_SA(0, 0), cA, voffA); PG8_STAGE(PG8_SA(0, 1), cA + hstep, voffA);
        if (wr == 1) PG8_BAR;
        PG8_WAIT_V(2); PG8_BAR;
        PG8_STAGE(PG8_SB(1, 0), cB + kstep, voffB); PG8_STAGE(PG8_SA(1, 0), cA + kstep, voffA); PG8_STAGE(PG8_SB(1, 1), cB + hstep + kstep, voffB);
        PG8_WAIT_V(6); PG8_BAR;
    } else {
        PG8_STAGE(PG8_SB(0, 0), cB, voffB); PG8_STAGE(PG8_SA(0, 0), cA, voffA); PG8_STAGE(PG8_SB(0, 1), cB + hstep, voffB); PG8_STAGE(PG8_SA(0, 1), cA + hstep, voffA);
        if (wr == 1) PG8_BAR;
        PG8_WAIT_V(4); PG8_BAR;
        PG8_STAGE(PG8_SB(1, 0), cB + kstep, voffB); PG8_STAGE(PG8_SA(1, 0), cA + kstep, voffA); PG8_STAGE(PG8_SB(1, 1), cB + hstep + kstep, voffB);
        PG8_WAIT_V(6); PG8_BAR;
    }
    for (;;) {
        const bool has_next = S.next(ui + 1, nxt);
        const char* nA = has_next ? (const char*)g.A + (size_t)nxt.pm * tstep : cA; const char* nB = has_next ? (const char*)g.Bt + (size_t)nxt.pn * tstep : cB;
        for (int t = 0; t < nt; t += 2) {
            const bool last = (t == nt - 2);
            const char* a1 = cA + (size_t)(t + 1) * kstep;
            const char* a2 = last ? nA : cA + (size_t)(t + 2) * kstep; const char* b2 = last ? nB : cB + (size_t)(t + 2) * kstep;
            const char* a3 = a2 + kstep; const char* b3 = b2 + kstep;
            if (last && has_next) S.a_ready(nxt);
            if constexpr (SP2) {
            PG8_LDB(B0, 0, 0); PG8_LDB(B1, 0, 1); PG8_SCHED; PG8_LDA(At, 0, 0); PG8_STAGE(PG8_SA(1, 1), a1 + hstep, voffA);
            PG8_WAIT_V(8); PG8_WAIT_L(0); PG8_BAR; PG8_MMA(0, 0, At, B0); PG8_MMA(0, 1, At, B1); PG8_BAR; PG8_SCHED;
            PG8_LDA(At, 0, 1); PG8_STAGE(PG8_SB(0, 0), b2, voffB); PG8_STAGE(PG8_SB(0, 1), b2 + hstep, voffB); PG8_STAGE(PG8_SA(0, 0), a2, voffA);
            PG8_WAIT_V(8); PG8_WAIT_L(0); PG8_BAR; PG8_MMA(1, 0, At, B0); PG8_MMA(1, 1, At, B1); PG8_BAR; PG8_SCHED;
            PG8_LDB(B0, 1, 0); PG8_LDB(B1, 1, 1); PG8_SCHED; PG8_LDA(At, 1, 0); PG8_STAGE(PG8_SA(0, 1), a2 + hstep, voffA);
            PG8_WAIT_V(8); PG8_WAIT_L(0); PG8_BAR; PG8_MMA(0, 0, At, B0); PG8_MMA(0, 1, At, B1); PG8_BAR; PG8_SCHED;
            PG8_LDA(At, 1, 1); PG8_STAGE(PG8_SB(1, 0), b3, voffB); PG8_STAGE(PG8_SB(1, 1), b3 + hstep, voffB); PG8_STAGE(PG8_SA(1, 0), a3, voffA);
            PG8_WAIT_V(8); PG8_WAIT_L(0); PG8_BAR; PG8_MMA(1, 0, At, B0); PG8_MMA(1, 1, At, B1); PG8_BAR; PG8_SCHED;
            } else {
            PG8_LDB(B0, 0, 0); PG8_SCHED; PG8_LDA(At, 0, 0); PG8_STAGE(PG8_SA(1, 1), a1 + hstep, voffA);
            PG8_WAIT_L(8); PG8_BAR; PG8_WAIT_L(0); PG8_MMA(0, 0, At, B0); PG8_BAR; PG8_SCHED;
            PG8_LDB(B1, 0, 1); PG8_STAGE(PG8_SB(0, 0), b2, voffB);
            PG8_BAR; PG8_WAIT_L(0); PG8_MMA(0, 1, At, B1); PG8_BAR;
            PG8_LDA(At, 0, 1); PG8_STAGE(PG8_SA(0, 0), a2, voffA);
            PG8_BAR; PG8_WAIT_L(0); PG8_MMA(1, 0, At, B0); PG8_BAR; PG8_SCHED;
            PG8_STAGE(PG8_SB(0, 1), b2 + hstep, voffB);
            PG8_WAIT_V(6); PG8_BAR; PG8_MMA(1, 1, At, B1); PG8_BAR;
            PG8_LDB(B0, 1, 0); PG8_SCHED; PG8_LDA(At, 1, 0); PG8_STAGE(PG8_SA(0, 1), a2 + hstep, voffA);
            PG8_WAIT_L(8); PG8_BAR; PG8_WAIT_L(0); PG8_MMA(0, 0, At, B0); PG8_BAR; PG8_SCHED;
            PG8_LDB(B1, 1, 1); PG8_STAGE(PG8_SB(1, 0), b3, voffB);
            PG8_BAR; PG8_WAIT_L(0); PG8_MMA(0, 1, At, B1); PG8_BAR;
            PG8_LDA(At, 1, 1); PG8_STAGE(PG8_SA(1, 0), a3, voffA);
            PG8_BAR; PG8_WAIT_L(0); PG8_MMA(1, 0, At, B0); PG8_BAR; PG8_SCHED;
            PG8_STAGE(PG8_SB(1, 1), b3 + hstep, voffB);
            PG8_WAIT_V(6); PG8_BAR; PG8_MMA(1, 1, At, B1); PG8_BAR;
            }
        }
        if constexpr (ALIGN_EPI) { if (wr == 0) PG8_BAR; }
        if constexpr (!Epi::AFTER_DRAIN) { E(acc, cur, wr, wc, fr, fq); S.done(cur); }
        if (!has_next) break;
#pragma unroll
        for (int a = 0; a < 2; ++a)
#pragma unroll
            for (int b = 0; b < 2; ++b)
#pragma unroll
                for (int m = 0; m < 4; ++m)
#pragma unroll
                    for (int n = 0; n < 2; ++n) acc[a][b][m][n] = (f32x4){0.f, 0.f, 0.f, 0.f};
        cur = nxt; cA = nA; cB = nB; ++ui;
        if constexpr (ALIGN_EPI) { if (wr == 1) PG8_BAR; }
    }
    PG8_WAIT_V(0);
    if constexpr (!ALIGN_EPI) { if (wr == 0) PG8_BAR; }
    PG8_BAR;
    if constexpr (Epi::AFTER_DRAIN) { E.fused(acc, cur, wr, wc, fr, fq, lds, wid, lane); S.done(cur); }
#undef PG8_SA
#undef PG8_SB
#undef PG8_STAGE
#undef PG8_LDA
#undef PG8_LDB
#undef PG8_MMA
#undef PG8_WAIT_V
#undef PG8_WAIT_L
#undef PG8_BAR
#undef PG8_SCHED
}
}

#define GAS __attribute__((address_space(1)))
#define LAS __attribute__((address_space(3)))
typedef unsigned short bf16;
typedef unsigned v4u __attribute__((ext_vector_type(4)));
typedef unsigned v2u __attribute__((ext_vector_type(2)));
typedef float f32x4 __attribute__((ext_vector_type(4)));
typedef float f32x2_t __attribute__((ext_vector_type(2)));
typedef __bf16 bf16x2_t __attribute__((ext_vector_type(2)));

constexpr int DM = 1024, NPB = 8, SEQ = 4096, NSB = 32, DSEQ = 8, LB = 2048;
constexpr int NP = NPB * SEQ, NS = NSB * DSEQ, NTOK = NP + NS;
constexpr int AW = 512, CC = 512, NH = 8, HD = 64, INC = 2560, CK = 31;
constexpr int NKEYS = 128, PH = 8, PQD = 2048;
constexpr float ALPHA = 1.18920711500272f, LN_EPS = 1e-5f;
constexpr size_t O_Y = 0, O_KP = (size_t)NTOK * DM, O_VP = O_KP + (size_t)NPB * 2048 * 512, O_CP = O_VP + (size_t)NPB * 2048 * 512,
                 O_KS = O_CP + (size_t)NPB * 30 * 512, O_VS = O_KS + (size_t)NSB * 2048 * 512, O_CS = O_VS + (size_t)NSB * 2048 * 512, O_END = O_CS + (size_t)NSB * 30 * 512;
static_assert(O_END == 118317056ull, "output map");
constexpr size_t MiB = 1u << 20;
constexpr size_t WS_CTL = 0, WS_WT1 = 1 * MiB, WS_WT2 = 6 * MiB, WS_WT3 = 8 * MiB, WS_SK = 12 * MiB, WS_EU = 13 * MiB, WS_EV = 45 * MiB,
                 WS_XB = 77 * MiB, WS_QKVG = 142 * MiB, WS_MIX = 271 * MiB, WS_H = 336 * MiB, WS_END = 465 * MiB;
constexpr size_t QSZ = (size_t)NTOK * 512 * 2;
static_assert(WS_XB + (size_t)NTOK * DM * 2 <= WS_QKVG && WS_QKVG + 4 * QSZ <= WS_MIX && WS_QKVG + (size_t)NTOK * PQD * 2 <= WS_MIX && WS_MIX + (size_t)NTOK * DM * 2 <= WS_H && WS_H + (size_t)NTOK * DM * 4 <= WS_END, "ws map");
static_assert(WS_MIX + (size_t)NTOK * 128 * 8 <= WS_H, "idx+gate overlay");

constexpr int NWAVES = 8, NTHREADS = 512;
constexpr int LDS_BYTES = 147456;

struct Params { const float* in[19]; float* out; unsigned char* ws; };

__device__ __forceinline__ unsigned cvtpk(float lo, float hi) { f32x2_t v = {lo, hi}; bf16x2_t b = __builtin_convertvector(v, bf16x2_t); return __builtin_bit_cast(unsigned, b); }
__device__ __forceinline__ float bflo(unsigned u) { return __uint_as_float(u << 16); }
__device__ __forceinline__ float bfhi(unsigned u) { return __uint_as_float(u & 0xffff0000u); }
__device__ __forceinline__ float dot2(unsigned a, unsigned b, float c) { return __builtin_amdgcn_fdot2_f32_bf16(__builtin_bit_cast(bf16x2_t, a), __builtin_bit_cast(bf16x2_t, b), c, false); }
__device__ __forceinline__ float wave_sum(float v) {
#pragma unroll
    for (int o = 1; o < 64; o <<= 1) v += __shfl_xor(v, o);
    return v;
}
__device__ __forceinline__ float wave_max(float v) {
#pragma unroll
    for (int o = 1; o < 64; o <<= 1) v = fmaxf(v, __shfl_xor(v, o));
    return v;
}
__device__ __forceinline__ unsigned wave_maxu(unsigned v) {
#pragma unroll
    for (int o = 1; o < 64; o <<= 1) { const unsigned w = (unsigned)__shfl_xor((int)v, o); v = v > w ? v : w; }
    return v;
}
#define LDS_WAIT() asm volatile("s_waitcnt lgkmcnt(0)" ::: "memory")

__device__ __forceinline__ void p0_transpose_item(const float* W, int N, int K, int srcn0, bf16* WT, int dstn0, int k0, LAS float* scr, int lane) {
#pragma unroll 8
    for (int i = 0; i < 32; ++i) { const int kk = 2 * i + (lane >> 5); scr[kk * 33 + (lane & 31)] = W[(size_t)(k0 + kk) * N + srcn0 + (lane & 31)]; }
    LDS_WAIT(); asm volatile("" ::: "memory");
    const int c = lane & 7;
#pragma unroll
    for (int j = 0; j < 4; ++j) { const int n = (lane >> 3) + 8 * j; const LAS float* s = scr + (8 * c) * 33 + n;
        v4u o; o.x = cvtpk(s[0 * 33], s[1 * 33]); o.y = cvtpk(s[2 * 33], s[3 * 33]); o.z = cvtpk(s[4 * 33], s[5 * 33]); o.w = cvtpk(s[6 * 33], s[7 * 33]);
        *(v4u*)(WT + (size_t)(dstn0 + n) * K + k0 + 8 * c) = o; }
    LDS_WAIT(); asm volatile("" ::: "memory");
}
__device__ __forceinline__ int w1_src_col(int n0) {
    if (n0 < 1536) return n0;
    const int t = n0 - 1536, j = t >> 8, c = t & 255;
    return c < 128 ? 1536 + 128 * j + c : 2048 + 128 * j + (c - 128);
}
__device__ __forceinline__ void rows4_to_bf16(const float* src, bf16* dst, int lane) {
    const f32x4* s = (const f32x4*)src + lane; v2u* d = (v2u*)dst + lane;
    f32x4 v[16];
#pragma unroll
    for (int j = 0; j < 16; ++j) v[j] = s[64 * j];
#pragma unroll
    for (int j = 0; j < 16; ++j) { v2u o; o.x = cvtpk(v[j].x, v[j].y); o.y = cvtpk(v[j].z, v[j].w); d[64 * j] = o; }
}

typedef int v6i_t __attribute__((ext_vector_type(6)));
typedef float v32f_t __attribute__((ext_vector_type(32)));
typedef float v16f_t __attribute__((ext_vector_type(16)));
typedef unsigned v3u __attribute__((ext_vector_type(3)));
__device__ __forceinline__ void rows2_to_fp6(const float* src, unsigned char* dst, float* scale_out, int lane) {
    const int lp = lane & 31, hf = lane >> 5;
    const f32x4* s = (const f32x4*)(src + (size_t)hf * DM + 32 * lp);
    f32x4 v[8]; float m = 0.f;
#pragma unroll
    for (int j = 0; j < 8; ++j) { v[j] = s[j]; m = fmaxf(m, fmaxf(fmaxf(fabsf(v[j].x), fabsf(v[j].y)), fmaxf(fabsf(v[j].z), fabsf(v[j].w)))); }
#pragma unroll
    for (int o = 1; o < 32; o <<= 1) m = fmaxf(m, __shfl_xor(m, o));
    const float sc = m > 0.f ? m * (1.f / 7.5f) : 1.f, inv = 1.f / sc;
    unsigned long long acc64 = 0ull; int nb = 0; unsigned pkw[6]; int wi = 0;
#pragma unroll
    for (int j = 0; j < 8; ++j) {
        const float f4[4] = {v[j].x * inv, v[j].y * inv, v[j].z * inv, v[j].w * inv};
#pragma unroll
        for (int c = 0; c < 4; ++c) {
            const float a_ = fminf(fabsf(f4[c]), 7.5f);
            const float cf = a_ < 1.f ? a_ * 8.f : (a_ < 2.f ? 8.f + (a_ - 1.f) * 8.f : (a_ < 4.f ? 16.f + (a_ - 2.f) * 4.f : 24.f + (a_ - 4.f) * 2.f));
            unsigned code = (unsigned)__builtin_rintf(cf); if (code > 31u) code = 31u;
            if (f4[c] < 0.f) code |= 32u;
            acc64 |= (unsigned long long)code << nb; nb += 6;
            if (nb >= 32) { pkw[wi++] = (unsigned)acc64; acc64 >>= 32; nb -= 32; }
        }
    }
    v6i_t pk; pk[0] = (int)pkw[0]; pk[1] = (int)pkw[1]; pk[2] = (int)pkw[2]; pk[3] = (int)pkw[3]; pk[4] = (int)pkw[4]; pk[5] = (int)pkw[5];
    v2u* d = (v2u*)(dst + (size_t)hf * 768 + 24 * lp);
    v2u w; w.x = (unsigned)pk[0]; w.y = (unsigned)pk[1]; d[0] = w; w.x = (unsigned)pk[2]; w.y = (unsigned)pk[3]; d[1] = w; w.x = (unsigned)pk[4]; w.y = (unsigned)pk[5]; d[2] = w;
    if (lp == 0) scale_out[hf] = sc;
}

struct EpiInProj {
    static constexpr bool PERM = true, AFTER_DRAIN = false;
    bf16 *qb, *gb; float* out;
    __device__ __forceinline__ void operator()(const f32x4 (&acc)[2][2][4][2], const pg8::Unit& u, int wr, int wc, int fr, int fq) const {
        const int pn = u.pn;
#pragma unroll
        for (int ai = 0; ai < 2; ++ai)
#pragma unroll
            for (int m = 0; m < 4; ++m) {
                const int row = u.pm * 256 + ai * 128 + wr * 64 + m * 16 + fr;
                long kvrow = -1, cvrow = -1;
                bool samp = row >= NP;
                if (!samp) { const int b = row >> 12, t = row & 4095; if (t >= 2048) kvrow = (long)b * 2048 + (t - 2048); if (t >= SEQ - 30) cvrow = (long)b * 30 + (t - (SEQ - 30)); }
                else { const int s = row - NP, b = s >> 3, tt = s & 7; kvrow = (long)b * 2048 + 2040 + tt; cvrow = (long)b * 30 + 22 + tt; }
                if (pn < 6) {
                    const int which = pn >> 1;
                    bf16* dst = qb + (size_t)which * ((size_t)NTOK * 512) + (size_t)row * 512;
                    const size_t fbase = samp ? O_KS : O_KP, fstride = samp ? (O_VS - O_KS) : (O_VP - O_KP);
                    const bool dof = (which != 0) && (kvrow >= 0);
                    float* fo = out + fbase + (size_t)(which == 2 ? 1 : 0) * fstride + (size_t)(kvrow < 0 ? 0 : kvrow) * 512;
#pragma unroll
                    for (int bj = 0; bj < 2; ++bj) {
                        const int col = (pn & 1) * 256 + bj * 128 + wc * 32 + fq * 8;
                        const f32x4 v0 = acc[ai][bj][m][0], v1 = acc[ai][bj][m][1];
                        v4u o; o.x = cvtpk(v0.x, v0.y); o.y = cvtpk(v0.z, v0.w); o.z = cvtpk(v1.x, v1.y); o.w = cvtpk(v1.z, v1.w);
                        *(v4u*)(dst + col) = o;
                        if (dof) { *(f32x4*)(fo + col) = v0; *(f32x4*)(fo + col + 4) = v1; }
                    }
                } else {
                    const int j = pn - 6;
                    const bool dof = cvrow >= 0;
                    float* fo = out + (samp ? O_CS : O_CP) + (size_t)(cvrow < 0 ? 0 : cvrow) * 512;
                    const int ch = j * 128 + wc * 32 + fq * 8;
                    f32x4 r[2];
#pragma unroll
                    for (int n = 0; n < 2; ++n) {
                        const f32x4 a = acc[ai][0][m][n], g = acc[ai][1][m][n];
                        r[n].x = a.x / (1.f + __expf(-g.x)); r[n].y = a.y / (1.f + __expf(-g.y)); r[n].z = a.z / (1.f + __expf(-g.z)); r[n].w = a.w / (1.f + __expf(-g.w));
                    }
                    v4u o; o.x = cvtpk(r[0].x, r[0].y); o.y = cvtpk(r[0].z, r[0].w); o.z = cvtpk(r[1].x, r[1].y); o.w = cvtpk(r[1].z, r[1].w);
                    *(v4u*)(gb + (size_t)row * 512 + ch) = o;
                    if (dof) { *(f32x4*)(fo + ch) = r[0]; *(f32x4*)(fo + ch + 4) = r[1]; }
                }
            }
    }
};
struct EpiResid {
    static constexpr bool PERM = true, AFTER_DRAIN = false;
    const bf16* XBp; bf16* H;
    __device__ __forceinline__ void operator()(const f32x4 (&acc)[2][2][4][2], const pg8::Unit& u, int wr, int wc, int fr, int fq) const {
#pragma unroll
        for (int ai = 0; ai < 2; ++ai)
#pragma unroll
            for (int m = 0; m < 4; ++m) {
                const int row = u.pm * 256 + ai * 128 + wr * 64 + m * 16 + fr;
#pragma unroll
                for (int bj = 0; bj < 2; ++bj) {
                    const int col = u.pn * 256 + bj * 128 + wc * 32 + fq * 8;
                    const v4u xv = *(const v4u*)(XBp + (size_t)row * DM + col);
                    const f32x4 a0 = acc[ai][bj][m][0], a1 = acc[ai][bj][m][1];
                    v4u o;
                    o.x = cvtpk(ALPHA * bflo(xv.x) + a0.x, ALPHA * bfhi(xv.x) + a0.y); o.y = cvtpk(ALPHA * bflo(xv.y) + a0.z, ALPHA * bfhi(xv.y) + a0.w);
                    o.z = cvtpk(ALPHA * bflo(xv.z) + a1.x, ALPHA * bfhi(xv.z) + a1.y); o.w = cvtpk(ALPHA * bflo(xv.w) + a1.z, ALPHA * bfhi(xv.w) + a1.w);
                    *(v4u*)(H + (size_t)row * DM + col) = o;
                }
            }
    }
};
struct EpiPlainBf16 {
    static constexpr bool PERM = true, AFTER_DRAIN = false;
    bf16* O; int ldc;
    __device__ __forceinline__ void operator()(const f32x4 (&acc)[2][2][4][2], const pg8::Unit& u, int wr, int wc, int fr, int fq) const {
#pragma unroll
        for (int ai = 0; ai < 2; ++ai)
#pragma unroll
            for (int m = 0; m < 4; ++m) {
                const int row = u.pm * 256 + ai * 128 + wr * 64 + m * 16 + fr;
#pragma unroll
                for (int bj = 0; bj < 2; ++bj) {
                    const int col = u.pn * 256 + bj * 128 + wc * 32 + fq * 8;
                    const f32x4 v0 = acc[ai][bj][m][0], v1 = acc[ai][bj][m][1];
                    v4u o; o.x = cvtpk(v0.x, v0.y); o.y = cvtpk(v0.z, v0.w); o.z = cvtpk(v1.x, v1.y); o.w = cvtpk(v1.z, v1.w);
                    *(v4u*)(O + (size_t)row * ldc + col) = o;
                }
            }
    }
};


__device__ __forceinline__ void conv_task(const __amdgpu_buffer_rsrc_t rs, unsigned gb_off, unsigned csb_off, const LAS float* wl, const float* cb, const float* lg, const float* lb, bf16* MIX, int task, int lane) {
    const bool samp = task >= 4096;
    const int b = samp ? task - 4096 : task >> 9, t0 = samp ? 0 : (task & 511) * 8;
    const size_t rowbase = samp ? (size_t)NP + (size_t)b * 8 : (size_t)b * 4096;
    f32x2_t acc2[8][4];
    f32x4 wA[8], wB[8];
#pragma unroll
    for (int tt = 0; tt < 8; ++tt) {
        wA[tt] = (f32x4){0.f, 0.f, 0.f, 0.f}; wB[tt] = (f32x4){0.f, 0.f, 0.f, 0.f};
#pragma unroll
        for (int c = 0; c < 4; ++c) acc2[tt][c] = (f32x2_t){0.f, 0.f};
    }
    v4u cur[16];
    const unsigned baseB = gb_off + (unsigned)((int)rowbase + t0 - 30) * 1024u;
    const unsigned baseA = samp ? csb_off + (unsigned)(b * 30) * 1024u : baseB;
    const int rmin = samp ? 0 : (30 - t0 > 0 ? 30 - t0 : 0);
#define CONV_LOADROW(RR, DST) do { const int rr_ = (RR); \
            const unsigned bs_ = rr_ < 30 ? baseA : baseB; const bool ok_ = (rr_ >= rmin) & (rr_ < 38); \
            const unsigned ro_ = ok_ ? bs_ + (unsigned)rr_ * 1024u : 0x80000000u; \
            DST = __builtin_amdgcn_raw_buffer_load_b128(rs, (int)(ro_ + lane16), 0, 0); } while (0)
    const unsigned lane16 = 16u * (unsigned)lane;
#pragma unroll
    for (int i = 0; i < 16; ++i) CONV_LOADROW(i, cur[i]);
    { const LAS f32x4* wp = (const LAS f32x4*)(wl + 8 * lane); wA[0] = wp[0]; wB[0] = wp[1]; }
#define CONV_FMA(I, TT) do { const int sl_ = ((I) - (TT)) & 7; \
                acc2[TT][0] = __builtin_elementwise_fma((f32x2_t){wA[sl_].x, wA[sl_].y}, x01, acc2[TT][0]); \
                acc2[TT][1] = __builtin_elementwise_fma((f32x2_t){wA[sl_].z, wA[sl_].w}, x23, acc2[TT][1]); \
                acc2[TT][2] = __builtin_elementwise_fma((f32x2_t){wB[sl_].x, wB[sl_].y}, x45, acc2[TT][2]); \
                acc2[TT][3] = __builtin_elementwise_fma((f32x2_t){wB[sl_].z, wB[sl_].w}, x67, acc2[TT][3]); } while (0)
#define CONV_ROW(I, RR, REFILL) do { const int rr = (RR); \
            const v4u u = cur[I]; \
            const f32x2_t x01 = {bflo(u.x), bfhi(u.x)}, x23 = {bflo(u.y), bfhi(u.y)}, x45 = {bflo(u.z), bfhi(u.z)}, x67 = {bflo(u.w), bfhi(u.w)}; \
            if (REFILL) CONV_LOADROW(rr + 16, cur[I]); \
            CONV_FMA(I, 7); \
            __builtin_amdgcn_sched_barrier(0); \
            { const int kk = rr + 1 > 31 ? 31 : rr + 1; const LAS f32x4* wp = (const LAS f32x4*)(wl + kk * 512 + 8 * lane); wA[((I) + 1) & 7] = wp[0]; wB[((I) + 1) & 7] = wp[1]; }     \
            __builtin_amdgcn_sched_barrier(0); \
            CONV_FMA(I, 0); CONV_FMA(I, 1); CONV_FMA(I, 2); CONV_FMA(I, 3); CONV_FMA(I, 4); CONV_FMA(I, 5); CONV_FMA(I, 6); \
            __builtin_amdgcn_sched_barrier(0); } while (0)
#pragma unroll 1
    for (int c0 = 0; c0 < 32; c0 += 16) {
#pragma unroll
        for (int i = 0; i < 16; ++i) CONV_ROW(i, c0 + i, true);
    }
#pragma unroll
    for (int i = 0; i < 8; ++i) CONV_ROW(i, 32 + i, false);
#undef CONV_ROW
#undef CONV_FMA
#undef CONV_LOADROW
    float acc[8][8];
#pragma unroll
    for (int tt = 0; tt < 8; ++tt)
#pragma unroll
        for (int c = 0; c < 4; ++c) { acc[tt][2 * c] = acc2[tt][c].x; acc[tt][2 * c + 1] = acc2[tt][c].y; }
    const f32x4 cb0 = *(const f32x4*)(cb + 8 * lane), cb1 = *(const f32x4*)(cb + 8 * lane + 4);
    const f32x4 lg0 = *(const f32x4*)(lg + 8 * lane), lg1 = *(const f32x4*)(lg + 8 * lane + 4);
    const f32x4 lb0 = *(const f32x4*)(lb + 8 * lane), lb1 = *(const f32x4*)(lb + 8 * lane + 4);
    const float cbv[8] = {cb0.x, cb0.y, cb0.z, cb0.w, cb1.x, cb1.y, cb1.z, cb1.w};
    const float lgv[8] = {lg0.x, lg0.y, lg0.z, lg0.w, lg1.x, lg1.y, lg1.z, lg1.w};
    const float lbv[8] = {lb0.x, lb0.y, lb0.z, lb0.w, lb1.x, lb1.y, lb1.z, lb1.w};
#pragma unroll
    for (int tt = 0; tt < 8; ++tt) {
        float y[8]; float s1 = 0.f;
#pragma unroll
        for (int c = 0; c < 8; ++c) { y[c] = acc[tt][c] + cbv[c]; s1 += y[c]; }
        const float mean = wave_sum(s1) * (1.f / 512.f);
        float s2 = 0.f;
#pragma unroll
        for (int c = 0; c < 8; ++c) { y[c] -= mean; s2 += y[c] * y[c]; }
        const float rstd = rsqrtf(wave_sum(s2) * (1.f / 512.f) + LN_EPS);
        float z[8];
#pragma unroll
        for (int c = 0; c < 8; ++c) { const float v = y[c] * rstd * lgv[c] + lbv[c]; z[c] = v / (1.f + __expf(-v)); }
        v4u o; o.x = cvtpk(z[0], z[1]); o.y = cvtpk(z[2], z[3]); o.z = cvtpk(z[4], z[5]); o.w = cvtpk(z[6], z[7]);
        *(v4u*)(MIX + (rowbase + t0 + tt) * 1024 + 512 + 8 * lane) = o;
    }
}

__device__ __forceinline__ void ln1_rows4(const bf16* H, bf16* X1B, const float* g, const float* bt, int r, int lane) {
    const v4u* hr = (const v4u*)(H + (size_t)r * DM) + 2 * lane;
    v4u hv[4][2];
#pragma unroll
    for (int u = 0; u < 4; ++u) { hv[u][0] = hr[u * 128]; hv[u][1] = hr[u * 128 + 1]; }
    const f32x4* gp = (const f32x4*)g + 4 * lane; const f32x4* bp = (const f32x4*)bt + 4 * lane;
    float gv[16], bv[16];
#pragma unroll
    for (int q = 0; q < 4; ++q) { const f32x4 a = gp[q], b = bp[q]; gv[4 * q] = a.x; gv[4 * q + 1] = a.y; gv[4 * q + 2] = a.z; gv[4 * q + 3] = a.w; bv[4 * q] = b.x; bv[4 * q + 1] = b.y; bv[4 * q + 2] = b.z; bv[4 * q + 3] = b.w; }
#pragma unroll
    for (int u = 0; u < 4; ++u) {
        float v[16];
#pragma unroll
        for (int k = 0; k < 2; ++k) { const v4u a = hv[u][k];
            v[8 * k] = bflo(a.x); v[8 * k + 1] = bfhi(a.x); v[8 * k + 2] = bflo(a.y); v[8 * k + 3] = bfhi(a.y); v[8 * k + 4] = bflo(a.z); v[8 * k + 5] = bfhi(a.z); v[8 * k + 6] = bflo(a.w); v[8 * k + 7] = bfhi(a.w); }
        float s = 0.f;
#pragma unroll
        for (int i = 0; i < 16; ++i) s += v[i];
        const float mean = wave_sum(s) * (1.f / DM); float s2 = 0.f;
#pragma unroll
        for (int i = 0; i < 16; ++i) { v[i] -= mean; s2 += v[i] * v[i]; }
        const float rstd = rsqrtf(wave_sum(s2) * (1.f / DM) + LN_EPS);
        float o[16];
#pragma unroll
        for (int i = 0; i < 16; ++i) o[i] = v[i] * rstd * gv[i] + bv[i];
        v4u w0, w1;
        w0.x = cvtpk(o[0], o[1]); w0.y = cvtpk(o[2], o[3]); w0.z = cvtpk(o[4], o[5]); w0.w = cvtpk(o[6], o[7]);
        w1.x = cvtpk(o[8], o[9]); w1.y = cvtpk(o[10], o[11]); w1.z = cvtpk(o[12], o[13]); w1.w = cvtpk(o[14], o[15]);
        v4u* od = (v4u*)(X1B + (size_t)(r + u) * DM) + 2 * lane; od[0] = w0; od[1] = w1;
    }
}

__device__ __forceinline__ unsigned f2key(float f) { const unsigned u = __float_as_uint(f); return (u & 0x80000000u) ? ~u : (u | 0x80000000u); }
__device__ __forceinline__ float key2f(unsigned k) { const unsigned u = (k & 0x80000000u) ? (k & 0x7fffffffu) : ~k; return __uint_as_float(u); }
__device__ __forceinline__ unsigned umax2(unsigned a, unsigned b) { return a > b ? a : b; }
__device__ __forceinline__ unsigned umin2(unsigned a, unsigned b) { return a < b ? a : b; }

typedef short bf16x8_t __attribute__((ext_vector_type(8)));
typedef float f32x16_t __attribute__((ext_vector_type(16)));
typedef short s16x4_t __attribute__((ext_vector_type(4)));
__device__ __forceinline__ int crow(int r, int hi) { return (r & 3) + 8 * (r >> 2) + 4 * hi; }
__device__ __forceinline__ s16x4_t vtr(const LAS unsigned char* p) { return __builtin_bit_cast(s16x4_t, __builtin_amdgcn_ds_read_tr16_b64_v4i16((LAS s16x4_t*)p)); }
struct AttnArgs { const bf16* QB; const bf16* KB; const bf16* VB; const float* ck; const float* cv; const float* out; bf16* OP; float* LSE; };
__device__ __forceinline__ bf16x8_t cvt8(const f32x4 a, const f32x4 b) { const v4u u = {cvtpk(a.x, a.y), cvtpk(a.z, a.w), cvtpk(b.x, b.y), cvtpk(b.z, b.w)}; return __builtin_bit_cast(bf16x8_t, u); }
template <bool SAMP, bool FULL>
__device__ __forceinline__ void attn_mfma_task(const AttnArgs& A, int task, LAS unsigned char* vbuf, int lane) {
    int b, h, br, res, i0, nq;
    if constexpr (!SAMP) {
        const int ti = task & 127; int rest = task >> 7; br = rest % 3; rest /= 3; h = rest & 7; b = rest >> 3;
        const int sh_ = 2 * br; res = ti >> (7 - sh_); i0 = (ti & ((128 >> sh_) - 1)) * 32; nq = 32;
    } else {
        const int sub = task % 13; int rest = task / 13; h = rest & 7; b = rest >> 3;
        if (sub == 0) { br = 0; res = 0; i0 = 2048; nq = 8; } else if (sub < 5) { br = 1; res = sub - 1; i0 = 512; nq = 2; } else { br = 2; res = sub - 5; i0 = 128; nq = 1; }
    }
    const int sh = 2 * br;
    const int q = lane & 31, hi = lane >> 5;
    const size_t rowb = (size_t)b * 4096;
    auto srow = [&](const float* cache, size_t onew, int pp) -> const float* {
        const int pc = pp > 2055 ? 2055 : pp;
        return pc < LB ? cache + ((size_t)b * 2048 + pc) * 512 + h * 64 : A.out + onew + ((size_t)b * 2048 + pc - 8) * 512 + h * 64;
    };
    const int iq = i0 + (q < nq ? q : nq - 1);
    const int posq = res + (iq << sh);
    const size_t qrow = SAMP ? (size_t)NP + (size_t)b * 8 + (posq - LB) : rowb + posq;
    bf16x8_t qf[4];
    { const bf16* qp = A.QB + qrow * 512 + h * 64 + 8 * hi;
#pragma unroll
      for (int ks = 0; ks < 4; ++ks) qf[ks] = *(const bf16x8_t*)(qp + 16 * ks); }
    const int tstart = FULL ? 0 : (i0 >= 128 ? 0 : ((128 - i0) >> 5));
    const int vc = lane & 7, vr = lane >> 3;
    const int vdst = (vc >> 2) * 2048 + vr * 64 + (vc & 3) * 16;
    v4u vreg[4];
    auto loadv = [&](int t) {
#pragma unroll
        for (int i_ = 0; i_ < 4; ++i_) {
            const int j_ = i0 - 128 + 32 * t + vr + 8 * i_;
            if constexpr (!SAMP) { vreg[i_] = *(const v4u*)(A.VB + (rowb + res + ((size_t)j_ << sh)) * 512 + h * 64 + 8 * vc); }
            else { const f32x4* vp_ = (const f32x4*)(srow(A.cv, O_VS, res + (j_ << sh)) + 8 * vc); vreg[i_] = __builtin_bit_cast(v4u, cvt8(vp_[0], vp_[1])); }
        }
    };
    if (tstart == 0) loadv(0); else if (tstart == 1) loadv(1); else if (tstart == 2) loadv(2); else if (tstart == 3) loadv(3); else loadv(4);
    f32x16_t sc[5];
    float mx = -INFINITY;
    bf16x8_t kall[FULL ? 5 : 1][4];
    if constexpr (FULL) {
#pragma unroll
        for (int t = 0; t < 5; ++t) {
            const int j = i0 - 128 + 32 * t + q;
            if constexpr (!SAMP) {
                const bf16* kp = A.KB + (rowb + res + ((size_t)j << sh)) * 512 + h * 64 + 8 * hi;
#pragma unroll
                for (int ks = 0; ks < 4; ++ks) kall[t][ks] = *(const bf16x8_t*)(kp + 16 * ks);
            } else {
                const f32x4* kp = (const f32x4*)(srow(A.ck, O_KS, res + (j << sh)) + 8 * hi);
#pragma unroll
                for (int ks = 0; ks < 4; ++ks) kall[t][ks] = cvt8(kp[4 * ks], kp[4 * ks + 1]);
            }
        }
        __builtin_amdgcn_sched_barrier(0);
    }
#pragma unroll
    for (int t = 0; t < 5; ++t) {
        if (t >= tstart) {
            const int j = i0 - 128 + 32 * t + q;
            bf16x8_t kf[4];
            if constexpr (FULL) {
#pragma unroll
                for (int ks = 0; ks < 4; ++ks) kf[ks] = kall[t][ks];
            } else if constexpr (!SAMP) {
                const bf16* kp = A.KB + (rowb + res + ((size_t)j << sh)) * 512 + h * 64 + 8 * hi;
#pragma unroll
                for (int ks = 0; ks < 4; ++ks) kf[ks] = *(const bf16x8_t*)(kp + 16 * ks);
            } else {
                const f32x4* kp = (const f32x4*)(srow(A.ck, O_KS, res + (j << sh)) + 8 * hi);
#pragma unroll
                for (int ks = 0; ks < 4; ++ks) kf[ks] = cvt8(kp[4 * ks], kp[4 * ks + 1]);
            }
            f32x16_t a = {0.f, 0.f, 0.f, 0.f, 0.f, 0.f, 0.f, 0.f, 0.f, 0.f, 0.f, 0.f, 0.f, 0.f, 0.f, 0.f};
#pragma unroll
            for (int ks = 0; ks < 4; ++ks) a = __builtin_amdgcn_mfma_f32_32x32x16_bf16(kf[ks], qf[ks], a, 0, 0, 0);
#pragma unroll
            for (int r = 0; r < 16; ++r) {
                float v = a[r] * 0.125f;
                if (t == 0) { if (crow(r, hi) < q) v = -INFINITY; }
                if (t == 4) { if (crow(r, hi) > q) v = -INFINITY; }
                a[r] = v; mx = fmaxf(mx, v);
            }
            sc[t] = a;
        } else {
#pragma unroll
            for (int r = 0; r < 16; ++r) sc[t][r] = -INFINITY;
        }
    }
    mx = fmaxf(mx, __shfl_xor(mx, 32));
    float l = 0.f;
#pragma unroll
    for (int t = 0; t < 5; ++t)
#pragma unroll
        for (int r = 0; r < 16; ++r) { const float pv = __expf(sc[t][r] - mx); sc[t][r] = pv; l += pv; }
    l += __shfl_xor(l, 32);
    f32x16_t o0 = {0.f, 0.f, 0.f, 0.f, 0.f, 0.f, 0.f, 0.f, 0.f, 0.f, 0.f, 0.f, 0.f, 0.f, 0.f, 0.f}, o1 = o0;
    const int vb = ((lane >> 4) & 1) * 32 + (lane & 3) * 8 + (4 * hi + ((lane & 15) >> 2)) * 64;
#pragma unroll
    for (int t = 0; t < 5; ++t) {
        if (t >= tstart) {
            LAS unsigned char* buf = vbuf + (t & 1) * 4096;
#pragma unroll
            for (int i = 0; i < 4; ++i) *(LAS v4u*)(buf + vdst + i * 512) = vreg[i];
            if (t < 4) loadv(t + 1);
            LDS_WAIT();
            unsigned pw_[8];
#pragma unroll
            for (int k = 0; k < 8; ++k) pw_[k] = cvtpk(sc[t][2 * k], sc[t][2 * k + 1]);
            const v4u pa0u = {pw_[0], pw_[1], pw_[2], pw_[3]}, pa1u = {pw_[4], pw_[5], pw_[6], pw_[7]};
            const bf16x8_t pa0 = __builtin_bit_cast(bf16x8_t, pa0u), pa1 = __builtin_bit_cast(bf16x8_t, pa1u);
            const LAS unsigned char* vp = buf + vb;
            s16x4_t lo, hh;
#define ATT_VFR() (bf16x8_t){lo[0], lo[1], lo[2], lo[3], hh[0], hh[1], hh[2], hh[3]}
            lo = vtr(vp);               hh = vtr(vp + 512);         o0 = __builtin_amdgcn_mfma_f32_32x32x16_bf16(pa0, ATT_VFR(), o0, 0, 0, 0);
            lo = vtr(vp + 1024);        hh = vtr(vp + 1024 + 512);  o0 = __builtin_amdgcn_mfma_f32_32x32x16_bf16(pa1, ATT_VFR(), o0, 0, 0, 0);
            lo = vtr(vp + 2048);        hh = vtr(vp + 2048 + 512);  o1 = __builtin_amdgcn_mfma_f32_32x32x16_bf16(pa0, ATT_VFR(), o1, 0, 0, 0);
            lo = vtr(vp + 3072);        hh = vtr(vp + 3072 + 512);  o1 = __builtin_amdgcn_mfma_f32_32x32x16_bf16(pa1, ATT_VFR(), o1, 0, 0, 0);
#undef ATT_VFR
            LDS_WAIT();
        }
    }
    const float rl = 1.f / l;
#pragma unroll
    for (int r = 0; r < 16; ++r) {
        const int qq = crow(r, hi);
        const float ri = __shfl(rl, qq);
        const int pp = res + ((i0 + qq) << sh);
        const size_t orow_ = SAMP ? (size_t)NP + (size_t)b * 8 + (pp - LB) : rowb + pp;
        if (qq < nq) {
            bf16* orow = A.OP + ((size_t)br * NTOK + orow_) * 512 + h * 64 + q;
            orow[0] = (bf16)(cvtpk(o0[r] * ri, 0.f) & 0xffffu);
            orow[32] = (bf16)(cvtpk(o1[r] * ri, 0.f) & 0xffffu);
        }
    }
    if (hi == 0 && q < nq) A.LSE[((size_t)br * NTOK + qrow) * 8 + h] = mx + __logf(l);
}
constexpr int ATT_KIMG = 0, ATT_VIMG = 49152, ATT_VPLANE = 24576, ATT_OTILE = 98304;
__device__ __forceinline__ void attn_block_phase(const AttnArgs& A, LAS unsigned char* lds, int G, int tid, int wave, int lane) {
    constexpr int NUNIT = NPB * NH * 3 * 16;
    asm volatile("" : "+v"(lane));
    const int q = lane & 31, hi = lane >> 5;
    const int srow0 = wave * 8 + (lane >> 3), sch = lane & 7;
    v4u pk_[6], pv_[6];
    auto decode = [&](int unit, int& b, int& h, int& br, int& res, int& i0u) {
        const int uu = unit & 15; int rest = unit >> 4; br = rest % 3; rest /= 3; h = rest & 7; b = rest >> 3;
        const int sh_ = 2 * br, upr = 16 >> sh_; res = uu / upr; i0u = (uu % upr) * 256;
    };
    auto request = [&](int unit) {
        int b, h, br, res, i0u; decode(unit, b, h, br, res, i0u); const int sh = 2 * br; const size_t rowb = (size_t)b * 4096;
#pragma unroll
        for (int p_ = 0; p_ < 6; ++p_) {
            const int row = srow0 + 64 * p_, j = i0u - 128 + row;
            if (j >= 0) { const size_t o = (rowb + res + ((size_t)j << sh)) * 512 + h * 64 + 8 * sch; pk_[p_] = *(const v4u*)(A.KB + o); pv_[p_] = *(const v4u*)(A.VB + o); }
        }
    };
    auto commit = [&](int unit) {
        int b, h, br, res, i0u; decode(unit, b, h, br, res, i0u);
#pragma unroll
        for (int p_ = 0; p_ < 6; ++p_) {
            const int row = srow0 + 64 * p_, j = i0u - 128 + row;
            if (j >= 0) {
                *(LAS v4u*)(lds + ATT_KIMG + row * 128 + ((sch ^ (row & 7)) << 4)) = pk_[p_];
                *(LAS v4u*)(lds + ATT_VIMG + (sch >> 2) * ATT_VPLANE + row * 64 + (sch & 3) * 16) = pv_[p_];
            }
        }
    };
    int unit = (int)blockIdx.x;
    if (unit < NUNIT) request(unit);
    bf16x8_t qf[4];
    auto request_q = [&](int u_) {
        int b, h, br, res, i0u; decode(u_, b, h, br, res, i0u); const int sh = 2 * br; const size_t rowb = (size_t)b * 4096;
        const bf16* qp = A.QB + (rowb + res + ((size_t)(i0u + 32 * wave + q) << sh)) * 512 + h * 64 + 8 * hi;
#pragma unroll
        for (int ks = 0; ks < 4; ++ks) qf[ks] = *(const bf16x8_t*)(qp + 16 * ks);
    };
    if (unit < NUNIT) request_q(unit);
    constexpr float SC2 = 0.125f * 1.4426950408889634f;
    for (; unit < NUNIT; unit += G) {
        int b, h, br, res, i0u; decode(unit, b, h, br, res, i0u); const int sh = 2 * br; const size_t rowb = (size_t)b * 4096;
        __syncthreads();
        commit(unit);
        __syncthreads();
        if (unit + G < NUNIT) request(unit + G);
        const int i0 = i0u + 32 * wave;
        const int tstart = i0 >= 128 ? 0 : ((128 - i0) >> 5);
        f32x16_t sc[5]; float mx = -INFINITY;
#pragma unroll
        for (int t = 0; t < 5; ++t) {
            if (t >= tstart) {
                const int row = 32 * (wave + t) + q;
                bf16x8_t kf[4];
#pragma unroll
                for (int ks = 0; ks < 4; ++ks) kf[ks] = *(const LAS bf16x8_t*)(lds + ATT_KIMG + row * 128 + (((2 * ks + hi) ^ (row & 7)) << 4));
                f32x16_t a = {0.f, 0.f, 0.f, 0.f, 0.f, 0.f, 0.f, 0.f, 0.f, 0.f, 0.f, 0.f, 0.f, 0.f, 0.f, 0.f};
#pragma unroll
                for (int ks = 0; ks < 4; ++ks) a = __builtin_amdgcn_mfma_f32_32x32x16_bf16(kf[ks], qf[ks], a, 0, 0, 0);
#pragma unroll
                for (int r = 0; r < 16; ++r) {
                    float v = a[r];
                    if (t == 0) { if (crow(r, hi) < q) v = -INFINITY; }
                    if (t == 4) { if (crow(r, hi) > q) v = -INFINITY; }
                    a[r] = v; mx = fmaxf(mx, v);
                }
                sc[t] = a;
            } else {
#pragma unroll
                for (int r = 0; r < 16; ++r) sc[t][r] = -INFINITY;
            }
        }
        if (unit + G < NUNIT) request_q(unit + G);
        mx = fmaxf(mx, __shfl_xor(mx, 32));
        const float mb = mx * SC2;
        float l = 0.f;
        unsigned pkp[5][8];
#pragma unroll
        for (int t = 0; t < 5; ++t)
#pragma unroll
            for (int k = 0; k < 8; ++k) { const float p0 = __builtin_amdgcn_exp2f(fmaf(sc[t][2 * k], SC2, -mb)), p1 = __builtin_amdgcn_exp2f(fmaf(sc[t][2 * k + 1], SC2, -mb)); l += p0 + p1; pkp[t][k] = cvtpk(p0, p1); }
        l += __shfl_xor(l, 32);
        f32x16_t o0 = {0.f, 0.f, 0.f, 0.f, 0.f, 0.f, 0.f, 0.f, 0.f, 0.f, 0.f, 0.f, 0.f, 0.f, 0.f, 0.f}, o1 = o0;
        const int vb = ((lane >> 4) & 1) * 32 + (lane & 3) * 8 + (4 * hi + ((lane & 15) >> 2)) * 64;
#pragma unroll
        for (int t = 0; t < 5; ++t) {
            if (t >= tstart) {
                const v4u pa0u = {pkp[t][0], pkp[t][1], pkp[t][2], pkp[t][3]}, pa1u = {pkp[t][4], pkp[t][5], pkp[t][6], pkp[t][7]};
                const bf16x8_t pa0 = __builtin_bit_cast(bf16x8_t, pa0u), pa1 = __builtin_bit_cast(bf16x8_t, pa1u);
                const LAS unsigned char* vp = lds + ATT_VIMG + 32 * (wave + t) * 64 + vb;
                s16x4_t lo, hh;
#define ATT_VFR() (bf16x8_t){lo[0], lo[1], lo[2], lo[3], hh[0], hh[1], hh[2], hh[3]}
                lo = vtr(vp);                      hh = vtr(vp + 512);                      o0 = __builtin_amdgcn_mfma_f32_32x32x16_bf16(ATT_VFR(), pa0, o0, 0, 0, 0);
                lo = vtr(vp + 1024);               hh = vtr(vp + 1024 + 512);               o0 = __builtin_amdgcn_mfma_f32_32x32x16_bf16(ATT_VFR(), pa1, o0, 0, 0, 0);
                lo = vtr(vp + ATT_VPLANE);         hh = vtr(vp + ATT_VPLANE + 512);         o1 = __builtin_amdgcn_mfma_f32_32x32x16_bf16(ATT_VFR(), pa0, o1, 0, 0, 0);
                lo = vtr(vp + ATT_VPLANE + 1024);  hh = vtr(vp + ATT_VPLANE + 1024 + 512);  o1 = __builtin_amdgcn_mfma_f32_32x32x16_bf16(ATT_VFR(), pa1, o1, 0, 0, 0);
#undef ATT_VFR
            }
        }
        const float rl = 1.f / l;
        const size_t orow_ = rowb + res + ((size_t)(i0 + q) << sh);
        {
            LAS unsigned char* ot = lds + ATT_OTILE + wave * 4096;
            const int fq_ = (q >> 1) & 7;
#pragma unroll
            for (int g = 0; g < 4; ++g) {
                v2u w0, w1;
                w0.x = cvtpk(o0[4 * g] * rl, o0[4 * g + 1] * rl); w0.y = cvtpk(o0[4 * g + 2] * rl, o0[4 * g + 3] * rl);
                w1.x = cvtpk(o1[4 * g] * rl, o1[4 * g + 1] * rl); w1.y = cvtpk(o1[4 * g + 2] * rl, o1[4 * g + 3] * rl);
                *(LAS v2u*)(ot + q * 128 + ((g ^ fq_) << 4) + 8 * hi) = w0;
                *(LAS v2u*)(ot + q * 128 + (((4 + g) ^ fq_) << 4) + 8 * hi) = w1;
            }
            LDS_WAIT();
#pragma unroll
            for (int i = 0; i < 4; ++i) {
                const int r = 8 * i + (lane >> 3), c = lane & 7;
                const v4u w = *(const LAS v4u*)(ot + r * 128 + ((c ^ ((r >> 1) & 7)) << 4));
                *(v4u*)(A.OP + ((size_t)br * NTOK + rowb + res + ((size_t)(i0 + r) << sh)) * 512 + h * 64 + 8 * c) = w;
            }
            LDS_WAIT();
        }
        if (hi == 0) A.LSE[((size_t)br * NTOK + orow_) * 8 + h] = mx * 0.125f + __logf(l);
    }
}
__device__ __forceinline__ void attn_merge_row(const bf16* OP, const float* LSE, bf16* MIX, int r, int lane) {
    const int h = lane >> 3;
    const float l0 = LSE[((size_t)0 * NTOK + r) * 8 + h], l1 = LSE[((size_t)1 * NTOK + r) * 8 + h], l2 = LSE[((size_t)2 * NTOK + r) * 8 + h];
    const float m = fmaxf(l0, fmaxf(l1, l2));
    float w0 = __expf(l0 - m), w1 = __expf(l1 - m), w2 = __expf(l2 - m);
    const float inv = 1.f / (w0 + w1 + w2); w0 *= inv; w1 *= inv; w2 *= inv;
    const v4u a = *(const v4u*)(OP + ((size_t)0 * NTOK + r) * 512 + 8 * lane), bq = *(const v4u*)(OP + ((size_t)1 * NTOK + r) * 512 + 8 * lane), c = *(const v4u*)(OP + ((size_t)2 * NTOK + r) * 512 + 8 * lane);
    v4u o;
    o.x = cvtpk(w0 * bflo(a.x) + w1 * bflo(bq.x) + w2 * bflo(c.x), w0 * bfhi(a.x) + w1 * bfhi(bq.x) + w2 * bfhi(c.x));
    o.y = cvtpk(w0 * bflo(a.y) + w1 * bflo(bq.y) + w2 * bflo(c.y), w0 * bfhi(a.y) + w1 * bfhi(bq.y) + w2 * bfhi(c.y));
    o.z = cvtpk(w0 * bflo(a.z) + w1 * bflo(bq.z) + w2 * bflo(c.z), w0 * bfhi(a.z) + w1 * bfhi(bq.z) + w2 * bfhi(c.z));
    o.w = cvtpk(w0 * bflo(a.w) + w1 * bflo(bq.w) + w2 * bflo(c.w), w0 * bfhi(a.w) + w1 * bfhi(bq.w) + w2 * bfhi(c.w));
    *(v4u*)(MIX + (size_t)r * 1024 + 8 * lane) = o;
}

__device__ __forceinline__ void cswap(unsigned& a, unsigned& b) { const unsigned hi_ = a > b ? a : b, lo_ = a > b ? b : a; a = hi_; b = lo_; }
__device__ __forceinline__ void sort16_desc(unsigned (&x)[16]) {
#pragma unroll
    for (int k = 2; k <= 16; k <<= 1)
#pragma unroll
        for (int j = k >> 1; j > 0; j >>= 1)
#pragma unroll
            for (int i = 0; i < 16; ++i) { const int l = i ^ j; if (l > i) { if ((i & k) == 0) cswap(x[i], x[l]); else cswap(x[l], x[i]); } }
}
__device__ __forceinline__ void merge16_desc(unsigned (&a)[16], const unsigned (&b)[16]) {
#pragma unroll
    for (int i = 0; i < 16; ++i) a[i] = umax2(a[i], b[15 - i]);
#pragma unroll
    for (int j = 8; j > 0; j >>= 1)
#pragma unroll
        for (int i = 0; i < 16; ++i) { const int l = i ^ j; if (l > i) cswap(a[i], a[l]); }
}
__device__ __forceinline__ void pair_merge16(unsigned (&a)[16]) {
    unsigned pb[16];
#pragma unroll
    for (int i = 0; i < 16; ++i) pb[i] = (unsigned)__shfl_xor((int)a[i], 32);
    merge16_desc(a, pb);
}
struct CacheCopy { const f32x4* ck; const f32x4* cv; f32x4* ok; f32x4* ov; };
__device__ __forceinline__ void top16_of_half(const bf16* PQ, const LAS unsigned char* skl, int token0, int h, int p, int lane, unsigned (&top)[16], const CacheCopy& cc, int slot0) {
    const int tok = lane & 31, hi = lane >> 5;
    const bf16* qp = PQ + (size_t)(token0 + tok) * PQD + h * 256 + p * 128 + 8 * hi;
    bf16x8_t bq[8];
#pragma unroll
    for (int ks = 0; ks < 8; ++ks) bq[ks] = *(const bf16x8_t*)(qp + 16 * ks);
    unsigned g0[16];
    constexpr long CPB = 2040L * 128, CTOT = NSB * CPB;
    int ci[2]; f32x4 ca[2], cb[2];
#pragma unroll 1
    for (int kt = 0; kt < 4; ++kt) {
        if (kt > 0) {
#pragma unroll
            for (int u = 0; u < 2; ++u) { cc.ok[ci[u]] = ca[u]; cc.ov[ci[u]] = cb[u]; }
        }
#pragma unroll
        for (int u = 0; u < 2; ++u) {
            int idx = (slot0 + kt) * 128 + lane + 64 * u; if (idx >= (int)CTOT) idx = (int)CTOT - 1;
            const int b = idx / (int)CPB, rem = idx - b * (int)CPB; ci[u] = b * 2048 * 128 + rem; ca[u] = cc.ck[ci[u] + 8 * 128]; cb[u] = cc.cv[ci[u] + 8 * 128];
        }
        f32x16_t a = {0.f, 0.f, 0.f, 0.f, 0.f, 0.f, 0.f, 0.f, 0.f, 0.f, 0.f, 0.f, 0.f, 0.f, 0.f, 0.f};
#pragma unroll
        for (int ks = 0; ks < 8; ++ks) { const int row = p * 128 + 32 * kt + tok; const bf16x8_t ka = *(const LAS bf16x8_t*)(skl + row * 256 + (((2 * ks + hi) ^ (row & 15)) << 4)); a = __builtin_amdgcn_mfma_f32_32x32x16_bf16(ka, bq[ks], a, 0, 0, 0); }
        unsigned x[16];
#pragma unroll
        for (int r = 0; r < 16; ++r) x[r] = (f2key(a[r]) & ~127u) | (unsigned)(32 * kt + crow(r, hi));
        sort16_desc(x);
        if (kt == 0) {
#pragma unroll
            for (int i = 0; i < 16; ++i) g0[i] = x[i];
        } else { merge16_desc(g0, x); }
    }
    pair_merge16(g0);
#pragma unroll
    for (int u = 0; u < 2; ++u) { cc.ok[ci[u]] = ca[u]; cc.ov[ci[u]] = cb[u]; }
#pragma unroll
    for (int i = 0; i < 16; ++i) top[i] = g0[i];
}
__device__ __forceinline__ void topk_mfma_task(const bf16* PQ, const LAS unsigned char* skl, int* IDX, float* GATE, int tile, int h, int lane, const CacheCopy& cc) {
    const int token0 = tile * 32;
    const int tok = lane & 31, hi = lane >> 5;
    unsigned t0[16], t1[16];
    const int slot0 = (tile * 8 + h) * 8;
    top16_of_half(PQ, skl, token0, h, 0, lane, t0, cc, slot0);
    top16_of_half(PQ, skl, token0, h, 1, lane, t1, cc, slot0 + 4);
    float v0[16], v1[16];
#pragma unroll
    for (int i = 0; i < 16; ++i) { v0[i] = key2f(t0[i] & ~127u); v1[i] = key2f(t1[i] & ~127u); }
    unsigned ca[16], cb[16];
#define CAND(dst, i0_, j0_, i1_, j1_, pad1) do { const float a_ = hi ? v0[i1_] : v0[i0_], b_ = hi ? v1[j1_] : v1[j0_]; \
        const unsigned pa_ = hi ? (t0[i1_] & 127u) : (t0[i0_] & 127u), pb_ = hi ? (t1[j1_] & 127u) : (t1[j0_] & 127u); \
        const unsigned fx_ = umin2((unsigned)fmaxf(fmaf(a_ + b_, 4096.f, 131072.5f), 0.f), 262143u);     \
        const unsigned k_ = (fx_ << 14) | (pa_ << 7) | pb_; dst = ((pad1) && hi) ? 0u : k_; } while (0)
    CAND(ca[0], 0, 0, 1, 0, 0);  CAND(ca[1], 0, 1, 1, 1, 0);  CAND(ca[2], 0, 2, 1, 2, 0);  CAND(ca[3], 0, 3, 1, 3, 0);
    CAND(ca[4], 0, 4, 1, 4, 0);  CAND(ca[5], 0, 5, 1, 5, 0);  CAND(ca[6], 0, 6, 1, 6, 0);  CAND(ca[7], 0, 7, 1, 7, 0);
    CAND(ca[8], 0, 8, 3, 0, 0);  CAND(ca[9], 0, 9, 3, 1, 0);  CAND(ca[10], 0, 10, 3, 2, 0); CAND(ca[11], 0, 11, 3, 3, 0);
    CAND(ca[12], 0, 12, 5, 0, 0); CAND(ca[13], 0, 13, 5, 1, 0); CAND(ca[14], 0, 14, 6, 0, 0); CAND(ca[15], 0, 15, 6, 1, 0);
    CAND(cb[0], 2, 0, 7, 0, 0);  CAND(cb[1], 2, 1, 7, 1, 0);  CAND(cb[2], 2, 2, 0, 0, 1);  CAND(cb[3], 2, 3, 0, 0, 1);
    CAND(cb[4], 2, 4, 0, 0, 1);  CAND(cb[5], 4, 0, 0, 0, 1);  CAND(cb[6], 4, 1, 0, 0, 1);  CAND(cb[7], 4, 2, 0, 0, 1);
    CAND(cb[8], 8, 0, 0, 0, 1);  CAND(cb[9], 9, 0, 0, 0, 1);  CAND(cb[10], 10, 0, 0, 0, 1); CAND(cb[11], 11, 0, 0, 0, 1);
    CAND(cb[12], 12, 0, 0, 0, 1); CAND(cb[13], 13, 0, 0, 0, 1); CAND(cb[14], 14, 0, 0, 0, 1); CAND(cb[15], 15, 0, 0, 0, 1);
#undef CAND
    sort16_desc(ca); sort16_desc(cb);
    merge16_desc(ca, cb);
    pair_merge16(ca);
    float g[16]; float sum = 0.f;
    const float gm = (float)(ca[0] >> 14);
#pragma unroll
    for (int k = 0; k < 16; ++k) { g[k] = __expf(((float)(ca[k] >> 14) - gm) * (1.f / 4096.f)); sum += g[k]; }
    const float inv = 1.f / sum;
    v4u e0, e1; f32x4 g0, g1;
    e0.x = (hi ? ca[8] : ca[0]) & 0x3fffu; e0.y = (hi ? ca[9] : ca[1]) & 0x3fffu; e0.z = (hi ? ca[10] : ca[2]) & 0x3fffu; e0.w = (hi ? ca[11] : ca[3]) & 0x3fffu;
    e1.x = (hi ? ca[12] : ca[4]) & 0x3fffu; e1.y = (hi ? ca[13] : ca[5]) & 0x3fffu; e1.z = (hi ? ca[14] : ca[6]) & 0x3fffu; e1.w = (hi ? ca[15] : ca[7]) & 0x3fffu;
    g0.x = (hi ? g[8] : g[0]) * inv; g0.y = (hi ? g[9] : g[1]) * inv; g0.z = (hi ? g[10] : g[2]) * inv; g0.w = (hi ? g[11] : g[3]) * inv;
    g1.x = (hi ? g[12] : g[4]) * inv; g1.y = (hi ? g[13] : g[5]) * inv; g1.z = (hi ? g[14] : g[6]) * inv; g1.w = (hi ? g[15] : g[7]) * inv;
    const size_t o = (size_t)(token0 + tok) * 128 + h * 16 + 8 * hi;
    *(v4u*)(IDX + o) = e0; *(v4u*)(IDX + o + 4) = e1;
    *(f32x4*)(GATE + o) = g0; *(f32x4*)(GATE + o + 4) = g1;
}

__device__ __forceinline__ float gelu_erf(float x) { return 0.5f * x * (1.f + erff(x * 0.70710678118654752f)); }
__device__ __forceinline__ int rdlane_i(int v, int l) { return __builtin_amdgcn_readlane(v, l); }
__device__ __forceinline__ float rdlane_f(float v, int l) { return __int_as_float(__builtin_amdgcn_readlane(__float_as_int(v), l)); }
__device__ __forceinline__ void peer_finish_token6(f32x2_t (&acc2)[16], const bf16* X1B, const float* g2, const float* b2, float* Y, int r, int lane) {
    const int lp = lane & 31, hf = lane >> 5;
    float acc[32];
#pragma unroll
    for (int i = 0; i < 16; ++i) { acc[2 * i] = acc2[i].x; acc[2 * i + 1] = acc2[i].y; }
#pragma unroll
    for (int i = 0; i < 32; ++i) acc[i] += __shfl_xor(acc[i], 32);
    const v4u* hp = (const v4u*)(X1B + (size_t)r * DM) + 4 * lp;
    float z[32];
#pragma unroll
    for (int k = 0; k < 4; ++k) { const v4u a = hp[k];
        z[8 * k + 0] = bflo(a.x); z[8 * k + 1] = bfhi(a.x); z[8 * k + 2] = bflo(a.y); z[8 * k + 3] = bfhi(a.y); z[8 * k + 4] = bflo(a.z); z[8 * k + 5] = bfhi(a.z); z[8 * k + 6] = bflo(a.w); z[8 * k + 7] = bfhi(a.w); }
    float s = 0.f;
#pragma unroll
    for (int i = 0; i < 32; ++i) { z[i] = ALPHA * z[i] + acc[i]; s += z[i]; }
    const float mean = wave_sum(s) * (0.5f / DM); float s2 = 0.f;
#pragma unroll
    for (int i = 0; i < 32; ++i) { z[i] -= mean; s2 += z[i] * z[i]; }
    const float rstd = rsqrtf(wave_sum(s2) * (0.5f / DM) + LN_EPS);
    const int c0 = 32 * lp + 16 * hf;
    const f32x4* gp = (const f32x4*)(g2 + c0); const f32x4* bp = (const f32x4*)(b2 + c0);
    f32x4* yp = (f32x4*)(Y + (size_t)r * DM + c0);
#pragma unroll
    for (int q = 0; q < 4; ++q) {
        const f32x4 gv = gp[q], bv = bp[q];
        f32x4 o;
        o.x = (hf ? z[16 + 4 * q] : z[4 * q]) * rstd * gv.x + bv.x; o.y = (hf ? z[16 + 4 * q + 1] : z[4 * q + 1]) * rstd * gv.y + bv.y;
        o.z = (hf ? z[16 + 4 * q + 2] : z[4 * q + 2]) * rstd * gv.z + bv.z; o.w = (hf ? z[16 + 4 * q + 3] : z[4 * q + 3]) * rstd * gv.w + bv.w;
        yp[q] = o;
    }
}
__device__ __forceinline__ void peer_phase6(const bf16* X1B, const int* IDX, const float* GATE, const unsigned char* EU6, const unsigned char* EV6, const float* SU, const float* SV,
                                            const float* g2, const float* b2, float* Y, int gw, int NGW, int lane, LAS unsigned char* wl, LAS unsigned char* lds0, int wave, int nblk) {
    constexpr int TT = 2;
    LAS unsigned char* xl = wl;
    LAS v2u* Q = (LAS v2u*)(wl + TT * 4096);
    const __amdgpu_buffer_rsrc_t rsu = __builtin_amdgcn_make_buffer_rsrc((void*)EU6, 0, 16384 * 768, 0x00020000);
    const __amdgpu_buffer_rsrc_t rsv = __builtin_amdgcn_make_buffer_rsrc((void*)EV6, 0, 16384 * 768, 0x00020000);
    const int full = NTOK / (TT * NGW);
#define P6_XSTORE(BASE, A, B) do { LAS f32x4* xd_ = (LAS f32x4*)(BASE) + (4 * (lane & 1)) * 32 + (lane >> 1); \
        f32x4 f_; f_.x = bflo(A.x); f_.y = bfhi(A.x); f_.z = bflo(A.y); f_.w = bfhi(A.y); xd_[0] = f_; \
        f_.x = bflo(A.z); f_.y = bfhi(A.z); f_.z = bflo(A.w); f_.w = bfhi(A.w); xd_[32] = f_; \
        f_.x = bflo(B.x); f_.y = bfhi(B.x); f_.z = bflo(B.y); f_.w = bfhi(B.y); xd_[64] = f_; \
        f_.x = bflo(B.z); f_.y = bfhi(B.z); f_.z = bflo(B.w); f_.w = bfhi(B.w); xd_[96] = f_; } while (0)
#pragma unroll 1
    for (int pass = 0; pass < full; ++pass) {
        asm volatile("" : "+v"(lane));
        const int lp = lane & 31, hf = lane >> 5; const int voff24 = lp * 24;
        const int tok0 = (pass * NGW + gw) * TT; constexpr int T = TT;
        int e[2 * TT]; float g[2 * TT];
#pragma unroll
        for (int t = 0; t < TT; ++t) {
            if (t < T) {
                const size_t o = (size_t)(tok0 + t) * 128;
                e[2 * t] = IDX[o + lane]; e[2 * t + 1] = IDX[o + 64 + lane]; g[2 * t] = GATE[o + lane]; g[2 * t + 1] = GATE[o + 64 + lane];
                const v4u* xp = (const v4u*)(X1B + (size_t)(tok0 + t) * DM) + 2 * lane; const v4u a = xp[0], b = xp[1];
                P6_XSTORE(xl + t * 4096, a, b);
            } else { e[2 * t] = 1 << 20; e[2 * t + 1] = 1 << 20; g[2 * t] = 0.f; g[2 * t + 1] = 0.f; }
        }
        int pos[2 * TT];
#pragma unroll
        for (int r = 0; r < 2 * TT; ++r) pos[r] = 0;
        unsigned base[TT];
#pragma unroll
        for (int t = 0; t < TT; ++t) base[t] = 0u;
#pragma unroll 1
        for (int sl = 0; sl < 8; ++sl) {
#pragma unroll
            for (int r = 0; r < 2 * TT; ++r) {
                const bool hit = (e[r] >> 11) == sl;
                const unsigned long long m = __ballot(hit);
                const unsigned below = __builtin_amdgcn_mbcnt_hi((unsigned)(m >> 32), __builtin_amdgcn_mbcnt_lo((unsigned)m, 0u));
                if (hit) pos[r] = (int)(base[r >> 1] + below);
                base[r >> 1] += (unsigned)__popcll(m);
            }
        }
#pragma unroll
        for (int r = 0; r < 2 * TT; ++r) if ((e[r] >> 8) < 64) { v2u ent; ent.x = (unsigned)e[r]; ent.y = __float_as_uint(g[r]); Q[(r >> 1) * 128 + pos[r]] = ent; }
        LDS_WAIT();
        f32x2_t acc0[16], acc1[16];
#pragma unroll
        for (int i = 0; i < 16; ++i) { acc0[i] = (f32x2_t){0.f, 0.f}; acc1[i] = (f32x2_t){0.f, 0.f}; }
        v4u ub[4], vb[4]; v2u ub2[4], vb2[4];
        float gA, suA, svA;
#define P6_FETCH(QOFF) do { \
            const v2u ql_ = Q[(QOFF) + 2 * (lane & 3) + hf]; const int el_ = (int)ql_.x; gA = __uint_as_float(ql_.y); \
            _Pragma("unroll") for (int s_ = 0; s_ < 4; ++s_) { \
                const int ea_ = __builtin_amdgcn_readfirstlane((int)Q[(QOFF) + 2 * s_].x), eb_ = __builtin_amdgcn_readfirstlane((int)Q[(QOFF) + 2 * s_ + 1].x); \
                const int vo_ = (hf ? eb_ : ea_) * 768 + voff24; \
                ub[s_] = __builtin_amdgcn_raw_buffer_load_b128(rsu, vo_, 0, 0); ub2[s_] = __builtin_amdgcn_raw_buffer_load_b64(rsu, vo_ + 16, 0, 0); \
                vb[s_] = __builtin_amdgcn_raw_buffer_load_b128(rsv, vo_, 0, 0); vb2[s_] = __builtin_amdgcn_raw_buffer_load_b64(rsv, vo_ + 16, 0, 0); } \
            suA = SU[el_]; svA = SV[el_]; } while (0)
#define P6_CVT(RA, RB) __builtin_amdgcn_cvt_scalef32_pk32_f32_fp6((v6i_t){(int)RA.x, (int)RA.y, (int)RA.z, (int)RA.w, (int)RB.x, (int)RB.y}, 1.0f)
#define P6_MATH(TI, ACC) do { \
            f32x4 xq_[8]; \
            { const LAS f32x4* xp_ = (const LAS f32x4*)(xl + (TI) * 4096) + lp; \
              _Pragma("unroll") for (int k_ = 0; k_ < 8; ++k_) xq_[k_] = xp_[32 * k_]; } \
            float part[4]; \
            _Pragma("unroll") for (int s_ = 0; s_ < 4; ++s_) { const v32f_t uf_ = P6_CVT(ub[s_], ub2[s_]); f32x2_t d01_ = {0.f, 0.f}, d23_ = {0.f, 0.f}; \
                _Pragma("unroll") for (int k_ = 0; k_ < 8; ++k_) { \
                    d01_ = __builtin_elementwise_fma((f32x2_t){uf_[4 * k_], uf_[4 * k_ + 1]}, (f32x2_t){xq_[k_].x, xq_[k_].y}, d01_); \
                    d23_ = __builtin_elementwise_fma((f32x2_t){uf_[4 * k_ + 2], uf_[4 * k_ + 3]}, (f32x2_t){xq_[k_].z, xq_[k_].w}, d23_); } \
                part[s_] = (d01_.x + d01_.y) + (d23_.x + d23_.y); } \
            _Pragma("unroll") for (int off_ = 2; off_ >= 1; off_ >>= 1) { const bool up_ = (lane & off_) != 0; \
                _Pragma("unroll") for (int i_ = 0; i_ < off_; ++i_) { float pa_ = part[i_], pb_ = part[i_ + off_]; asm("" : "+v"(pa_), "+v"(pb_)); const float keep_ = up_ ? pb_ : pa_; const float send_ = up_ ? pa_ : pb_; part[i_] = keep_ + __shfl_xor(send_, off_); } } \
            float tot_ = part[0]; tot_ += __shfl_xor(tot_, 4); tot_ += __shfl_xor(tot_, 8); tot_ += __shfl_xor(tot_, 16);         \
            const float coefv_ = gA * svA * gelu_erf(suA * tot_); \
            _Pragma("unroll") for (int s_ = 0; s_ < 4; ++s_) { const float cf_ = __shfl(coefv_, (lane & 32) | s_); const f32x2_t cf2_ = {cf_, cf_}; const v32f_t vf_ = P6_CVT(vb[s_], vb2[s_]); \
                _Pragma("unroll") for (int i_ = 0; i_ < 16; ++i_) ACC[i_] = __builtin_elementwise_fma((f32x2_t){vf_[2 * i_], vf_[2 * i_ + 1]}, cf2_, ACC[i_]); } \
        } while (0)
#define P6_SB() __builtin_amdgcn_sched_barrier(0)
#define P6_ROUND(TI, ACC, QNEXT) do { \
            int von_[4]; \
            const v2u qn_ = Q[(QNEXT) + 2 * (lane & 3) + hf]; \
            _Pragma("unroll") for (int s_ = 0; s_ < 4; ++s_) { \
                const int ea_ = __builtin_amdgcn_readfirstlane((int)Q[(QNEXT) + 2 * s_].x), eb_ = __builtin_amdgcn_readfirstlane((int)Q[(QNEXT) + 2 * s_ + 1].x); \
                von_[s_] = (hf ? eb_ : ea_) * 768 + voff24; } \
            f32x4 xq_[8]; \
            { const LAS f32x4* xp_ = (const LAS f32x4*)(xl + (TI) * 4096) + lp; \
              _Pragma("unroll") for (int k_ = 0; k_ < 8; ++k_) xq_[k_] = xp_[32 * k_]; } \
            float part[4]; \
            _Pragma("unroll") for (int s_ = 0; s_ < 4; ++s_) { const v32f_t uf_ = P6_CVT(ub[s_], ub2[s_]); P6_SB(); \
                ub[s_] = __builtin_amdgcn_raw_buffer_load_b128(rsu, von_[s_], 0, 0); ub2[s_] = __builtin_amdgcn_raw_buffer_load_b64(rsu, von_[s_] + 16, 0, 0); P6_SB(); \
                f32x2_t d01_ = {0.f, 0.f}, d23_ = {0.f, 0.f}; \
                _Pragma("unroll") for (int k_ = 0; k_ < 8; ++k_) { \
                    d01_ = __builtin_elementwise_fma((f32x2_t){uf_[4 * k_], uf_[4 * k_ + 1]}, (f32x2_t){xq_[k_].x, xq_[k_].y}, d01_); \
                    d23_ = __builtin_elementwise_fma((f32x2_t){uf_[4 * k_ + 2], uf_[4 * k_ + 3]}, (f32x2_t){xq_[k_].z, xq_[k_].w}, d23_); } \
                part[s_] = (d01_.x + d01_.y) + (d23_.x + d23_.y); } \
            _Pragma("unroll") for (int off_ = 2; off_ >= 1; off_ >>= 1) { const bool up_ = (lane & off_) != 0; \
                _Pragma("unroll") for (int i_ = 0; i_ < off_; ++i_) { float pa_ = part[i_], pb_ = part[i_ + off_]; asm("" : "+v"(pa_), "+v"(pb_)); const float keep_ = up_ ? pb_ : pa_; const float send_ = up_ ? pa_ : pb_; part[i_] = keep_ + __shfl_xor(send_, off_); } } \
            float tot_ = part[0]; tot_ += __shfl_xor(tot_, 4); tot_ += __shfl_xor(tot_, 8); tot_ += __shfl_xor(tot_, 16); \
            const float coefv_ = gA * svA * gelu_erf(suA * tot_); \
            P6_SB(); gA = __uint_as_float(qn_.y); suA = SU[(int)qn_.x]; svA = SV[(int)qn_.x]; P6_SB(); \
            _Pragma("unroll") for (int s_ = 0; s_ < 4; ++s_) { const float cf_ = __shfl(coefv_, (lane & 32) | s_); const f32x2_t cf2_ = {cf_, cf_}; const v32f_t vf_ = P6_CVT(vb[s_], vb2[s_]); P6_SB(); \
                vb[s_] = __builtin_amdgcn_raw_buffer_load_b128(rsv, von_[s_], 0, 0); vb2[s_] = __builtin_amdgcn_raw_buffer_load_b64(rsv, von_[s_] + 16, 0, 0); P6_SB(); \
                _Pragma("unroll") for (int i_ = 0; i_ < 16; ++i_) ACC[i_] = __builtin_elementwise_fma((f32x2_t){vf_[2 * i_], vf_[2 * i_ + 1]}, cf2_, ACC[i_]); } \
        } while (0)
        if (T == 2) {
            P6_SB(); P6_FETCH(0); P6_SB();
#pragma unroll 1
            for (int jj = 0; jj < 16; ++jj) {
                if ((jj & 1) == 0) __builtin_amdgcn_s_barrier();
                P6_ROUND(0, acc0, 128 + 8 * jj); P6_SB();
                P6_ROUND(1, acc1, (jj < 15 ? 8 * jj + 8 : 120)); P6_SB();
            }
        } else {
#pragma unroll 1
            for (int jj = 0; jj < 16; ++jj) { P6_SB(); P6_FETCH(8 * jj); P6_SB(); P6_MATH(0, acc0); }
        }
        asm volatile("" ::: "memory"); __builtin_amdgcn_sched_barrier(0);
        peer_finish_token6(acc0, X1B, g2, b2, Y, tok0, lane);
        asm volatile("" ::: "memory"); __builtin_amdgcn_sched_barrier(0);
        if (T > 1) peer_finish_token6(acc1, X1B, g2, b2, Y, tok0 + 1, lane);
        LDS_WAIT();
    }
    {
        asm volatile("" : "+v"(lane));
        const int lp = lane & 31, hf = lane >> 5; const int voff24 = lp * 24;
        float gA, suA, svA; v4u ub[4], vb[4]; v2u ub2[4], vb2[4];
#pragma unroll 1
        for (int tr = full * TT * NGW + (int)blockIdx.x; tr < NTOK; tr += nblk) {
            __syncthreads();
            {
                const size_t o = (size_t)tr * 128 + 16 * wave + (lane & 15);
                if (lane < 16) { v2u ent; ent.x = (unsigned)IDX[o]; ent.y = __float_as_uint(GATE[o]); Q[lane] = ent; }
                const v4u* xp = (const v4u*)(X1B + (size_t)tr * DM) + 2 * lane; const v4u a = xp[0], b = xp[1];
                P6_XSTORE(xl, a, b);
            }
            LDS_WAIT();
            f32x2_t acc0[16];
#pragma unroll
            for (int i = 0; i < 16; ++i) acc0[i] = (f32x2_t){0.f, 0.f};
            P6_SB(); P6_FETCH(0); P6_SB(); P6_MATH(0, acc0);
            P6_SB(); P6_FETCH(8); P6_SB(); P6_MATH(0, acc0);
#pragma unroll
            for (int i = 0; i < 32; ++i) ((LAS float*)(wl + 4096))[i * 64 + lane] = (i & 1) ? acc0[i >> 1].y : acc0[i >> 1].x;
            __syncthreads();
            if (wave == 0) {
#pragma unroll 1
                for (int w = 1; w < 8; ++w) {
                    const LAS float* rp = (const LAS float*)(lds0 + w * 12288 + 4096) + lane;
#pragma unroll
                    for (int i = 0; i < 16; ++i) { acc0[i].x += rp[(2 * i) * 64]; acc0[i].y += rp[(2 * i + 1) * 64]; }
                }
                peer_finish_token6(acc0, X1B, g2, b2, Y, tr, lane);
            }
        }
    }
#undef P6_FETCH
#undef P6_XSTORE
#undef P6_CVT
#undef P6_MATH
#undef P6_ROUND
#undef P6_SB
}

template <int NB>
__device__ __forceinline__ void block_gemm32(const bf16* A, const bf16* Bt, int row0, int n0, int n1, LAS float* part, float (&v0)[2], float (&v1)[2], int tid) {
    const int lane = tid & 63, w = tid >> 6, q = lane & 31, hi = lane >> 5;
    const bf16* ap = A + (size_t)(row0 + q) * DM + 128 * w + 8 * hi;
    const bf16* b0p = Bt + (size_t)(n0 + q) * DM + 128 * w + 8 * hi;
    const bf16* b1p = Bt + (size_t)(n1 + q) * DM + 128 * w + 8 * hi;
    bf16x8_t af[8], bf0[8], bf1[8];
#pragma unroll
    for (int ks = 0; ks < 8; ++ks) { af[ks] = *(const bf16x8_t*)(ap + 16 * ks); bf0[ks] = *(const bf16x8_t*)(b0p + 16 * ks); if constexpr (NB == 2) bf1[ks] = *(const bf16x8_t*)(b1p + 16 * ks); }
    f32x16_t acc0 = {0.f, 0.f, 0.f, 0.f, 0.f, 0.f, 0.f, 0.f, 0.f, 0.f, 0.f, 0.f, 0.f, 0.f, 0.f, 0.f}, acc1 = acc0;
#pragma unroll
    for (int ks = 0; ks < 8; ++ks) {
        acc0 = __builtin_amdgcn_mfma_f32_32x32x16_bf16(af[ks], bf0[ks], acc0, 0, 0, 0);
        if constexpr (NB == 2) acc1 = __builtin_amdgcn_mfma_f32_32x32x16_bf16(af[ks], bf1[ks], acc1, 0, 0, 0);
    }
    __syncthreads();
#pragma unroll
    for (int r = 0; r < 16; ++r) { part[(w * 16 + r) * 64 + lane] = acc0[r]; if constexpr (NB == 2) part[8192 + (w * 16 + r) * 64 + lane] = acc1[r]; }
    __syncthreads();
#pragma unroll
    for (int e = 0; e < 2; ++e) {
        float s0 = 0.f, s1 = 0.f;
#pragma unroll
        for (int ww = 0; ww < 8; ++ww) { s0 += part[ww * 1024 + tid + 512 * e]; if constexpr (NB == 2) s1 += part[8192 + ww * 1024 + tid + 512 * e]; }
        v0[e] = s0; v1[e] = s1;
    }
}
__device__ __forceinline__ void tile_ij(int tid, int e, int& i, int& j) { const int idx = tid + 512 * e, r = idx >> 6, ln = idx & 63; i = crow(r, ln >> 5); j = ln & 31; }
__device__ __forceinline__ void sample_inproj_task(const bf16* XB, const bf16* WT1, bf16* QB, bf16* GB, float* out, int task, LAS float* part, int tid) {
    const int rt = task >> 6, ct = task & 63;
    float v0[2], v1[2];
    if (ct < 48) {
        block_gemm32<1>(XB, WT1, NP + 32 * rt, 32 * ct, 0, part, v0, v1, tid);
        const int which = ct >> 4;
#pragma unroll
        for (int e = 0; e < 2; ++e) {
            int i, j; tile_ij(tid, e, i, j);
            const int s_ = 32 * rt + i, col = (ct & 15) * 32 + j;
            QB[(size_t)which * ((size_t)NTOK * 512) + (size_t)(NP + s_) * 512 + col] = (bf16)(cvtpk(v0[e], 0.f) & 0xffffu);
            if (which != 0) out[(which == 1 ? O_KS : O_VS) + ((size_t)(s_ >> 3) * 2048 + 2040 + (s_ & 7)) * 512 + col] = v0[e];
        }
    } else {
        const int cb = ct - 48; const int na = 1536 + 256 * (cb >> 2) + (cb & 3) * 32;
        block_gemm32<2>(XB, WT1, NP + 32 * rt, na, na + 128, part, v0, v1, tid);
#pragma unroll
        for (int e = 0; e < 2; ++e) {
            int i, j; tile_ij(tid, e, i, j);
            const int s_ = 32 * rt + i, ch = cb * 32 + j;
            const float g = v0[e] / (1.f + __expf(-v1[e]));
            GB[(size_t)(NP + s_) * 512 + ch] = (bf16)(cvtpk(g, 0.f) & 0xffffu);
            out[O_CS + ((size_t)(s_ >> 3) * 30 + 22 + (s_ & 7)) * 512 + ch] = g;
        }
    }
}
__device__ __forceinline__ void sample_outproj_task(const bf16* MIX, const bf16* WT2, const float* xs, bf16* H, int task, LAS float* part, int tid) {
    const int rt = task >> 5, ct = task & 31;
    float v0[2], v1[2];
    block_gemm32<1>(MIX, WT2, NP + 32 * rt, 32 * ct, 0, part, v0, v1, tid);
#pragma unroll
    for (int e = 0; e < 2; ++e) { int i, j; tile_ij(tid, e, i, j); const int s_ = 32 * rt + i; H[(size_t)(NP + s_) * DM + 32 * ct + j] = (bf16)(cvtpk(ALPHA * xs[(size_t)s_ * DM + 32 * ct + j] + v0[e], 0.f) & 0xffffu); }
}
__device__ __forceinline__ void sample_query_task(const bf16* X1B, const bf16* WT3, bf16* PQ, int task, LAS float* part, int tid) {
    const int rt = task >> 6, ct = task & 63;
    float v0[2], v1[2];
    block_gemm32<1>(X1B, WT3, NP + 32 * rt, 32 * ct, 0, part, v0, v1, tid);
#pragma unroll
    for (int e = 0; e < 2; ++e) { int i, j; tile_ij(tid, e, i, j); const int s_ = 32 * rt + i; PQ[(size_t)(NP + s_) * PQD + 32 * ct + j] = (bf16)(cvtpk(v0[e], 0.f) & 0xffffu); }
}

#define XB_TMO      128
#define XB_XCNT(j)  (256  + 64 * (j))
#define XB_XSUB(j)  (1280 + 64 * (j))
#define XB_XGEN(j)  (2304 + 64 * (j))
#define XB_TOP      3328
#define XB_TOPGEN   3392
#define XCD_BAR_WORDS 3456
#define XB_SPIN_CAP (1u << 18)
__device__ __forceinline__ unsigned xb_ld(unsigned* p)              { return __hip_atomic_load(p, __ATOMIC_RELAXED, __HIP_MEMORY_SCOPE_AGENT); }
__device__ __forceinline__ unsigned xb_add(unsigned* p, unsigned v) { return __hip_atomic_fetch_add(p, v, __ATOMIC_RELAXED, __HIP_MEMORY_SCOPE_AGENT); }
__device__ __forceinline__ unsigned xb_xcc_id() { return (unsigned)__builtin_amdgcn_s_getreg((3 << 11) | 20) & 0xFu; }
#define XB_SPIN(cond, bar) do { unsigned _sp = 0; while (cond) { __builtin_amdgcn_s_sleep(1); \
    if ((++_sp & 255u) == 0u) { if (xb_ld(&(bar)[XB_TMO])) break; if (_sp > XB_SPIN_CAP) { atomicAdd(&(bar)[XB_TMO], 1u); break; } } } } while (0)
struct XcdBarrier { unsigned* bar; unsigned x; volatile LAS unsigned* st; };
__device__ __forceinline__ XcdBarrier xcd_barrier_post(unsigned* bar, volatile LAS unsigned* st) {
    XcdBarrier b; b.bar = bar; b.x = xb_xcc_id(); b.st = st;
    if (threadIdx.x == 0) (void)xb_add(&bar[XB_XCNT(b.x)], 1u);
    return b;
}
__device__ __forceinline__ void xcd_barrier_complete(unsigned* bar, unsigned x, unsigned& nloc, unsigned& nx) {
    const unsigned G = gridDim.x * gridDim.y * gridDim.z;
    unsigned sum, cnt, mine, sp = 0u;
    for (;;) {
        sum = 0u; cnt = 0u; mine = 0u;
#pragma unroll
        for (unsigned j = 0; j < 16; ++j) { const unsigned c = xb_ld(&bar[XB_XCNT(j)]); sum += c; cnt += (c > 0u) ? 1u : 0u; mine = (j == x) ? c : mine; }
        if (sum == G) break;
        __builtin_amdgcn_s_sleep(1);
        if ((++sp & 255u) == 0u) { if (xb_ld(&bar[XB_TMO])) break; if (sp > XB_SPIN_CAP) { atomicAdd(&bar[XB_TMO], 1u); break; } }
    }
    nloc = mine > 0u ? mine : 1u; nx = cnt > 0u ? cnt : 1u;
}
__device__ __forceinline__ void xcd_barrier(const XcdBarrier& b) {
    asm volatile("s_waitcnt vmcnt(0)" ::: "memory");
    __syncthreads();
    if (threadIdx.x == 0) {
        unsigned* bar = b.bar;
        __builtin_amdgcn_s_waitcnt(0);
        unsigned nloc = b.st[0], nx = b.st[1];
        if (nloc == 0u) { xcd_barrier_complete(bar, b.x, nloc, nx); b.st[0] = nloc; b.st[1] = nx; }
        const unsigned old = xb_add(&bar[XB_XSUB(b.x)], 1u);
        const unsigned gen = old / nloc;
        if (old + 1u == (gen + 1u) * nloc) {
            __builtin_amdgcn_fence(__ATOMIC_RELEASE, "agent");
            asm volatile("s_waitcnt vmcnt(0)" ::: "memory");
            const unsigned og = xb_add(&bar[XB_TOP], 1u);
            const unsigned tg = og / nx;
            if (og + 1u == (tg + 1u) * nx) xb_add(&bar[XB_TOPGEN], 1u);
            else XB_SPIN(xb_ld(&bar[XB_TOPGEN]) == tg, bar);
            __builtin_amdgcn_fence(__ATOMIC_ACQUIRE, "agent");
            xb_add(&bar[XB_XGEN(b.x)], 1u);
            asm volatile("s_waitcnt vmcnt(0)" ::: "memory");
        } else {
            XB_SPIN(xb_ld(&bar[XB_XGEN(b.x)]) == gen, bar);
            __builtin_amdgcn_fence(__ATOMIC_ACQUIRE, "agent");
            asm volatile("s_waitcnt vmcnt(0)" ::: "memory");
        }
    }
    __syncthreads();
}

__global__ void __launch_bounds__(NTHREADS, 2) fwd_megakernel(Params p) {
    extern __shared__ __attribute__((aligned(16))) unsigned char lds_raw[];
    LAS unsigned char* lds = (LAS unsigned char*)lds_raw;
    cg::grid_group grid = cg::this_grid();
    int tid = threadIdx.x, lane = tid & 63; const int wave = __builtin_amdgcn_readfirstlane(tid >> 6);
    const int G = gridDim.x, gw = blockIdx.x * NWAVES + wave, NGW = G * NWAVES;
    const long gt = (long)blockIdx.x * NTHREADS + tid, NGT = (long)G * NTHREADS;
    unsigned char* ws = p.ws;
    float* out = p.out;
    volatile LAS unsigned* bst = (volatile LAS unsigned*)(lds + LDS_BYTES - 64);
    if (tid < 16) bst[tid] = 0u;
    __syncthreads();
    const XcdBarrier xbar = xcd_barrier_post((unsigned*)(ws + WS_CTL), bst);
    bf16* WT1 = (bf16*)(ws + WS_WT1); bf16* WT2 = (bf16*)(ws + WS_WT2); bf16* WT3 = (bf16*)(ws + WS_WT3); bf16* SKB = (bf16*)(ws + WS_SK);
    unsigned char* EU8 = ws + WS_EU; unsigned char* EV8 = ws + WS_EV;
    float* SU = (float*)(ws + WS_EU + 16 * MiB); float* SV = (float*)(ws + WS_EV + 16 * MiB);
    bf16* XB = (bf16*)(ws + WS_XB);
    bf16* CSB = (bf16*)(ws + WS_EU + 20 * MiB);
    bf16* QB = (bf16*)(ws + WS_QKVG); bf16* KB = (bf16*)(ws + WS_QKVG + QSZ); bf16* VB = (bf16*)(ws + WS_QKVG + 2 * QSZ); bf16* GB = (bf16*)(ws + WS_QKVG + 3 * QSZ);
    bf16* MIX = (bf16*)(ws + WS_MIX); bf16* HBB = (bf16*)(ws + WS_H);

    {
        LAS float* scr = (LAS float*)(lds + wave * 16384);
        constexpr int I1 = 16 * (INC / 32), I2 = 16 * (DM / 32), I3 = 16 * (PQD / 32);
        for (int it = gw; it < I1 + I2 + I3; it += NGW) {
            int r = it;
            if (r < I1) { const int kb = r / (INC / 32), nb = r % (INC / 32); p0_transpose_item(p.in[5], INC, DM, w1_src_col(32 * nb), WT1, 32 * nb, 64 * kb, scr, lane); continue; } r -= I1;
            if (r < I2) { const int kb = r / (DM / 32), nb = r % (DM / 32); p0_transpose_item(p.in[6], DM, DM, 32 * nb, WT2, 32 * nb, 64 * kb, scr, lane); continue; } r -= I2;
            { const int kb = r / (PQD / 32), nb = r % (PQD / 32); p0_transpose_item(p.in[13], PQD, DM, 32 * nb, WT3, 32 * nb, 64 * kb, scr, lane); }
        }
        constexpr int I_XP = NP / 4, I_XS = NS / 4, I_SK = 64, I_EU = 8192, I_EV = 8192, I_CS = NSB * 30 * 512 / 4096;
        for (int it = gw; it < I_XP + I_XS + I_SK + I_CS + I_EU + I_EV; it += NGW) {
            int r = it;
            if (r < I_XP) { rows4_to_bf16(p.in[0] + (size_t)r * 4096, XB + (size_t)r * 4096, lane); continue; } r -= I_XP;
            if (r < I_XS) { rows4_to_bf16(p.in[1] + (size_t)r * 4096, XB + (size_t)NP * DM + (size_t)r * 4096, lane); continue; } r -= I_XS;
            if (r < I_SK) { rows4_to_bf16(p.in[14] + (size_t)r * 4096, SKB + (size_t)r * 4096, lane); continue; } r -= I_SK;
            if (r < I_CS) { rows4_to_bf16(p.in[4] + (size_t)r * 4096, CSB + (size_t)r * 4096, lane); continue; } r -= I_CS;
            if (r < I_EU) { rows2_to_fp6(p.in[15] + (size_t)r * 2048, EU8 + (size_t)r * 1536, SU + 2 * r, lane); continue; } r -= I_EU;
            rows2_to_fp6(p.in[16] + (size_t)r * 2048, EV8 + (size_t)r * 1536, SV + 2 * r, lane);
        }
        {
            constexpr long PER_BC = 22L * 128, TOTC = NSB * PER_BC;
            const f32x4* sc = (const f32x4*)p.in[4]; f32x4* oc = (f32x4*)(out + O_CS);
            for (long i = gt; i < TOTC; i += NGT) { const long b = i / PER_BC, rem = i - b * PER_BC; oc[b * 30 * 128 + rem] = sc[b * 30 * 128 + 8 * 128 + rem]; }
        }
    }
    xcd_barrier(xbar); asm volatile("" : "+v"(tid), "+v"(lane));

    {
        pg8::Gemm g{XB, WT1, NP, INC, DM}; pg8::StaticOrder S; S.init(NP, INC, G, (int)blockIdx.x);
        EpiInProj E{QB, GB, out};
        pg8::gemm_phase<EpiInProj, pg8::StaticOrder, true, true>(lds, g, S, E);
        for (int task = blockIdx.x; task < 8 * 64; task += G) sample_inproj_task(XB, WT1, QB, GB, out, task, (LAS float*)lds, tid);
    }
    xcd_barrier(xbar); asm volatile("" : "+v"(tid), "+v"(lane));

    bf16* OP = (bf16*)(ws + WS_H); float* LSE = (float*)(ws + WS_H + (size_t)3 * NTOK * 512 * 2);
    {
        LAS float* wl = (LAS float*)(lds + 65536);
        for (int i = tid; i < (CK + 1) * CC / 4; i += NTHREADS) ((LAS f32x4*)wl)[i] = i < CK * CC / 4 ? ((const f32x4*)p.in[7])[i] : (f32x4){0.f, 0.f, 0.f, 0.f};
        __syncthreads();
        LAS unsigned char* vbuf = lds + wave * 8192;
        const AttnArgs AA{QB, KB, VB, p.in[2], p.in[3], out, OP, LSE};
        constexpr int T_CONV = 4096 + NSB, T_SA = NSB * NH * 13;
        const __amdgpu_buffer_rsrc_t rsw = __builtin_amdgcn_make_buffer_rsrc((void*)ws, 0, 0x40000000, 0x00020000);
        for (int task = gw; task < T_CONV + T_SA; task += NGW) {
            asm volatile("" : "+v"(lane));
            int k = task;
            if (k < T_SA) { attn_mfma_task<true, false>(AA, k, vbuf, lane); continue; }
            k -= T_SA;
            conv_task(rsw, (unsigned)((const unsigned char*)GB - ws), (unsigned)((const unsigned char*)CSB - ws), wl, p.in[8], p.in[9], p.in[10], MIX, k, lane);
        }
        attn_block_phase(AA, lds, G, tid, wave, lane);
    }
    xcd_barrier(xbar); asm volatile("" : "+v"(tid), "+v"(lane));
    for (int r = gw; r < NTOK; r += NGW) attn_merge_row(OP, LSE, MIX, r, lane);
    xcd_barrier(xbar); asm volatile("" : "+v"(tid), "+v"(lane));

    {
        pg8::Gemm g{MIX, WT2, NP, DM, DM}; pg8::StaticOrder S; S.init(NP, DM, G, (int)blockIdx.x);
        EpiResid E{XB, HBB};
        pg8::gemm_phase<EpiResid, pg8::StaticOrder, true, true>(lds, g, S, E);
        for (int task = blockIdx.x; task < 8 * 32; task += G) sample_outproj_task(MIX, WT2, p.in[1], HBB, task, (LAS float*)lds, tid);
    }
    xcd_barrier(xbar); asm volatile("" : "+v"(tid), "+v"(lane));

    bf16* X1B = XB;
    for (int r = 4 * gw; r < NTOK; r += 4 * NGW) ln1_rows4(HBB, X1B, p.in[11], p.in[12], r, lane);
    xcd_barrier(xbar); asm volatile("" : "+v"(tid), "+v"(lane));

    bf16* PQ = (bf16*)(ws + WS_QKVG);
    {
        pg8::Gemm g{X1B, WT3, NP, PQD, DM}; pg8::StaticOrder S; S.init(NP, PQD, G, (int)blockIdx.x);
        EpiPlainBf16 E{PQ, PQD};
        pg8::gemm_phase<EpiPlainBf16, pg8::StaticOrder, true, true>(lds, g, S, E);
        for (int task = blockIdx.x; task < 8 * 64; task += G) sample_query_task(X1B, WT3, PQ, task, (LAS float*)lds, tid);
    }
    xcd_barrier(xbar); asm volatile("" : "+v"(tid), "+v"(lane));

    int* IDX = (int*)(ws + WS_MIX); float* GATE = (float*)(ws + WS_MIX + (size_t)NTOK * 128 * 4);
    {
        constexpr int NTILE = NTOK / 32;
        const CacheCopy CC{(const f32x4*)p.in[2], (const f32x4*)p.in[3], (f32x4*)(out + O_KS), (f32x4*)(out + O_VS)};
        const int ntb = ((int)blockIdx.x < NTILE) ? (NTILE - 1 - (int)blockIdx.x) / G + 1 : 0;
        for (int hp = 0; hp < 4; ++hp) {
            __syncthreads();
            const v4u* src = (const v4u*)(SKB + (size_t)hp * 2 * 2 * 128 * 128);
#pragma unroll 4
            for (int i = 0; i < 16; ++i) { const int gch = tid + NTHREADS * i, row = gch >> 4, ch = gch & 15; *(LAS v4u*)(lds + row * 256 + ((ch ^ (row & 15)) << 4)) = src[gch]; }
            __syncthreads();
            if (G == 256) {
                topk_mfma_task(PQ, lds + (wave & 1) * 65536, IDX, GATE, (int)blockIdx.x * 4 + (wave >> 1), 2 * hp + (wave & 1), lane, CC);
                const int x = (int)blockIdx.x - 8;
                if (x >= 0 && x < 64 && ((x >> 4) == hp) && wave == 0) topk_mfma_task(PQ, lds + ((x >> 3) & 1) * 65536, IDX, GATE, 1024 + (x & 7), x >> 3, lane, CC);
            } else {
                for (int k0 = 0; k0 < ntb; k0 += 4) {
                    const int k = k0 + (wave >> 1);
                    if (k < ntb) topk_mfma_task(PQ, lds + (wave & 1) * 65536, IDX, GATE, (int)blockIdx.x + G * k, 2 * hp + (wave & 1), lane, CC);
                }
            }
        }
    }
    xcd_barrier(xbar); asm volatile("" : "+v"(tid), "+v"(lane));

#ifdef PEER_TOKEN_MAJOR
    peer_phase(X1B, HB, IDX, GATE, EU8, EV8, SU, SV, p.in[17], p.in[18], out + O_Y, gw, NGW, lane);
#else
    peer_phase6(X1B, IDX, GATE, EU8, EV8, SU, SV, p.in[17], p.in[18], out + O_Y, gw, NGW, lane, lds + wave * 12288, lds, wave, G);
    grid.sync();
#endif
}

extern "C" void kernel_launch(void* const* d_in, const int* in_sizes, int n_in, void* d_out, int out_size, void* d_ws, size_t ws_size, hipStream_t stream) {
    static int grid_blocks = 0;
    if (grid_blocks == 0) {
        if (n_in != 19 || (size_t)out_size != O_END || ws_size < WS_END) { fprintf(stderr, "kernel_launch: unexpected shapes n_in %d out %d ws %zu\n", n_in, out_size, ws_size); grid_blocks = -1; return; }
        int dev = 0, cus = 0, per_cu = 0;
        (void)hipGetDevice(&dev);
        (void)hipDeviceGetAttribute(&cus, hipDeviceAttributeMultiprocessorCount, dev);
        (void)hipFuncSetAttribute((const void*)fwd_megakernel, hipFuncAttributeMaxDynamicSharedMemorySize, LDS_BYTES);
        (void)hipOccupancyMaxActiveBlocksPerMultiprocessor(&per_cu, (const void*)fwd_megakernel, NTHREADS, LDS_BYTES);
        if (per_cu < 1) { fprintf(stderr, "kernel_launch: occupancy query says %d blocks per CU\n", per_cu); per_cu = 1; }
        if (per_cu > 1) per_cu = 1;
        grid_blocks = cus * per_cu;
        (void)hipGetLastError();
    }
    if (grid_blocks < 0) return;
    (void)hipMemsetAsync((char*)d_ws + WS_CTL, 0, 16384, stream);
    Params p{};
    for (int i = 0; i < 19; ++i) p.in[i] = (const float*)d_in[i];
    p.out = (float*)d_out; p.ws = (unsigned char*)d_ws;
    void* args[] = {&p};
    hipError_t e = hipLaunchCooperativeKernel((const void*)fwd_megakernel, dim3(grid_blocks), dim3(NTHREADS), args, LDS_BYTES, stream);
    if (e != hipSuccess) fprintf(stderr, "cooperative launch failed: %s (grid %d)\n", hipGetErrorString(e), grid_blocks);
}
```
